# Optimizing an MI355X kernel written in HIP

```python
import jax, jax.numpy as jnp
from jax import lax
import numpy as np

D_MODEL = 2048
BATCH = 2
SEQ = 4096
DEPTH = 1

GLA_HEADS = 4
GLA_DK = D_MODEL // (2 * GLA_HEADS)
GLA_DV = D_MODEL // GLA_HEADS
GLA_RANK = 16
GLA_TAU = 16.0
GLA_CHUNK = 64
FOX_HEADS = 8
FOX_DH = 128
FOX_BLOCK = 128
D_FF = 5632
CONV_W = 3
PLE_DIM = 256
LN_EPS = 1e-5
RMS_EPS = 1e-6
ALPHA = (2 * DEPTH) ** 0.25
BETA = (8 * DEPTH) ** -0.25

GLA_QK = GLA_HEADS * GLA_DK
GLA_V = GLA_HEADS * GLA_DV
FOX_W = FOX_HEADS * FOX_DH
SPLITS = (GLA_QK, GLA_QK, GLA_V, GLA_V, GLA_RANK,
          FOX_W, FOX_W, FOX_W, FOX_HEADS,
          D_MODEL, D_MODEL)
N_IN = sum(SPLITS)

kernel_name = "hybrid_gla_fox_gated_merge_deepnorm"


def layer_norm(x, g, b):
    xf = x.astype(jnp.float32)
    mu = jnp.mean(xf, -1, keepdims=True)
    var = jnp.mean(jnp.square(xf - mu), -1, keepdims=True)
    return ((xf - mu) * lax.rsqrt(var + LN_EPS) * g.astype(jnp.float32)
            + b.astype(jnp.float32)).astype(x.dtype)


def gla_chunked(q, k, v, log_a):
    B, S, H, DK = q.shape
    DV = v.shape[-1]
    n = S // GLA_CHUNK

    def to_chunks(t):
        return t.reshape(B, n, GLA_CHUNK, H, t.shape[-1]).transpose(1, 0, 3, 2, 4)

    qc, kc, vc, gc = (to_chunks(t) for t in (q, k, v, log_a))
    causal = jnp.tril(jnp.ones((GLA_CHUNK, GLA_CHUNK), bool))[:, :, None]

    def step(state, inp):
        qb, kb, vb, gb = inp
        bcum = jnp.cumsum(gb, axis=-2)
        inter = jnp.einsum('bhck,bhkv->bhcv', qb * jnp.exp(bcum), state)
        diff = bcum[..., :, None, :] - bcum[..., None, :, :]
        decay = jnp.exp(jnp.where(causal, diff, -jnp.inf))
        attn = jnp.einsum('bhtk,bhsk,bhtsk->bhts', qb, kb, decay)
        intra = jnp.einsum('bhts,bhsv->bhtv', attn, vb)
        blast = bcum[..., -1:, :]
        state = (jnp.exp(blast[..., 0, :])[..., None] * state
                 + jnp.einsum('bhsk,bhsv->bhkv', kb * jnp.exp(blast - bcum), vb))
        return state, inter + intra

    s0 = jnp.zeros((B, H, DK, DV), jnp.float32)
    _, o = lax.scan(step, s0, (qc, kc, vc, gc))
    return o.transpose(1, 0, 3, 2, 4).reshape(B, S, H, DV)


def fox_attention(q, k, v, log_f):
    B, S, H, Dh = q.shape
    nb = S // FOX_BLOCK
    c = jnp.cumsum(log_f, axis=1).transpose(0, 2, 1)
    qh = q.transpose(0, 2, 1, 3) * (Dh ** -0.5)
    kh = k.transpose(0, 2, 1, 3)
    vh = v.transpose(0, 2, 1, 3)
    qb = qh.reshape(B, H, nb, FOX_BLOCK, Dh).transpose(2, 0, 1, 3, 4)
    cb = c.reshape(B, H, nb, FOX_BLOCK).transpose(2, 0, 1, 3)
    pos_k = jnp.arange(S)

    def block(args):
        i, q_i, c_i = args
        pos_q = i * FOX_BLOCK + jnp.arange(FOX_BLOCK)
        s = (jnp.einsum('bhqd,bhkd->bhqk', q_i, kh)
             + c_i[..., :, None] - c[..., None, :])
        s = jnp.where(pos_k[None, :] <= pos_q[:, None], s, -jnp.inf)
        pr = jax.nn.softmax(s, axis=-1)
        return jnp.einsum('bhqk,bhkd->bhqd', pr, vh)

    o = lax.map(block, (jnp.arange(nb), qb, cb))
    return o.transpose(1, 0, 3, 2, 4).reshape(B, S, H, Dh)


def token_mixers(x, w_in, w_gla_lr, b_gla_lr, gla_norm_g, b_forget,
                 w_branch_gla, w_branch_fox, w_out):
    B, S, _ = x.shape
    f32 = jnp.float32
    proj = x @ w_in
    offsets = np.cumsum(SPLITS)[:-1].tolist()
    gq, gk, gv, gr, glr, fq, fk, fv, ff, ma, mb = jnp.split(proj, offsets, axis=-1)

    q = gq.reshape(B, S, GLA_HEADS, GLA_DK).astype(f32) * (GLA_DK ** -0.5)
    k = gk.reshape(B, S, GLA_HEADS, GLA_DK).astype(f32)
    v = gv.reshape(B, S, GLA_HEADS, GLA_DV).astype(f32)
    log_a = (jax.nn.log_sigmoid((glr @ w_gla_lr + b_gla_lr).astype(f32))
             / GLA_TAU).reshape(B, S, GLA_HEADS, GLA_DK)
    o = gla_chunked(q, k, v, log_a)
    o = o * lax.rsqrt(jnp.mean(o * o, -1, keepdims=True) + RMS_EPS) * gla_norm_g.astype(f32)
    o = (o.reshape(B, S, GLA_V) * jax.nn.silu(gr.astype(f32))).astype(x.dtype)
    y_gla = o @ w_branch_gla

    fqh = fq.reshape(B, S, FOX_HEADS, FOX_DH).astype(f32)
    fkh = fk.reshape(B, S, FOX_HEADS, FOX_DH).astype(f32)
    fvh = fv.reshape(B, S, FOX_HEADS, FOX_DH).astype(f32)
    log_f = jax.nn.log_sigmoid((ff + b_forget).astype(f32))
    of = fox_attention(fqh, fkh, fvh, log_f).reshape(B, S, FOX_W).astype(x.dtype)
    y_fox = of @ w_branch_fox

    merged = jax.nn.sigmoid(ma) * y_gla + jax.nn.sigmoid(mb) * y_fox
    return merged @ w_out


def causal_dwconv(h, w, b):
    S = h.shape[1]
    hp = jnp.pad(h, ((0, 0), (CONV_W - 1, 0), (0, 0)))
    y = b
    for j in range(CONV_W):
        y = y + hp[:, j:j + S, :] * w[j]
    return y


def conv_gated_mlp(x, w_gate, w_up, conv_w, conv_b, w_down):
    g = causal_dwconv(x @ w_gate, conv_w, conv_b)
    h = jax.nn.gelu(g) * (x @ w_up)
    return h @ w_down


def setup_inputs(seed: int = 0) -> dict:
    key = jax.random.key(seed)
    ks = jax.random.split(key, 24)
    f32 = jnp.float32

    def nrm(k, shape, scale):
        return jax.random.normal(k, shape, f32) * scale

    L = DEPTH
    return {
        "x": nrm(ks[0], (BATCH, SEQ, D_MODEL), 1.0),
        "p": nrm(ks[1], (DEPTH, BATCH, SEQ, PLE_DIM), 1.0),
        "w_in": nrm(ks[2], (L, D_MODEL, N_IN), D_MODEL ** -0.5),
        "w_gla_lr": nrm(ks[3], (L, GLA_RANK, GLA_QK), GLA_RANK ** -0.5),
        "b_gla_lr": nrm(ks[4], (L, GLA_QK), 0.1),
        "gla_norm_g": 1.0 + nrm(ks[5], (L, GLA_DV), 0.02),
        "b_forget": jax.random.uniform(ks[6], (L, FOX_HEADS), f32, 1.0, 5.0),
        "w_branch_gla": nrm(ks[7], (L, GLA_V, D_MODEL), GLA_V ** -0.5),
        "w_branch_fox": nrm(ks[8], (L, FOX_W, D_MODEL), FOX_W ** -0.5),
        "w_out": nrm(ks[9], (L, D_MODEL, D_MODEL), BETA * D_MODEL ** -0.5),
        "ln1_g": 1.0 + nrm(ks[10], (L, D_MODEL), 0.02),
        "ln1_b": nrm(ks[11], (L, D_MODEL), 0.02),
        "w_gate": nrm(ks[12], (L, D_MODEL, D_FF), D_MODEL ** -0.5),
        "w_up": nrm(ks[13], (L, D_MODEL, D_FF), D_MODEL ** -0.5),
        "conv_w": nrm(ks[14], (L, CONV_W, D_FF), CONV_W ** -0.5),
        "conv_b": nrm(ks[15], (L, D_FF), 0.02),
        "w_down": nrm(ks[16], (L, D_FF, D_MODEL), BETA * D_FF ** -0.5),
        "ln2_g": 1.0 + nrm(ks[17], (L, D_MODEL), 0.02),
        "ln2_b": nrm(ks[18], (L, D_MODEL), 0.02),
        "w_ple_gate": nrm(ks[19], (L, D_MODEL, D_MODEL), D_MODEL ** -0.5),
        "w_ple_proj": nrm(ks[20], (L, PLE_DIM, D_MODEL), BETA * PLE_DIM ** -0.5),
    }


def reference(x, p, w_in, w_gla_lr, b_gla_lr, gla_norm_g, b_forget,
              w_branch_gla, w_branch_fox, w_out, ln1_g, ln1_b,
              w_gate, w_up, conv_w, conv_b, w_down, ln2_g, ln2_b,
              w_ple_gate, w_ple_proj):
    for i in range(DEPTH):
        mix = token_mixers(x, w_in[i], w_gla_lr[i], b_gla_lr[i], gla_norm_g[i],
                           b_forget[i], w_branch_gla[i], w_branch_fox[i], w_out[i])
        x = layer_norm(ALPHA * x + mix, ln1_g[i], ln1_b[i])
        ffn = conv_gated_mlp(x, w_gate[i], w_up[i], conv_w[i], conv_b[i], w_down[i])
        x = layer_norm(ALPHA * x + ffn, ln2_g[i], ln2_b[i])
        x = x + jax.nn.sigmoid(x @ w_ple_gate[i]) * (p[i] @ w_ple_proj[i])
    return x
```

```cpp
#include <hip/hip_runtime.h>
#include <hip/hip_cooperative_groups.h>
#include <cstdio>
#include <cstdint>
namespace cg = cooperative_groups;

constexpr int BATCH = 2, SEQ = 4096, DM = 2048, MTOK = BATCH * SEQ;
constexpr int N_IN = 13336, NPAD = 13568, FF = 5632, PLE = 256;
constexpr float ALPHA_RES = 1.189207115002721f;
constexpr float LN_EPS = 1e-5f, RMS_EPS = 1e-6f;
constexpr float LOG2E = 1.4426950408889634f;

constexpr size_t MiB = 1u << 20;
constexpr size_t WS_CTL = 0, CTL_ZERO_BYTES = 65536;
constexpr size_t WS_WBG = 1 * MiB, WS_WBF = 9 * MiB, WS_WOUT = 13 * MiB, WS_WG = 21 * MiB, WS_WU = 43 * MiB, WS_WD = 65 * MiB, WS_WPG = 87 * MiB, WS_WPP = 95 * MiB;
constexpr size_t WS_PB = 96 * MiB;
constexpr size_t WS_R1 = 100 * MiB;
constexpr size_t WS_WIN = WS_R1, WS_XB = WS_R1 + 53 * MiB;
constexpr size_t WS_QT = WS_R1, WS_KT = WS_R1 + 16 * MiB, WS_VT = WS_R1 + 32 * MiB, WS_ATT = WS_R1 + 64 * MiB, WS_DEC = WS_R1 + 68 * MiB, WS_FVT = WS_R1 + 69 * MiB, WS_CB = WS_R1 + 85 * MiB;
constexpr size_t WS_YTMP = WS_R1;
constexpr size_t WS_G = WS_R1;
constexpr size_t WS_V2 = WS_R1;
constexpr size_t WS_GQ = 188 * MiB, WS_GK = 204 * MiB, WS_GV = 220 * MiB, WS_GR = 252 * MiB, WS_FQ = 284 * MiB, WS_FK = 300 * MiB, WS_FV = 316 * MiB, WS_MB = 332 * MiB, WS_MA = 364 * MiB, WS_SM = 396 * MiB;
constexpr size_t WS_ORAW = WS_GQ;
constexpr size_t WS_X1 = WS_GQ;
constexpr size_t WS_OG = WS_GR, WS_OF = WS_FQ, WS_MERGED = WS_FK;
constexpr size_t WS_H = WS_GR;
constexpr size_t WS_TMP = WS_GR;
constexpr size_t WS_XNB = WS_MA;
constexpr size_t WS_END = 397 * MiB;
constexpr int CW_QUEUE = 64;
constexpr int CW_BAR = 4096;

constexpr int LDS_BYTES = 147456;
constexpr int MISC_OFF = LDS_BYTES - 256;
#define LAS __attribute__((address_space(3)))
typedef LAS unsigned char* lds_t;
namespace pg8 {
#define PG8_LAS __attribute__((address_space(3)))
typedef unsigned short bf16_t;
typedef short bf16x8 __attribute__((ext_vector_type(8)));
typedef float f32x4 __attribute__((ext_vector_type(4)));
typedef unsigned u32x4 __attribute__((ext_vector_type(4)));
constexpr int BM = 256, BK = 64, HALF = 128, HTB = HALF * BK * 2  , STAGE_BYTES = 8 * HTB, NXCD = 8, WGM = 8;

__host__ __device__ __forceinline__ int lds_byte(int r, int c) { const int st = (r >> 4) * 2 + (c >> 5), rr = r & 15, cc = c & 31, ob = rr * 64 + cc * 2; return st * 1024 + (ob ^ (((ob >> 9) & 1) << 5)); }
__host__ __device__ __forceinline__ void stage_rc(int b, int& R, int& C) { const int st = b / 1024, sb = b % 1024, swz = sb ^ (((sb >> 9) & 1) << 5); R = (st >> 1) * 16 + swz / 64; C = (st & 1) * 32 + (swz % 64) / 2; }
__host__ __device__ __forceinline__ int perm32(int rho) { const int n = rho >> 4, i = rho & 15; return 8 * (i >> 2) + 4 * n + (i & 3); }

struct Unit { int pm, pn; };
struct Gemm { const bf16_t* A; const bf16_t* Bt; int M, N, K; };

struct StaticOrder {
    int nM, nN, nwg, G, c;
    __host__ __device__ void init(int M, int N, int G_, int c_) { nM = M / BM; nN = N / BM; nwg = nM * nN; G = G_; c = c_; }
    __host__ __device__ bool next(int i, Unit& u) const {
        const long L = (long)i * G + c; if (L >= nwg) return false;
        int wgid = (int)L; { const int q = nwg / NXCD, r = nwg % NXCD, xcd = wgid % NXCD, off = wgid / NXCD; wgid = (xcd < r ? xcd * (q + 1) : r * (q + 1) + (xcd - r) * q) + off; }
        const int nig = WGM * nN, gid = wgid / nig, fm = gid * WGM, gsz = (nM - fm) < WGM ? (nM - fm) : WGM;
        u.pm = fm + ((wgid % nig) % gsz); u.pn = (wgid % nig) / gsz; return true;
    }
    __device__ __forceinline__ void a_ready(const Unit&) const {}
    __device__ __forceinline__ void done(const Unit&) const {}
};

__device__ __forceinline__ unsigned cvt_pk_bf16(float lo, float hi) { unsigned r; asm volatile("v_cvt_pk_bf16_f32 %0, %1, %2" : "=v"(r) : "v"(lo), "v"(hi)); return r; }
typedef float f32x2 __attribute__((ext_vector_type(2)));

__device__ __forceinline__ float fsigmoid(float x) { return __builtin_amdgcn_rcpf(1.0f + __builtin_amdgcn_exp2f(-1.4426950408889634f * x)); }
__device__ __forceinline__ void unpack8(const u32x4 w, float (&f)[8]) {
#pragma unroll
    for (int i = 0; i < 4; ++i) { f[2 * i] = __uint_as_float(w[i] << 16); f[2 * i + 1] = __uint_as_float(w[i] & 0xffff0000u); }
}
__device__ __forceinline__ u32x4 pack8(const f32x4 a, const f32x4 b) { u32x4 w; w.x = cvt_pk_bf16(a[0], a[1]); w.y = cvt_pk_bf16(a[2], a[3]); w.z = cvt_pk_bf16(b[0], b[1]); w.w = cvt_pk_bf16(b[2], b[3]); return w; }

struct EpiProj {
    static constexpr bool PERM = true, AFTER_DRAIN = false;
    unsigned char* ws; float qscale;
    __device__ __forceinline__ void operator()(const f32x4 (&acc)[2][2][4][2], const Unit& u, int wr, int wc, int fr, int fq) const {
        const int pn = u.pn; const int row0 = u.pm * BM + wr * 64 + fr;
        if (pn == 52) {
            if (wc == 0) { float* sm = (float*)(ws + WS_SM);
#pragma unroll
                for (int ai = 0; ai < 2; ++ai)
#pragma unroll
                    for (int m = 0; m < 4; ++m) { float* rp = sm + (size_t)(row0 + ai * HALF + m * 16) * 32 + 8 * fq; *(f32x4*)rp = acc[ai][0][m][0]; *(f32x4*)(rp + 4) = acc[ai][0][m][1]; } }
            return;
        }
        size_t off; int ldc, ct; float sc = 1.f;
        if (pn < 4) { off = WS_GQ; ldc = 1024; ct = pn; }
        else if (pn < 8) { off = WS_GK; ldc = 1024; ct = pn - 4; }
        else if (pn < 16) { off = WS_GV; ldc = 2048; ct = pn - 8; }
        else if (pn < 24) { off = WS_GR; ldc = 2048; ct = pn - 16; }
        else if (pn < 28) { off = WS_FQ; ldc = 1024; ct = pn - 24; sc = qscale; }
        else if (pn < 32) { off = WS_FK; ldc = 1024; ct = pn - 28; }
        else if (pn < 36) { off = WS_FV; ldc = 1024; ct = pn - 32; }
        else if (pn < 44) { off = WS_MA; ldc = 2048; ct = pn - 36; }
        else { off = WS_MB; ldc = 2048; ct = pn - 44; }
        bf16_t* base = (bf16_t*)(ws + off); const int col0 = ct * BM + wc * 32 + 8 * fq;
#pragma unroll
        for (int ai = 0; ai < 2; ++ai)
#pragma unroll
            for (int m = 0; m < 4; ++m) { bf16_t* rowp = base + (size_t)(row0 + ai * HALF + m * 16) * ldc + col0;
#pragma unroll
                for (int bj = 0; bj < 2; ++bj) *(u32x4*)(rowp + bj * HALF) = pack8(acc[ai][bj][m][0] * sc, acc[ai][bj][m][1] * sc); }
    }
};
struct EpiBf {
    static constexpr bool PERM = true, AFTER_DRAIN = false;
    bf16_t* O; int ldc;
    __device__ __forceinline__ void operator()(const f32x4 (&acc)[2][2][4][2], const Unit& u, int wr, int wc, int fr, int fq) const {
        const int row0 = u.pm * BM + wr * 64 + fr, col0 = u.pn * BM + wc * 32 + 8 * fq;
#pragma unroll
        for (int ai = 0; ai < 2; ++ai)
#pragma unroll
            for (int m = 0; m < 4; ++m) { bf16_t* rowp = O + (size_t)(row0 + ai * HALF + m * 16) * ldc + col0;
#pragma unroll
                for (int bj = 0; bj < 2; ++bj) *(u32x4*)(rowp + bj * HALF) = pack8(acc[ai][bj][m][0], acc[ai][bj][m][1]); }
    }
};
template <int MODE> struct EpiEw {
    static constexpr bool PERM = true, AFTER_DRAIN = false;
    float* O32; bf16_t* Obf; const float* I32; const bf16_t* GATE; int ldc; float alpha;
    __device__ __forceinline__ void operator()(const f32x4 (&acc)[2][2][4][2], const Unit& u, int wr, int wc, int fr, int fq) const {
        const int row0 = u.pm * BM + wr * 64 + fr, col0 = u.pn * BM + wc * 32 + 8 * fq;
#pragma unroll
        for (int ai = 0; ai < 2; ++ai)
#pragma unroll
            for (int m = 0; m < 4; ++m) { const size_t ro = (size_t)(row0 + ai * HALF + m * 16) * ldc + col0;
#pragma unroll
                for (int bj = 0; bj < 2; ++bj) { const size_t o = ro + bj * HALF; f32x4 a0 = acc[ai][bj][m][0], a1 = acc[ai][bj][m][1];
                    if (MODE == 0) { *(f32x4*)(O32 + o) = a0; *(f32x4*)(O32 + o + 4) = a1; }
                    if (MODE == 1 || MODE == 2) { float g[8]; unpack8(*(const u32x4*)(GATE + o), g);
#pragma unroll
                        for (int j = 0; j < 4; ++j) { a0[j] *= fsigmoid(g[j]); a1[j] *= fsigmoid(g[4 + j]); }
                        if (MODE == 1) { *(f32x4*)(O32 + o) = a0; *(f32x4*)(O32 + o + 4) = a1; }
                        else { const f32x4 i0 = *(const f32x4*)(I32 + o), i1 = *(const f32x4*)(I32 + o + 4); *(u32x4*)(Obf + o) = pack8(a0 + i0, a1 + i1); } }
                    if (MODE == 3) { const f32x4 i0 = *(const f32x4*)(I32 + o), i1 = *(const f32x4*)(I32 + o + 4); *(f32x4*)(O32 + o) = i0 * alpha + a0; *(f32x4*)(O32 + o + 4) = i1 * alpha + a1; }
                    if (MODE == 4) { const f32x4 i0 = *(const f32x4*)(I32 + o), i1 = *(const f32x4*)(I32 + o + 4); f32x4 x0 = *(const f32x4*)(O32 + o), x1 = *(const f32x4*)(O32 + o + 4);
#pragma unroll
                        for (int j = 0; j < 4; ++j) { x0[j] += fsigmoid(a0[j]) * i0[j]; x1[j] += fsigmoid(a1[j]) * i1[j]; }
                        *(f32x4*)(O32 + o) = x0; *(f32x4*)(O32 + o + 4) = x1; }
                } }
    }
};
struct EpiUp {
    static constexpr bool PERM = true, AFTER_DRAIN = false;
    const bf16_t* G; bf16_t* H; const float* cw; const float* cb;
    __device__ __forceinline__ void operator()(const f32x4 (&acc)[2][2][4][2], const Unit& u, int wr, int wc, int fr, int fq) const {
        const int row0 = u.pm * BM + wr * 64 + fr;
#pragma unroll
        for (int bj = 0; bj < 2; ++bj) {
            const int c0 = u.pn * BM + bj * HALF + wc * 32 + 8 * fq;
            const f32x4 w0a = *(const f32x4*)(cw + c0), w0b = *(const f32x4*)(cw + c0 + 4), w1a = *(const f32x4*)(cw + FF + c0), w1b = *(const f32x4*)(cw + FF + c0 + 4);
            const f32x4 w2a = *(const f32x4*)(cw + 2 * FF + c0), w2b = *(const f32x4*)(cw + 2 * FF + c0 + 4), ba = *(const f32x4*)(cb + c0), bb = *(const f32x4*)(cb + c0 + 4);
#pragma unroll
            for (int ai = 0; ai < 2; ++ai)
#pragma unroll
                for (int m = 0; m < 4; ++m) {
                    const int r = row0 + ai * HALF + m * 16, t = r & (SEQ - 1);
                    const int r1 = t >= 1 ? r - 1 : r, r2 = t >= 2 ? r - 2 : r; const float f1 = t >= 1 ? 1.f : 0.f, f2 = t >= 2 ? 1.f : 0.f;
                    float g2[8], g1[8], g0[8];
                    unpack8(*(const u32x4*)(G + (size_t)r * FF + c0), g2); unpack8(*(const u32x4*)(G + (size_t)r1 * FF + c0), g1); unpack8(*(const u32x4*)(G + (size_t)r2 * FF + c0), g0);
                    f32x4 h0, h1;
#pragma unroll
                    for (int j = 0; j < 4; ++j) {
                        const float ca = ba[j] + w0a[j] * (g0[j] * f2) + w1a[j] * (g1[j] * f1) + w2a[j] * g2[j];
                        const float cb_ = bb[j] + w0b[j] * (g0[4 + j] * f2) + w1b[j] * (g1[4 + j] * f1) + w2b[j] * g2[4 + j];
                        const float ya = 1.5957691216057308f * (ca + 0.044715f * ca * ca * ca), yb = 1.5957691216057308f * (cb_ + 0.044715f * cb_ * cb_ * cb_);
                        h0[j] = ca * fsigmoid(ya) * acc[ai][bj][m][0][j]; h1[j] = cb_ * fsigmoid(yb) * acc[ai][bj][m][1][j];
                    }
                    *(u32x4*)(H + (size_t)r * FF + c0) = pack8(h0, h1);
                }
        }
    }
};

template <class Epi, class Sched, bool ALIGN_EPI = false, bool SP2 = false>
__device__ __forceinline__ void gemm_phase(PG8_LAS unsigned char* lds, const Gemm g, const Sched& S, const Epi& E) {
    const int tid = threadIdx.x, wid = __builtin_amdgcn_readfirstlane(tid >> 6), lane = tid & 63, wr = wid >> 2, wc = wid & 3, fr = lane & 15, fq = lane >> 4;
    const int K = g.K, nt = K / BK;
    unsigned voffA[2], voffB[2];
#pragma unroll
    for (int i = 0; i < 2; ++i) { int R, C; stage_rc(tid * 16 + i * 8192, R, C); const int Rb = Epi::PERM ? ((R & ~31) + perm32(R & 31)) : R;
        voffA[i] = (unsigned)(R * K + C) * 2u; voffB[i] = (unsigned)(Rb * K + C) * 2u; }
    const size_t kstep = (size_t)(BK * 2);
    const size_t hstep = (size_t)HALF * K * 2;
    const size_t tstep = 2 * hstep;
    const unsigned ldsw = (unsigned)wid * 1024u;
    const int aoff = lds_byte(wr * 64 + fr, fq * 8), boff = lds_byte(wc * 32 + fr, fq * 8);
#define PG8_SA(b, h) (((b) * 2 + (h)) * HTB)
#define PG8_SB(b, h) ((4 + (b) * 2 + (h)) * HTB)
#define PG8_STAGE(bufoff, gbase, voff) do { _Pragma("unroll") for (int _i = 0; _i < 2; ++_i) \
        __builtin_amdgcn_global_load_lds((const unsigned*)((const char*)(gbase) + (voff)[_i]), (PG8_LAS unsigned*)(lds + (bufoff) + ldsw + _i * 8192), 16, 0, 0); } while (0)
#define PG8_LDA(dst, b, h) do { _Pragma("unroll") for (int m = 0; m < 4; ++m) _Pragma("unroll") for (int k = 0; k < 2; ++k) dst[m][k] = *(const PG8_LAS bf16x8*)(lds + PG8_SA(b, h) + aoff + m * 2048 + k * 1024); } while (0)
#define PG8_LDB(dst, b, h) do { _Pragma("unroll") for (int n = 0; n < 2; ++n) _Pragma("unroll") for (int k = 0; k < 2; ++k) dst[n][k] = *(const PG8_LAS bf16x8*)(lds + PG8_SB(b, h) + boff + n * 2048 + k * 1024); } while (0)
#define PG8_MMA(ai, bj, At, Bt) do { __builtin_amdgcn_s_setprio(1); _Pragma("unroll") for (int m = 0; m < 4; ++m) _Pragma("unroll") for (int n = 0; n < 2; ++n) _Pragma("unroll") for (int k = 0; k < 2; ++k) \
        acc[ai][bj][m][n] = __builtin_amdgcn_mfma_f32_16x16x32_bf16(Bt[n][k], At[m][k], acc[ai][bj][m][n], 0, 0, 0); __builtin_amdgcn_s_setprio(0); } while (0)
#define PG8_WAIT_V(n) asm volatile("s_waitcnt vmcnt(" #n ")" ::: "memory")
#define PG8_WAIT_L(n) asm volatile("s_waitcnt lgkmcnt(" #n ")" ::: "memory")
#define PG8_BAR __builtin_amdgcn_s_barrier()
#define PG8_SCHED __builtin_amdgcn_sched_barrier(0)
    Unit cur, nxt; int ui = 0;
    if (!S.next(0, cur)) return;
    f32x4 acc[2][2][4][2];
#pragma unroll
    for (int a = 0; a < 2; ++a)
#pragma unroll
        for (int b = 0; b < 2; ++b)
#pragma unroll
            for (int m = 0; m < 4; ++m)
#pragma unroll
                for (int n = 0; n < 2; ++n) acc[a][b][m][n] = (f32x4){0.f, 0.f, 0.f, 0.f};
    bf16x8 At[4][2], B0[2][2], B1[2][2];
    const char* cA = (const char*)g.A + (size_t)cur.pm * tstep; const char* cB = (const char*)g.Bt + (size_t)cur.pn * tstep;
    S.a_ready(cur);
    if constexpr (SP2) {
        PG8_STAGE(PG8_SB(0, 0), cB, voffB); PG8_STAGE(PG8_SB(0, 1), cB + hstep, voffB); PG8_STAGE(PG8_SA(0, 0), cA, voffA); PG8_STAGE(PG8_SA(0, 1), cA + hstep, voffA);
        if (wr == 1) PG8_BAR;
        PG8_WAIT_V(2); PG8_BAR;
        PG8_STAGE(PG8_SB(1, 0), cB + kstep, voffB); PG8_STAGE(PG8_SA(1, 0), cA + kstep, voffA); PG8_STAGE(PG8_SB(1, 1), cB + hstep + kstep, voffB);
        PG8_WAIT_V(6); PG8_BAR;
    } else {
        PG8_STAGE(PG8_SB(0, 0), cB, voffB); PG8_STAGE(PG8_SA(0, 0), cA, voffA); PG8_STAGE(PG8_SB(0, 1), cB + hstep, voffB); PG8_STAGE(PG8_SA(0, 1), cA + hstep, voffA);
        if (wr == 1) PG8_BAR;
        PG8_WAIT_V(4); PG8_BAR;
        PG8_STAGE(PG8_SB(1, 0), cB + kstep, voffB); PG8_STAGE(PG8_SA(1, 0), cA + kstep, voffA); PG8_STAGE(PG8_SB(1, 1), cB + hstep + kstep, voffB);
        PG8_WAIT_V(6); PG8_BAR;
    }
    for (;;) {
        const bool has_next = S.next(ui + 1, nxt);
        const char* nA = has_next ? (const char*)g.A + (size_t)nxt.pm * tstep : cA; const char* nB = has_next ? (const char*)g.Bt + (size_t)nxt.pn * tstep : cB;
        for (int t = 0; t < nt; t += 2) {
            const bool last = (t == nt - 2);
            const char* a1 = cA + (size_t)(t + 1) * kstep;
            const char* a2 = last ? nA : cA + (size_t)(t + 2) * kstep; const char* b2 = last ? nB : cB + (size_t)(t + 2) * kstep;
            const char* a3 = a2 + kstep; const char* b3 = b2 + kstep;
            if (last && has_next) S.a_ready(nxt);
            if constexpr (SP2) {
            PG8_LDB(B0, 0, 0); PG8_LDB(B1, 0, 1); PG8_SCHED; PG8_LDA(At, 0, 0); PG8_STAGE(PG8_SA(1, 1), a1 + hstep, voffA);
            PG8_WAIT_V(8); PG8_WAIT_L(0); PG8_BAR; PG8_MMA(0, 0, At, B0); PG8_MMA(0, 1, At, B1); PG8_BAR; PG8_SCHED;
            PG8_LDA(At, 0, 1); PG8_STAGE(PG8_SB(0, 0), b2, voffB); PG8_STAGE(PG8_SB(0, 1), b2 + hstep, voffB); PG8_STAGE(PG8_SA(0, 0), a2, voffA);
            PG8_WAIT_V(8); PG8_WAIT_L(0); PG8_BAR; PG8_MMA(1, 0, At, B0); PG8_MMA(1, 1, At, B1); PG8_BAR; PG8_SCHED;
            PG8_LDB(B0, 1, 0); PG8_LDB(B1, 1, 1); PG8_SCHED; PG8_LDA(At, 1, 0); PG8_STAGE(PG8_SA(0, 1), a2 + hstep, voffA);
            PG8_WAIT_V(8); PG8_WAIT_L(0); PG8_BAR; PG8_MMA(0, 0, At, B0); PG8_MMA(0, 1, At, B1); PG8_BAR; PG8_SCHED;
            PG8_LDA(At, 1, 1); PG8_STAGE(PG8_SB(1, 0), b3, voffB); PG8_STAGE(PG8_SB(1, 1), b3 + hstep, voffB); PG8_STAGE(PG8_SA(1, 0), a3, voffA);
            PG8_WAIT_V(8); PG8_WAIT_L(0); PG8_BAR; PG8_MMA(1, 0, At, B0); PG8_MMA(1, 1, At, B1); PG8_BAR; PG8_SCHED;
            } else {
            PG8_LDB(B0, 0, 0); PG8_SCHED; PG8_LDA(At, 0, 0); PG8_STAGE(PG8_SA(1, 1), a1 + hstep, voffA);
            PG8_WAIT_L(8); PG8_BAR; PG8_WAIT_L(0); PG8_MMA(0, 0, At, B0); PG8_BAR; PG8_SCHED;
            PG8_LDB(B1, 0, 1); PG8_STAGE(PG8_SB(0, 0), b2, voffB);
            PG8_BAR; PG8_WAIT_L(0); PG8_MMA(0, 1, At, B1); PG8_BAR;
            PG8_LDA(At, 0, 1); PG8_STAGE(PG8_SA(0, 0), a2, voffA);
            PG8_BAR; PG8_WAIT_L(0); PG8_MMA(1, 0, At, B0); PG8_BAR; PG8_SCHED;
            PG8_STAGE(PG8_SB(0, 1), b2 + hstep, voffB);
            PG8_WAIT_V(6); PG8_BAR; PG8_MMA(1, 1, At, B1); PG8_BAR;
            PG8_LDB(B0, 1, 0); PG8_SCHED; PG8_LDA(At, 1, 0); PG8_STAGE(PG8_SA(0, 1), a2 + hstep, voffA);
            PG8_WAIT_L(8); PG8_BAR; PG8_WAIT_L(0); PG8_MMA(0, 0, At, B0); PG8_BAR; PG8_SCHED;
            PG8_LDB(B1, 1, 1); PG8_STAGE(PG8_SB(1, 0), b3, voffB);
            PG8_BAR; PG8_WAIT_L(0); PG8_MMA(0, 1, At, B1); PG8_BAR;
            PG8_LDA(At, 1, 1); PG8_STAGE(PG8_SA(1, 0), a3, voffA);
            PG8_BAR; PG8_WAIT_L(0); PG8_MMA(1, 0, At, B0); PG8_BAR; PG8_SCHED;
            PG8_STAGE(PG8_SB(1, 1), b3 + hstep, voffB);
            PG8_WAIT_V(6); PG8_BAR; PG8_MMA(1, 1, At, B1); PG8_BAR;
            }
        }
        if constexpr (ALIGN_EPI) { if (wr == 0) PG8_BAR; }
        if constexpr (!Epi::AFTER_DRAIN) { E(acc, cur, wr, wc, fr, fq); S.done(cur); }
        if (!has_next) break;
#pragma unroll
        for (int a = 0; a < 2; ++a)
#pragma unroll
            for (int b = 0; b < 2; ++b)
#pragma unroll
                for (int m = 0; m < 4; ++m)
#pragma unroll
                    for (int n = 0; n < 2; ++n) acc[a][b][m][n] = (f32x4){0.f, 0.f, 0.f, 0.f};
        cur = nxt; cA = nA; cB = nB; ++ui;
        if constexpr (ALIGN_EPI) { if (wr == 1) PG8_BAR; }
    }
    PG8_WAIT_V(0);
    if constexpr (!ALIGN_EPI) { if (wr == 0) PG8_BAR; }
    PG8_BAR;
    if constexpr (Epi::AFTER_DRAIN) { E.fused(acc, cur, wr, wc, fr, fq, lds, wid, lane); S.done(cur); }
#undef PG8_SA
#undef PG8_SB
#undef PG8_STAGE
#undef PG8_LDA
#undef PG8_LDB
#undef PG8_MMA
#undef PG8_WAIT_V
#undef PG8_WAIT_L
#undef PG8_BAR
#undef PG8_SCHED
}
}

typedef unsigned short bf16;
typedef float v4f __attribute__((ext_vector_type(4)));
typedef float v16f __attribute__((ext_vector_type(16)));
typedef unsigned v4u __attribute__((ext_vector_type(4)));
typedef unsigned v2u __attribute__((ext_vector_type(2)));
typedef short v8s __attribute__((ext_vector_type(8)));
#define RLX_AGENT __ATOMIC_RELAXED, __HIP_MEMORY_SCOPE_AGENT
template <class T> __device__ __forceinline__ T lds_ld(lds_t p, int off) { return *(const LAS T*)(p + off); }
template <class T> __device__ __forceinline__ void lds_st(lds_t p, int off, T v) { *(LAS T*)(p + off) = v; }
__device__ __forceinline__ unsigned cvtpk(float lo, float hi) { return pg8::cvt_pk_bf16(lo, hi); }
__device__ __forceinline__ float bf_lo(unsigned w) { return __uint_as_float(w << 16); }
__device__ __forceinline__ float bf_hi(unsigned w) { return __uint_as_float(w & 0xffff0000u); }
__device__ __forceinline__ float wave_sum(float v) {
#pragma unroll
    for (int o = 1; o < 64; o <<= 1) v += __shfl_xor(v, o);
    return v;
}
#define MFMA16(a, b, c) __builtin_amdgcn_mfma_f32_16x16x32_bf16((a), (b), (c), 0, 0, 0)
#define MFMA32(a, b, c) __builtin_amdgcn_mfma_f32_32x32x16_bf16((a), (b), (c), 0, 0, 0)

#define XB_TMO      128
#define XB_XCNT(j)  (256  + 64 * (j))
#define XB_XSUB(j)  (1280 + 64 * (j))
#define XB_XGEN(j)  (2304 + 64 * (j))
#define XB_TOP      3328
#define XB_TOPGEN   3392
#define XCD_BAR_WORDS 3456
#define XB_SPIN_CAP (1u << 22)
__device__ __forceinline__ unsigned xb_ld(unsigned* p)              { return __hip_atomic_load(p, __ATOMIC_RELAXED, __HIP_MEMORY_SCOPE_AGENT); }
__device__ __forceinline__ unsigned xb_add(unsigned* p, unsigned v) { return __hip_atomic_fetch_add(p, v, __ATOMIC_RELAXED, __HIP_MEMORY_SCOPE_AGENT); }
__device__ __forceinline__ unsigned xb_xcc_id() { return (unsigned)__builtin_amdgcn_s_getreg((3 << 11) | 20) & 0xFu; }
#define XB_SPIN(cond, bar) do { unsigned _sp = 0; while (cond) { __builtin_amdgcn_s_sleep(1); \
    if ((++_sp & 255u) == 0u) { if (xb_ld(&(bar)[XB_TMO])) break; if (_sp > XB_SPIN_CAP) { atomicAdd(&(bar)[XB_TMO], 1u); break; } } } } while (0)
struct XcdBarrier { unsigned* bar; unsigned x; volatile LAS unsigned* st; };
__device__ __forceinline__ XcdBarrier xcd_barrier_post(unsigned* bar, volatile LAS unsigned* st) {
    XcdBarrier b; b.bar = bar; b.x = xb_xcc_id(); b.st = st;
    if (threadIdx.x == 0) (void)xb_add(&bar[XB_XCNT(b.x)], 1u);
    return b;
}
__device__ __forceinline__ void xcd_barrier_complete(unsigned* bar, unsigned x, unsigned& nloc, unsigned& nx) {
    const unsigned G = gridDim.x * gridDim.y * gridDim.z;
    unsigned sum, cnt, mine, sp = 0u;
    for (;;) {
        sum = 0u; cnt = 0u; mine = 0u;
#pragma unroll
        for (unsigned j = 0; j < 16; ++j) { const unsigned c = xb_ld(&bar[XB_XCNT(j)]); sum += c; cnt += (c > 0u) ? 1u : 0u; mine = (j == x) ? c : mine; }
        if (sum == G) break;
        __builtin_amdgcn_s_sleep(1);
        if ((++sp & 255u) == 0u) { if (xb_ld(&bar[XB_TMO])) break; if (sp > XB_SPIN_CAP) { atomicAdd(&bar[XB_TMO], 1u); break; } }
    }
    nloc = mine > 0u ? mine : 1u; nx = cnt > 0u ? cnt : 1u;
}
__device__ __forceinline__ void xcd_barrier(const XcdBarrier& b) {
    asm volatile("s_waitcnt vmcnt(0)" ::: "memory");
    __syncthreads();
    if (threadIdx.x == 0) {
        unsigned* bar = b.bar;
        __builtin_amdgcn_s_waitcnt(0);
        unsigned nloc = b.st[0], nx = b.st[1];
        if (nloc == 0u) { xcd_barrier_complete(bar, b.x, nloc, nx); b.st[0] = nloc; b.st[1] = nx; }
        const unsigned old = xb_add(&bar[XB_XSUB(b.x)], 1u);
        const unsigned gen = old / nloc;
        if (old + 1u == (gen + 1u) * nloc) {
            __builtin_amdgcn_fence(__ATOMIC_RELEASE, "agent");
            asm volatile("s_waitcnt vmcnt(0)" ::: "memory");
            const unsigned og = xb_add(&bar[XB_TOP], 1u);
            const unsigned tg = og / nx;
            if (og + 1u == (tg + 1u) * nx) xb_add(&bar[XB_TOPGEN], 1u);
            else XB_SPIN(xb_ld(&bar[XB_TOPGEN]) == tg, bar);
            __builtin_amdgcn_fence(__ATOMIC_ACQUIRE, "agent");
            xb_add(&bar[XB_XGEN(b.x)], 1u);
            asm volatile("s_waitcnt vmcnt(0)" ::: "memory");
        } else {
            XB_SPIN(xb_ld(&bar[XB_XGEN(b.x)]) == gen, bar);
            __builtin_amdgcn_fence(__ATOMIC_ACQUIRE, "agent");
            asm volatile("s_waitcnt vmcnt(0)" ::: "memory");
        }
    }
    __syncthreads();
}

__device__ __forceinline__ void tr_item(const float* W, int K, int Nsrc, int scol, bf16* WT, int drow, int kb, lds_t scr, int lane) {
    const int k0 = 64 * kb;
#pragma unroll 8
    for (int i = 0; i < 32; ++i) { const int kk = 2 * i + (lane >> 5); lds_st<float>(scr, (kk * 33 + (lane & 31)) * 4, W[(size_t)(k0 + kk) * Nsrc + scol + (lane & 31)]); }
    asm volatile("s_waitcnt lgkmcnt(0)" ::: "memory");
    const int c = lane & 7;
#pragma unroll
    for (int j = 0; j < 4; ++j) { const int n = (lane >> 3) + 8 * j; const int so = ((8 * c) * 33 + n) * 4;
        v4u o; o.x = cvtpk(lds_ld<float>(scr, so), lds_ld<float>(scr, so + 33 * 4)); o.y = cvtpk(lds_ld<float>(scr, so + 2 * 33 * 4), lds_ld<float>(scr, so + 3 * 33 * 4));
        o.z = cvtpk(lds_ld<float>(scr, so + 4 * 33 * 4), lds_ld<float>(scr, so + 5 * 33 * 4)); o.w = cvtpk(lds_ld<float>(scr, so + 6 * 33 * 4), lds_ld<float>(scr, so + 7 * 33 * 4));
        *(v4u*)(WT + (size_t)(drow + n) * K + k0 + 8 * c) = o; }
    asm volatile("s_waitcnt lgkmcnt(0)" ::: "memory");
}
__device__ __forceinline__ void tr_mat(const float* W, int K, int N, bf16* WT, int r, lds_t scr, int lane) { const int nblk = N / 32, kb = r / nblk, nb = r % nblk; tr_item(W, K, N, 32 * nb, WT, 32 * nb, kb, scr, lane); }

__device__ __forceinline__ void p0_prologue(lds_t lds, const float* const* in, unsigned char* ws, int G) {
    const int tid = threadIdx.x, lane = tid & 63, wave = tid >> 6;
    lds_t scr = lds + wave * 16384;
    const int gw = blockIdx.x * 8 + wave, NGW = G * 8;
    constexpr int I_WIN = 32 * 416, I_BG = 32 * 64, I_BF = 16 * 64, I_OUT = 32 * 64, I_G = 32 * 176, I_U = I_G, I_D = 88 * 64, I_PG = 32 * 64, I_PP = 4 * 64;
    constexpr int NITEMS = I_WIN + I_BG + I_BF + I_OUT + I_G + I_U + I_D + I_PG + I_PP;
    for (int it = gw; it < NITEMS; it += NGW) {
        int r = it;
        if (r < I_WIN) { const int kb = r / 416, nb = r % 416, drow = 32 * nb; const int scol = drow + (drow >= 6144 ? 16 : 0) + (drow >= 9216 ? 8 : 0);
            tr_item(in[2], 2048, N_IN, scol, (bf16*)(ws + WS_WIN), drow, kb, scr, lane); continue; } r -= I_WIN;
        if (r < I_BG) { tr_mat(in[7], 2048, 2048, (bf16*)(ws + WS_WBG), r, scr, lane); continue; } r -= I_BG;
        if (r < I_BF) { tr_mat(in[8], 1024, 2048, (bf16*)(ws + WS_WBF), r, scr, lane); continue; } r -= I_BF;
        if (r < I_OUT) { tr_mat(in[9], 2048, 2048, (bf16*)(ws + WS_WOUT), r, scr, lane); continue; } r -= I_OUT;
        if (r < I_G) { tr_mat(in[12], 2048, FF, (bf16*)(ws + WS_WG), r, scr, lane); continue; } r -= I_G;
        if (r < I_U) { tr_mat(in[13], 2048, FF, (bf16*)(ws + WS_WU), r, scr, lane); continue; } r -= I_U;
        if (r < I_D) { tr_mat(in[16], FF, 2048, (bf16*)(ws + WS_WD), r, scr, lane); continue; } r -= I_D;
        if (r < I_PG) { tr_mat(in[19], 2048, 2048, (bf16*)(ws + WS_WPG), r, scr, lane); continue; } r -= I_PG;
        tr_mat(in[20], PLE, 2048, (bf16*)(ws + WS_WPP), r, scr, lane);
    }
    const int gt = blockIdx.x * 512 + tid, NT = G * 512;
    { const float* win = in[2]; bf16* WT = (bf16*)(ws + WS_WIN);
      for (int i = gt; i < 256 * 256; i += NT) { const int j = i >> 8, kc = (i & 255) * 8; v4u o = (v4u){0u, 0u, 0u, 0u};
          if (j < 24) { const int sc = j < 16 ? 6144 + j : 9232 + (j - 16); float f[8];
#pragma unroll
              for (int e = 0; e < 8; ++e) f[e] = win[(size_t)(kc + e) * N_IN + sc];
              o.x = cvtpk(f[0], f[1]); o.y = cvtpk(f[2], f[3]); o.z = cvtpk(f[4], f[5]); o.w = cvtpk(f[6], f[7]); }
          *(v4u*)(WT + (size_t)(13312 + j) * 2048 + kc) = o; } }
    { const float* x = in[0]; bf16* XB = (bf16*)(ws + WS_XB);
      for (int i = gt; i < MTOK * DM / 8; i += NT) { const v4f a = *(const v4f*)(x + (size_t)i * 8), b = *(const v4f*)(x + (size_t)i * 8 + 4);
          v4u o; o.x = cvtpk(a[0], a[1]); o.y = cvtpk(a[2], a[3]); o.z = cvtpk(b[0], b[1]); o.w = cvtpk(b[2], b[3]); *(v4u*)(XB + (size_t)i * 8) = o; } }
    { const float* p = in[1]; bf16* PB = (bf16*)(ws + WS_PB);
      for (int i = gt; i < MTOK * PLE / 8; i += NT) { const v4f a = *(const v4f*)(p + (size_t)i * 8), b = *(const v4f*)(p + (size_t)i * 8 + 4);
          v4u o; o.x = cvtpk(a[0], a[1]); o.y = cvtpk(a[2], a[3]); o.z = cvtpk(b[0], b[1]); o.w = cvtpk(b[2], b[3]); *(v4u*)(PB + (size_t)i * 8) = o; } }
}

__device__ __forceinline__ void gla_prep_item(lds_t lds, int item, const unsigned char* ws, const float* wlr, const float* blr, int tid) {
    const bf16* GQ = (const bf16*)(ws + WS_GQ); const bf16* GK = (const bf16*)(ws + WS_GK); const bf16* GV = (const bf16*)(ws + WS_GV); const float* SM = (const float*)(ws + WS_SM);
    bf16* QT = (bf16*)(ws + WS_QT); bf16* KT = (bf16*)(ws + WS_KT); bf16* VT = (bf16*)(ws + WS_VT); bf16* ATT = (bf16*)(ws + WS_ATT); float* DEC = (float*)(ws + WS_DEC);
    const int c = item & 63, bh = item >> 6, h = bh & 3, b = bh >> 2;
    const size_t tok0 = (size_t)b * SEQ + 64 * c;
    constexpr int L_BC = 0, L_TOT = 65536, L_GLR = 67584, L_QS = 71680, L_KS = 105472, QROW = 528;
    const int lane = tid & 63, wid = tid >> 6, l15 = lane & 15, q4 = lane >> 4;
    __syncthreads();
    if (tid < 256) { const int row = tid >> 2, quad = tid & 3; const v4f v = *(const v4f*)(SM + (tok0 + row) * 32 + quad * 4); lds_st<v4f>(lds, L_GLR + (row * 16 + quad * 4) * 4, v); }
    const int k = tid & 255, half = tid >> 8;
    float w[16];
#pragma unroll
    for (int r = 0; r < 16; ++r) w[r] = wlr[r * 1024 + h * 256 + k];
    const float bias = blr[h * 256 + k];
    __syncthreads();
    float run = 0.f;
    for (int tt = 0; tt < 32; ++tt) { const int t = half * 32 + tt; float z = bias;
#pragma unroll
        for (int r4 = 0; r4 < 4; ++r4) { const v4f g = lds_ld<v4f>(lds, L_GLR + (t * 16 + r4 * 4) * 4); z += g[0] * w[4 * r4] + g[1] * w[4 * r4 + 1] + g[2] * w[4 * r4 + 2] + g[3] * w[4 * r4 + 3]; }
        const float ls = fminf(z, 0.f) - log1pf(expf(-fabsf(z)));
        run += ls * 0.0625f;
        lds_st<float>(lds, L_BC + (t * 256 + k) * 4, run); }
    lds_st<float>(lds, L_TOT + (half * 256 + k) * 4, run);
    __syncthreads();
    if (tid < 256) DEC[(size_t)item * 256 + tid] = expf(lds_ld<float>(lds, L_TOT + tid * 4) + lds_ld<float>(lds, L_TOT + (256 + tid) * 4));
#pragma unroll 1
    for (int i = 0; i < 4; ++i) { const int idx = tid + 512 * i, t = idx >> 5, kc = (idx & 31) * 8;
        const v4u qv = *(const v4u*)(GQ + (tok0 + t) * 1024 + h * 256 + kc), kv = *(const v4u*)(GK + (tok0 + t) * 1024 + h * 256 + kc);
        v4f b0 = lds_ld<v4f>(lds, L_BC + (t * 256 + kc) * 4), b1 = lds_ld<v4f>(lds, L_BC + (t * 256 + kc + 4) * 4);
        if (t >= 32) { b0 += lds_ld<v4f>(lds, L_TOT + kc * 4); b1 += lds_ld<v4f>(lds, L_TOT + (kc + 4) * 4); }
        float qq[8], kk[8], bc[8];
#pragma unroll
        for (int j = 0; j < 4; ++j) { qq[2 * j] = bf_lo(qv[j]); qq[2 * j + 1] = bf_hi(qv[j]); kk[2 * j] = bf_lo(kv[j]); kk[2 * j + 1] = bf_hi(kv[j]); bc[j] = b0[j]; bc[4 + j] = b1[j]; }
#pragma unroll
        for (int j = 0; j < 8; ++j) { qq[j] = qq[j] * expf(bc[j]) * 0.0625f; kk[j] = kk[j] * expf(-bc[j]); }
        v4u qp, kp; qp.x = cvtpk(qq[0], qq[1]); qp.y = cvtpk(qq[2], qq[3]); qp.z = cvtpk(qq[4], qq[5]); qp.w = cvtpk(qq[6], qq[7]);
        kp.x = cvtpk(kk[0], kk[1]); kp.y = cvtpk(kk[2], kk[3]); kp.z = cvtpk(kk[4], kk[5]); kp.w = cvtpk(kk[6], kk[7]);
        *(v4u*)(QT + (size_t)item * 16384 + t * 256 + kc) = qp;
        lds_st<v4u>(lds, L_QS + t * QROW + kc * 2, qp); lds_st<v4u>(lds, L_KS + t * QROW + kc * 2, kp); }
    __syncthreads();
#pragma unroll 1
    for (int i = 0; i < 4; ++i) { const int idx = tid + 512 * i, kk = idx >> 3, sc = (idx & 7) * 8; unsigned e[8];
#pragma unroll
        for (int j = 0; j < 8; ++j) e[j] = lds_ld<unsigned short>(lds, L_KS + (sc + j) * QROW + kk * 2);
        v4u o; o.x = e[0] | (e[1] << 16); o.y = e[2] | (e[3] << 16); o.z = e[4] | (e[5] << 16); o.w = e[6] | (e[7] << 16);
        *(v4u*)(KT + (size_t)item * 16384 + kk * 64 + sc) = o; }
    { const int mt = wid >> 1;
#pragma unroll
      for (int nn = 0; nn < 2; ++nn) { const int nt = (wid & 1) * 2 + nn; v4f acc = (v4f){0.f, 0.f, 0.f, 0.f};
          if (nt <= mt) {
#pragma unroll
              for (int ks = 0; ks < 8; ++ks) { const v8s a = lds_ld<v8s>(lds, L_QS + (16 * mt + l15) * QROW + (32 * ks + 8 * q4) * 2), bb = lds_ld<v8s>(lds, L_KS + (16 * nt + l15) * QROW + (32 * ks + 8 * q4) * 2); acc = MFMA16(a, bb, acc); } }
#pragma unroll
          for (int r = 0; r < 4; ++r) { const int t = 16 * mt + 4 * q4 + r, s = 16 * nt + l15; const float v = (s <= t) ? acc[r] : 0.f; ATT[(size_t)item * 4096 + t * 64 + s] = (bf16)(cvtpk(v, 0.f) & 0xffffu); } } }
    __syncthreads();
#pragma unroll 1
    for (int i = 0; i < 8; ++i) { const int idx = tid + 512 * i, s = idx >> 6, vc = (idx & 63) * 8; const v4u vv = *(const v4u*)(GV + (tok0 + s) * 2048 + h * 512 + vc);
#pragma unroll
        for (int j = 0; j < 4; ++j) { lds_st<unsigned short>(lds, (vc + 2 * j) * 132 + s * 2, (unsigned short)(vv[j] & 0xffffu)); lds_st<unsigned short>(lds, (vc + 2 * j + 1) * 132 + s * 2, (unsigned short)(vv[j] >> 16)); } }
    __syncthreads();
#pragma unroll 1
    for (int i = 0; i < 8; ++i) { const int idx = tid + 512 * i, v = idx >> 3, c8 = idx & 7; v4u o;
        o.x = lds_ld<unsigned>(lds, v * 132 + c8 * 16); o.y = lds_ld<unsigned>(lds, v * 132 + c8 * 16 + 4); o.z = lds_ld<unsigned>(lds, v * 132 + c8 * 16 + 8); o.w = lds_ld<unsigned>(lds, v * 132 + c8 * 16 + 12);
        *(v4u*)(VT + (size_t)item * 32768 + v * 64 + c8 * 8) = o; }
}
__device__ __forceinline__ void fv_tr_item(lds_t lds, int item, const unsigned char* ws, int tid) {
    const bf16* FV = (const bf16*)(ws + WS_FV); bf16* FVT = (bf16*)(ws + WS_FVT);
    const int bh = item >> 6, tt = item & 63, b = bh >> 3, h = bh & 7;
    __syncthreads();
#pragma unroll
    for (int i = 0; i < 2; ++i) { const int idx = tid + 512 * i, s = idx >> 4, dc = (idx & 15) * 8; const v4u vv = *(const v4u*)(FV + ((size_t)b * SEQ + 64 * tt + s) * 1024 + h * 128 + dc);
#pragma unroll
        for (int j = 0; j < 4; ++j) { lds_st<unsigned short>(lds, (dc + 2 * j) * 132 + s * 2, (unsigned short)(vv[j] & 0xffffu)); lds_st<unsigned short>(lds, (dc + 2 * j + 1) * 132 + s * 2, (unsigned short)(vv[j] >> 16)); } }
    __syncthreads();
#pragma unroll
    for (int i = 0; i < 2; ++i) { const int idx = tid + 512 * i, d = idx >> 3, c8 = idx & 7; v4u o;
        o.x = lds_ld<unsigned>(lds, d * 132 + c8 * 16); o.y = lds_ld<unsigned>(lds, d * 132 + c8 * 16 + 4); o.z = lds_ld<unsigned>(lds, d * 132 + c8 * 16 + 8); o.w = lds_ld<unsigned>(lds, d * 132 + c8 * 16 + 12);
        *(v4u*)(FVT + ((size_t)bh * 128 + d) * SEQ + 64 * tt + c8 * 8) = o; }
}
__device__ __forceinline__ void fox_cumsum_item(lds_t lds, int bh, const unsigned char* ws, const float* bfg, int tid) {
    const float* SM = (const float*)(ws + WS_SM); float* CB = (float*)(ws + WS_CB);
    const int b = bh >> 3, h = bh & 7, lane = tid & 63, wid = tid >> 6; const float bf = bfg[h];
    __syncthreads();
    float v[8]; float run = 0.f;
#pragma unroll
    for (int j = 0; j < 8; ++j) { const float z = SM[((size_t)b * SEQ + tid * 8 + j) * 32 + 16 + h] + bf; run += fminf(z, 0.f) - log1pf(expf(-fabsf(z))); v[j] = run; }
    float inc = run;
#pragma unroll
    for (int o = 1; o < 64; o <<= 1) { const float n = __shfl_up(inc, o); if (lane >= o) inc += n; }
    if (lane == 63) lds_st<float>(lds, wid * 4, inc);
    __syncthreads();
    float pre = inc - run;
    for (int w2 = 0; w2 < wid; ++w2) pre += lds_ld<float>(lds, w2 * 4);
#pragma unroll
    for (int j = 0; j < 8; ++j) CB[(size_t)bh * SEQ + tid * 8 + j] = -LOG2E * (pre + v[j]);
}

__device__ __forceinline__ void gla_scan_item(lds_t lds, int item, const unsigned char* ws, int tid) {
    const bf16* QT = (const bf16*)(ws + WS_QT); const bf16* KT = (const bf16*)(ws + WS_KT); const bf16* VT = (const bf16*)(ws + WS_VT); const bf16* ATT = (const bf16*)(ws + WS_ATT); const float* DEC = (const float*)(ws + WS_DEC);
    float* ORAW = (float*)(ws + WS_ORAW);
    const int vq = item & 3, bh4 = item >> 2, h = bh4 & 3, b = bh4 >> 2;
    const int lane = tid & 63, wid = tid >> 6, l15 = lane & 15, q4 = lane >> 4;
    constexpr int QROW = 528, KROW = 144, L_Q = 0, L_K = 33792, L_A = 33792 + 36864, L_D = L_A + 9216;
    const int vcol = 128 * vq + 16 * wid + l15;
    v4f S[16];
#pragma unroll
    for (int i = 0; i < 16; ++i) S[i] = (v4f){0.f, 0.f, 0.f, 0.f};
    v4u pq[4], pk[4], pa, pvf[2]; v4f pd;
#define GS_PREFETCH(cc) do { const size_t it_ = (size_t)bh4 * 64 + (cc); \
        _Pragma("unroll") for (int i = 0; i < 4; ++i) { const int idx = tid + 512 * i; pq[i] = *(const v4u*)(QT + it_ * 16384 + idx * 8); pk[i] = *(const v4u*)(KT + it_ * 16384 + idx * 8); } \
        pa = *(const v4u*)(ATT + it_ * 4096 + tid * 8); if (tid < 64) pd = *(const v4f*)(DEC + it_ * 256 + tid * 4); \
        _Pragma("unroll") for (int kk = 0; kk < 2; ++kk) pvf[kk] = *(const v4u*)(VT + (it_ * 512 + vcol) * 64 + 32 * kk + 8 * q4); } while (0)
    GS_PREFETCH(0);
    for (int c = 0; c < 64; ++c) {
        __syncthreads();
#pragma unroll
        for (int i = 0; i < 4; ++i) { const int idx = tid + 512 * i; lds_st<v4u>(lds, L_Q + (idx >> 5) * QROW + (idx & 31) * 16, pq[i]); lds_st<v4u>(lds, L_K + (idx >> 3) * KROW + (idx & 7) * 16, pk[i]); }
        lds_st<v4u>(lds, L_A + (tid >> 3) * KROW + (tid & 7) * 16, pa);
        if (tid < 64) lds_st<v4f>(lds, L_D + tid * 16, pd);
        v8s vf[2]; vf[0] = __builtin_bit_cast(v8s, pvf[0]); vf[1] = __builtin_bit_cast(v8s, pvf[1]);
        __syncthreads();
        if (c + 1 < 64) GS_PREFETCH(c + 1);
        v4f o[4];
#pragma unroll
        for (int mt = 0; mt < 4; ++mt) o[mt] = (v4f){0.f, 0.f, 0.f, 0.f};
#pragma unroll
        for (int ks = 0; ks < 8; ++ks) {
            v4u bw; bw.x = cvtpk(S[2 * ks][0], S[2 * ks][1]); bw.y = cvtpk(S[2 * ks][2], S[2 * ks][3]); bw.z = cvtpk(S[2 * ks + 1][0], S[2 * ks + 1][1]); bw.w = cvtpk(S[2 * ks + 1][2], S[2 * ks + 1][3]);
            const v8s bfr = __builtin_bit_cast(v8s, bw);
#pragma unroll
            for (int mt = 0; mt < 4; ++mt) { const v2u lo = lds_ld<v2u>(lds, L_Q + (16 * mt + l15) * QROW + (32 * ks + 4 * q4) * 2), hi = lds_ld<v2u>(lds, L_Q + (16 * mt + l15) * QROW + (32 * ks + 16 + 4 * q4) * 2);
                const v4u aw = (v4u){lo.x, lo.y, hi.x, hi.y}; o[mt] = MFMA16(__builtin_bit_cast(v8s, aw), bfr, o[mt]); }
        }
#pragma unroll
        for (int kk = 0; kk < 2; ++kk)
#pragma unroll
            for (int mt = 0; mt < 4; ++mt) { const v8s a = lds_ld<v8s>(lds, L_A + (16 * mt + l15) * KROW + (32 * kk + 8 * q4) * 2); o[mt] = MFMA16(a, vf[kk], o[mt]); }
        { float* op = ORAW + ((size_t)b * SEQ + 64 * c) * 2048 + h * 512 + vcol;
#pragma unroll
          for (int mt = 0; mt < 4; ++mt)
#pragma unroll
              for (int r = 0; r < 4; ++r) op[(size_t)(16 * mt + 4 * q4 + r) * 2048] = o[mt][r]; }
#pragma unroll
        for (int kt = 0; kt < 16; ++kt) { v4f acc = S[kt];
#pragma unroll
            for (int kk = 0; kk < 2; ++kk) { const v8s a = lds_ld<v8s>(lds, L_K + (16 * kt + l15) * KROW + (32 * kk + 8 * q4) * 2); acc = MFMA16(a, vf[kk], acc); }
            const v4f dc = lds_ld<v4f>(lds, L_D + (16 * kt + 4 * q4) * 4); S[kt] = acc * dc; }
    }
#undef GS_PREFETCH
}

__device__ __forceinline__ void fox_unit(lds_t lds, int bh, int qi, const unsigned char* ws, int tid) {
    const bf16* FQ = (const bf16*)(ws + WS_FQ); const bf16* FK = (const bf16*)(ws + WS_FK); const bf16* FVT = (const bf16*)(ws + WS_FVT); const float* CB = (const float*)(ws + WS_CB); bf16* OF = (bf16*)(ws + WS_OF);
    const int lane = tid & 63, wid = tid >> 6, r32 = lane & 31, hi = lane >> 5, rg = wid & 3, par = wid >> 2;
    const int b = bh >> 3, h = bh & 7; const size_t rowbase = (size_t)b * SEQ; const int q0 = qi * 128;
    constexpr int KROW = 272, VROW = 136, TILEB = 17408, L_V0 = 2 * TILEB;
    const size_t qrow = rowbase + q0 + 32 * rg + r32;
    constexpr int L_QF = 4 * TILEB;
#pragma unroll
    for (int i = 0; i < 4; ++i) { const int idx = tid + 512 * i; lds_st<v4u>(lds, L_QF + (idx >> 4) * KROW + (idx & 15) * 16, *(const v4u*)(FQ + (rowbase + q0 + (idx >> 4)) * 1024 + h * 128 + (idx & 15) * 8)); }
    const int qb = L_QF + (32 * rg + r32) * KROW + 16 * hi;
    v16f o[4];
#pragma unroll
    for (int d = 0; d < 4; ++d)
#pragma unroll
        for (int r = 0; r < 16; ++r) o[d][r] = 0.f;
    const float NEG = -__builtin_inff();
    float m = NEG, l = 0.f;
    const int niter = qi + 1;
    v4u pk[4], pv[4];
#define FX_PREFETCH(it) do { \
        _Pragma("unroll") for (int i = 0; i < 4; ++i) { const int idx = tid + 512 * i, tile = idx >> 10; \
            pk[i] = *(const v4u*)(FK + (rowbase + (size_t)(2 * (it) + tile) * 64 + ((idx >> 4) & 63)) * 1024 + h * 128 + (idx & 15) * 8); \
            pv[i] = *(const v4u*)(FVT + ((size_t)bh * 128 + ((idx >> 3) & 127)) * SEQ + (2 * (it) + tile) * 64 + (idx & 7) * 8); } } while (0)
    FX_PREFETCH(0);
    for (int it = 0; it < niter; ++it) {
        __syncthreads();
#pragma unroll
        for (int i = 0; i < 4; ++i) { const int idx = tid + 512 * i, tile = idx >> 10;
            lds_st<v4u>(lds, tile * TILEB + ((idx >> 4) & 63) * KROW + (idx & 15) * 16, pk[i]);
            const int vo = L_V0 + tile * TILEB + ((idx >> 3) & 127) * VROW + (idx & 7) * 16;
            lds_st<v2u>(lds, vo, (v2u){pv[i].x, pv[i].y}); lds_st<v2u>(lds, vo + 8, (v2u){pv[i].z, pv[i].w}); }
        __syncthreads();
        if (it + 1 < niter) FX_PREFETCH(it + 1);
        const int ks0 = (2 * it + par) * 64;
        if (ks0 <= q0 + 32 * rg) {
            v16f s0, s1;
            { const float* cb = CB + (size_t)bh * SEQ + ks0 + 4 * hi;
#pragma unroll
              for (int g = 0; g < 4; ++g) { const v4f b0 = *(const v4f*)(cb + 8 * g), b1 = *(const v4f*)(cb + 32 + 8 * g);
#pragma unroll
                  for (int j = 0; j < 4; ++j) { s0[4 * g + j] = b0[j]; s1[4 * g + j] = b1[j]; } } }
            const int kb = par * TILEB + r32 * KROW + 16 * hi;
#pragma unroll
            for (int s = 0; s < 8; ++s) { const v8s a0 = lds_ld<v8s>(lds, kb + 32 * s), a1 = lds_ld<v8s>(lds, kb + 32 * KROW + 32 * s), qv = lds_ld<v8s>(lds, qb + 32 * s); s0 = MFMA32(a0, qv, s0); s1 = MFMA32(a1, qv, s1); }
            if (ks0 + 63 > q0 + 32 * rg) { const int qabs = q0 + 32 * rg + r32;
#pragma unroll
                for (int r = 0; r < 16; ++r) { const int kv = ks0 + (r & 3) + 8 * (r >> 2) + 4 * hi; if (kv > qabs) s0[r] = NEG; if (kv + 32 > qabs) s1[r] = NEG; } }
            float rm = fmaxf(s0[0], s1[0]);
#pragma unroll
            for (int r = 1; r < 16; ++r) rm = fmaxf(rm, fmaxf(s0[r], s1[r]));
            rm = fmaxf(rm, __shfl_xor(rm, 32));
            const float mn = fmaxf(m, rm), alpha = __builtin_amdgcn_exp2f(m - mn); m = mn;
            float ps = 0.f;
#pragma unroll
            for (int r = 0; r < 16; ++r) { s0[r] = __builtin_amdgcn_exp2f(s0[r] - mn); s1[r] = __builtin_amdgcn_exp2f(s1[r] - mn); ps += s0[r] + s1[r]; }
            l = l * alpha + ps;
#pragma unroll
            for (int d = 0; d < 4; ++d)
#pragma unroll
                for (int r = 0; r < 16; ++r) o[d][r] *= alpha;
            v8s pf[4];
            { v4u w;
              w.x = cvtpk(s0[0], s0[1]); w.y = cvtpk(s0[2], s0[3]); w.z = cvtpk(s0[4], s0[5]); w.w = cvtpk(s0[6], s0[7]); pf[0] = __builtin_bit_cast(v8s, w);
              w.x = cvtpk(s0[8], s0[9]); w.y = cvtpk(s0[10], s0[11]); w.z = cvtpk(s0[12], s0[13]); w.w = cvtpk(s0[14], s0[15]); pf[1] = __builtin_bit_cast(v8s, w);
              w.x = cvtpk(s1[0], s1[1]); w.y = cvtpk(s1[2], s1[3]); w.z = cvtpk(s1[4], s1[5]); w.w = cvtpk(s1[6], s1[7]); pf[2] = __builtin_bit_cast(v8s, w);
              w.x = cvtpk(s1[8], s1[9]); w.y = cvtpk(s1[10], s1[11]); w.z = cvtpk(s1[12], s1[13]); w.w = cvtpk(s1[14], s1[15]); pf[3] = __builtin_bit_cast(v8s, w); }
            const int vb = L_V0 + par * TILEB + r32 * VROW + 8 * hi;
#pragma unroll
            for (int d = 0; d < 4; ++d)
#pragma unroll
                for (int kk = 0; kk < 4; ++kk) { const v2u lo = lds_ld<v2u>(lds, vb + 32 * d * VROW + 32 * kk), hh = lds_ld<v2u>(lds, vb + 32 * d * VROW + 32 * kk + 16);
                    const v4u aw = (v4u){lo.x, lo.y, hh.x, hh.y}; o[d] = MFMA32(__builtin_bit_cast(v8s, aw), pf[kk], o[d]); }
        }
    }
#undef FX_PREFETCH
    l += __shfl_xor(l, 32);
    __syncthreads();
    constexpr int L_ML = 65536;
    if (par == 1) {
#pragma unroll
        for (int d = 0; d < 4; ++d)
#pragma unroll
            for (int r = 0; r < 16; ++r) lds_st<float>(lds, ((rg * 64 + d * 16 + r) * 64 + lane) * 4, o[d][r]);
        lds_st<float>(lds, L_ML + (rg * 128 + lane) * 4, m); lds_st<float>(lds, L_ML + (rg * 128 + 64 + lane) * 4, l);
    }
    __syncthreads();
    if (par == 0) {
        const float m1 = lds_ld<float>(lds, L_ML + (rg * 128 + lane) * 4), l1 = lds_ld<float>(lds, L_ML + (rg * 128 + 64 + lane) * 4);
        const float mt = fmaxf(m, m1), a0 = __builtin_amdgcn_exp2f(m - mt), a1 = __builtin_amdgcn_exp2f(m1 - mt);
        const float inv = 1.0f / (l * a0 + l1 * a1);
        bf16* op = OF + qrow * 1024 + h * 128 + 4 * hi;
#pragma unroll
        for (int d = 0; d < 4; ++d)
#pragma unroll
            for (int g = 0; g < 4; ++g) { float v[4];
#pragma unroll
                for (int j = 0; j < 4; ++j) v[j] = (o[d][4 * g + j] * a0 + lds_ld<float>(lds, ((rg * 64 + d * 16 + 4 * g + j) * 64 + lane) * 4) * a1) * inv;
                *(v2u*)(op + 32 * d + 8 * g) = (v2u){cvtpk(v[0], v[1]), cvtpk(v[2], v[3])}; }
    }
}

__device__ __forceinline__ void gla_norm_pass(unsigned char* ws, const float* gng, int G) {
    const float* ORAW = (const float*)(ws + WS_ORAW); bf16* GR = (bf16*)(ws + WS_GR);
    const int lane = threadIdx.x & 63; const int gw = blockIdx.x * 8 + (threadIdx.x >> 6), NGW = G * 8;
    for (int it = gw; it < MTOK * 4; it += NGW) {
        const size_t off = (size_t)it * 512 + lane * 8;
        const v4f a = *(const v4f*)(ORAW + off), b = *(const v4f*)(ORAW + off + 4);
        float ss = (a[0] * a[0] + a[1] * a[1]) + (a[2] * a[2] + a[3] * a[3]) + (b[0] * b[0] + b[1] * b[1]) + (b[2] * b[2] + b[3] * b[3]);
        ss = wave_sum(ss);
        const float rstd = 1.0f / sqrtf(ss * (1.0f / 512.0f) + RMS_EPS);
        const v4u gw4 = *(const v4u*)(GR + off); const v4f g0 = *(const v4f*)(gng + lane * 8), g1 = *(const v4f*)(gng + lane * 8 + 4);
        float gr[8];
#pragma unroll
        for (int j = 0; j < 4; ++j) { gr[2 * j] = bf_lo(gw4[j]); gr[2 * j + 1] = bf_hi(gw4[j]); }
        float r[8];
#pragma unroll
        for (int j = 0; j < 4; ++j) { r[j] = a[j] * rstd * g0[j] * (gr[j] * pg8::fsigmoid(gr[j])); r[4 + j] = b[j] * rstd * g1[j] * (gr[4 + j] * pg8::fsigmoid(gr[4 + j])); }
        v4u o; o.x = cvtpk(r[0], r[1]); o.y = cvtpk(r[2], r[3]); o.z = cvtpk(r[4], r[5]); o.w = cvtpk(r[6], r[7]);
        *(v4u*)(GR + off) = o;
    }
}
__device__ __forceinline__ void ln_pass(const float* src, float* dst, bf16* dstb, const float* g, const float* bta, int G) {
    const int lane = threadIdx.x & 63; const int gw = blockIdx.x * 8 + (threadIdx.x >> 6), NGW = G * 8;
    for (int row = gw; row < MTOK; row += NGW) {
        const float* xr = src + (size_t)row * DM + lane * 4;
        v4f v[8]; float s = 0.f;
#pragma unroll
        for (int j = 0; j < 8; ++j) { v[j] = *(const v4f*)(xr + 256 * j); s += (v[j][0] + v[j][1]) + (v[j][2] + v[j][3]); }
        const float mean = wave_sum(s) * (1.0f / DM); float s2 = 0.f;
#pragma unroll
        for (int j = 0; j < 8; ++j) { v[j] = v[j] - mean; s2 += (v[j][0] * v[j][0] + v[j][1] * v[j][1]) + (v[j][2] * v[j][2] + v[j][3] * v[j][3]); }
        const float rstd = 1.0f / sqrtf(wave_sum(s2) * (1.0f / DM) + LN_EPS);
#pragma unroll
        for (int j = 0; j < 8; ++j) { const v4f gg = *(const v4f*)(g + lane * 4 + 256 * j), bb = *(const v4f*)(bta + lane * 4 + 256 * j); const v4f y = v[j] * rstd * gg + bb;
            *(v4f*)(dst + (size_t)row * DM + lane * 4 + 256 * j) = y;
            *(v2u*)(dstb + (size_t)row * DM + lane * 4 + 256 * j) = (v2u){cvtpk(y[0], y[1]), cvtpk(y[2], y[3])}; }
    }
}

#ifndef PH
#define PH 0xFFFF
#endif
struct Args { const float* in[21]; float* out; unsigned char* ws; };
__global__ void __launch_bounds__(512, 2) mega_fwd(Args args) {
    extern __shared__ __attribute__((aligned(16))) unsigned char lds_raw[];
    lds_t lds = (lds_t)lds_raw;
    volatile LAS unsigned* MISC = (volatile LAS unsigned*)(lds + MISC_OFF);
    const int tid = threadIdx.x, G = gridDim.x;
    unsigned char* ws = args.ws;
    unsigned* ctl = (unsigned*)(ws + WS_CTL);
    if (tid < 64) MISC[tid] = 0u;
    __syncthreads();
    XcdBarrier bar = xcd_barrier_post(ctl + CW_BAR, MISC + 8);
#define GRID_BAR() xcd_barrier(bar)

    if (PH & 1) p0_prologue(lds, args.in, ws, G);
    cg::this_grid().sync();
    GRID_BAR();

    if (PH & 2) { pg8::Gemm g{(const pg8::bf16_t*)(ws + WS_XB), (const pg8::bf16_t*)(ws + WS_WIN), MTOK, NPAD, DM}; pg8::StaticOrder S; S.init(MTOK, NPAD, G, (int)blockIdx.x);
      pg8::EpiProj E{ws, 0.08838834764831845f * LOG2E};
      pg8::gemm_phase<pg8::EpiProj, pg8::StaticOrder, true, true>(lds, g, S, E); }
    GRID_BAR();

    if (PH & 4) for (int it = blockIdx.x; it < 512 + 1024 + 16; it += G) {
        if (it < 512) gla_prep_item(lds, it, ws, args.in[3], args.in[4], tid);
        else if (it < 1536) fv_tr_item(lds, it - 512, ws, tid);
        else fox_cumsum_item(lds, it - 1536, ws, args.in[6], tid);
    }
    GRID_BAR();

    if (PH & 8) { if (blockIdx.x < 32) gla_scan_item(lds, (int)blockIdx.x, ws, tid); }
    if (PH & 16) for (;;) {
        __syncthreads();
        if (tid == 0) MISC[16] = __hip_atomic_fetch_add(ctl + CW_QUEUE, 1u, RLX_AGENT);
        __syncthreads();
        const int j = (int)MISC[16];
        if (j >= 512) break;
        fox_unit(lds, j & 15, 31 - (j >> 4), ws, tid);
    }
    GRID_BAR();

    if (PH & 32) gla_norm_pass(ws, args.in[5], G);
    GRID_BAR();

    if (PH & 64) { pg8::StaticOrder S; S.init(MTOK, DM, G, (int)blockIdx.x);
      { pg8::Gemm g{(const pg8::bf16_t*)(ws + WS_OG), (const pg8::bf16_t*)(ws + WS_WBG), MTOK, DM, 2048};
        pg8::EpiEw<1> E{(float*)(ws + WS_YTMP), nullptr, nullptr, (const pg8::bf16_t*)(ws + WS_MA), DM, 0.f};
        pg8::gemm_phase<pg8::EpiEw<1>, pg8::StaticOrder, false, true>(lds, g, S, E); }
      asm volatile("s_waitcnt vmcnt(0)" ::: "memory"); __syncthreads();
      { pg8::Gemm g{(const pg8::bf16_t*)(ws + WS_OF), (const pg8::bf16_t*)(ws + WS_WBF), MTOK, DM, 1024};
        pg8::EpiEw<2> E{nullptr, (pg8::bf16_t*)(ws + WS_MERGED), (const float*)(ws + WS_YTMP), (const pg8::bf16_t*)(ws + WS_MB), DM, 0.f};
        pg8::gemm_phase<pg8::EpiEw<2>, pg8::StaticOrder, false, true>(lds, g, S, E); } }
    GRID_BAR();

    if (PH & 128) { pg8::StaticOrder S; S.init(MTOK, DM, G, (int)blockIdx.x);
      pg8::Gemm g{(const pg8::bf16_t*)(ws + WS_MERGED), (const pg8::bf16_t*)(ws + WS_WOUT), MTOK, DM, 2048};
      pg8::EpiEw<3> E{(float*)(ws + WS_X1), nullptr, args.in[0], nullptr, DM, ALPHA_RES};
      pg8::gemm_phase<pg8::EpiEw<3>, pg8::StaticOrder, false, true>(lds, g, S, E); }
    GRID_BAR();
    if (PH & 256) ln_pass((const float*)(ws + WS_X1), (float*)(ws + WS_X1), (bf16*)(ws + WS_XNB), args.in[10], args.in[11], G);
    GRID_BAR();

    if (PH & 512) { pg8::StaticOrder S; S.init(MTOK, FF, G, (int)blockIdx.x);
      pg8::Gemm g{(const pg8::bf16_t*)(ws + WS_XNB), (const pg8::bf16_t*)(ws + WS_WG), MTOK, FF, 2048};
      pg8::EpiBf E{(pg8::bf16_t*)(ws + WS_G), FF};
      pg8::gemm_phase<pg8::EpiBf, pg8::StaticOrder, true, true>(lds, g, S, E); }
    GRID_BAR();
    if (PH & 1024) { pg8::StaticOrder S; S.init(MTOK, FF, G, (int)blockIdx.x);
      pg8::Gemm g{(const pg8::bf16_t*)(ws + WS_XNB), (const pg8::bf16_t*)(ws + WS_WU), MTOK, FF, 2048};
      pg8::EpiUp E{(const pg8::bf16_t*)(ws + WS_G), (pg8::bf16_t*)(ws + WS_H), args.in[14], args.in[15]};
      pg8::gemm_phase<pg8::EpiUp, pg8::StaticOrder, true, true>(lds, g, S, E); }
    GRID_BAR();
    if (PH & 2048) { pg8::StaticOrder S; S.init(MTOK, DM, G, (int)blockIdx.x);
      pg8::Gemm g{(const pg8::bf16_t*)(ws + WS_H), (const pg8::bf16_t*)(ws + WS_WD), MTOK, DM, FF};
      pg8::EpiEw<3> E{(float*)(ws + WS_V2), nullptr, (const float*)(ws + WS_X1), nullptr, DM, ALPHA_RES};
      pg8::gemm_phase<pg8::EpiEw<3>, pg8::StaticOrder, false, true>(lds, g, S, E); }
    GRID_BAR();
    if (PH & 4096) ln_pass((const float*)(ws + WS_V2), args.out, (bf16*)(ws + WS_XNB), args.in[17], args.in[18], G);
    GRID_BAR();

    if (PH & 8192) { pg8::StaticOrder S; S.init(MTOK, DM, G, (int)blockIdx.x);
      { pg8::Gemm g{(const pg8::bf16_t*)(ws + WS_PB), (const pg8::bf16_t*)(ws + WS_WPP), MTOK, DM, PLE};
        pg8::EpiEw<0> E{(float*)(ws + WS_TMP), nullptr, nullptr, nullptr, DM, 0.f};
        pg8::gemm_phase<pg8::EpiEw<0>, pg8::StaticOrder, false, true>(lds, g, S, E); }
      asm volatile("s_waitcnt vmcnt(0)" ::: "memory"); __syncthreads();
      { pg8::Gemm g{(const pg8::bf16_t*)(ws + WS_XNB), (const pg8::bf16_t*)(ws + WS_WPG), MTOK, DM, 2048};
        pg8::EpiEw<4> E{args.out, nullptr, (const float*)(ws + WS_TMP), nullptr, DM, 0.f};
        pg8::gemm_phase<pg8::EpiEw<4>, pg8::StaticOrder, false, true>(lds, g, S, E); } }
}

extern "C" void kernel_launch(void* const* d_in, const int* in_sizes, int n_in, void* d_out, int out_size, void* d_ws, size_t ws_size, hipStream_t stream) {
    static int grid = 0;
    if (grid == 0) {
        if (n_in != 21 || in_sizes[0] != MTOK * DM || out_size != MTOK * DM || ws_size < WS_END) { fprintf(stderr, "kernel_launch: unexpected shapes (n_in %d, in0 %d, out %d, ws %zu < %zu)\n", n_in, n_in > 0 ? in_sizes[0] : -1, out_size, ws_size, (size_t)WS_END); grid = -1; return; }
        int dev = 0, cus = 0, per_cu = 0;
        if (hipGetDevice(&dev) != hipSuccess || hipDeviceGetAttribute(&cus, hipDeviceAttributeMultiprocessorCount, dev) != hipSuccess) { fprintf(stderr, "kernel_launch: device query failed\n"); grid = -1; return; }
        if (hipFuncSetAttribute((const void*)mega_fwd, hipFuncAttributeMaxDynamicSharedMemorySize, LDS_BYTES) != hipSuccess) { fprintf(stderr, "kernel_launch: hipFuncSetAttribute failed\n"); grid = -1; return; }
        if (hipOccupancyMaxActiveBlocksPerMultiprocessor(&per_cu, (const void*)mega_fwd, 512, LDS_BYTES) != hipSuccess || per_cu < 1) { fprintf(stderr, "kernel_launch: occupancy query says %d blocks per CU\n", per_cu); per_cu = 1; }
        (void)hipGetLastError();
        grid = cus;
    }
    if (grid < 0) return;
    if (hipMemsetAsync((char*)d_ws + WS_CTL, 0, CTL_ZERO_BYTES, stream) != hipSuccess) { fprintf(stderr, "kernel_launch: memset failed\n"); return; }
    Args a{};
    for (int i = 0; i < 21; ++i) a.in[i] = (const float*)d_in[i];
    a.out = (float*)d_out; a.ws = (unsigned char*)d_ws;
    void* kargs[] = {&a};
    const hipError_t e = hipLaunchCooperativeKernel((const void*)mega_fwd, dim3(grid), dim3(512), kargs, LDS_BYTES, stream);
    if (e != hipSuccess) fprintf(stderr, "kernel_launch: cooperative launch failed: %s (grid %d)\n", hipGetErrorString(e), grid);
}
```

```cpp
#include <hip/hip_runtime.h>
#include <hip/hip_cooperative_groups.h>
#include <cstdio>
#include <cstdint>
namespace cg = cooperative_groups;

constexpr int BATCH = 2, SEQ = 4096, DM = 2048, MTOK = BATCH * SEQ;
constexpr int N_IN = 13336, NPAD = 13568, FF = 5632, PLE = 256;
constexpr float ALPHA_RES = 1.189207115002721f;
constexpr float LN_EPS = 1e-5f, RMS_EPS = 1e-6f;
constexpr float LOG2E = 1.4426950408889634f;

constexpr size_t MiB = 1u << 20;
constexpr size_t WS_CTL = 0, CTL_ZERO_BYTES = 65536;
constexpr size_t WS_WBG = 1 * MiB, WS_WBF = 9 * MiB, WS_WOUT = 13 * MiB, WS_WG = 21 * MiB, WS_WU = 43 * MiB, WS_WD = 65 * MiB, WS_WPG = 87 * MiB, WS_WPP = 95 * MiB;
constexpr size_t WS_PB = 96 * MiB;
constexpr size_t WS_R1 = 100 * MiB;
constexpr size_t WS_WIN = WS_R1, WS_XB = WS_R1 + 53 * MiB;
constexpr size_t WS_QT = WS_R1, WS_KT = WS_R1 + 16 * MiB, WS_VT = WS_R1 + 32 * MiB, WS_ATT = WS_R1 + 64 * MiB, WS_DEC = WS_R1 + 68 * MiB, WS_FVT = WS_R1 + 69 * MiB, WS_CB = WS_R1 + 85 * MiB;
constexpr size_t WS_YTMP = WS_R1;
constexpr size_t WS_G = WS_R1;
constexpr size_t WS_V2 = WS_R1;
constexpr size_t WS_GQ = 188 * MiB, WS_GK = 204 * MiB, WS_GV = 220 * MiB, WS_GR = 252 * MiB, WS_FQ = 284 * MiB, WS_FK = 300 * MiB, WS_FV = 316 * MiB, WS_MB = 332 * MiB, WS_MA = 364 * MiB, WS_SM = 396 * MiB;
constexpr size_t WS_ORAW = WS_GQ;
constexpr size_t WS_X1 = WS_GQ;
constexpr size_t WS_OG = WS_GR, WS_OF = WS_FQ, WS_MERGED = WS_FK;
constexpr size_t WS_H = WS_GR;
constexpr size_t WS_TMP = WS_GR;
constexpr size_t WS_XNB = WS_MA;
constexpr size_t WS_LSEG = 397 * MiB;
constexpr size_t WS_END = 413 * MiB;
constexpr int CW_QUEUE = 64;
constexpr int CW_BAR = 4096;

constexpr int LDS_BYTES = 147456;
constexpr int MISC_OFF = LDS_BYTES - 256;
#define LAS __attribute__((address_space(3)))
typedef LAS unsigned char* lds_t;
namespace pg8 {
#define PG8_LAS __attribute__((address_space(3)))
typedef unsigned short bf16_t;
typedef short bf16x8 __attribute__((ext_vector_type(8)));
typedef float f32x4 __attribute__((ext_vector_type(4)));
typedef unsigned u32x4 __attribute__((ext_vector_type(4)));
constexpr int BM = 256, BK = 64, HALF = 128, HTB = HALF * BK * 2  , STAGE_BYTES = 8 * HTB, NXCD = 8, WGM = 8;

__host__ __device__ __forceinline__ int lds_byte(int r, int c) { const int st = (r >> 4) * 2 + (c >> 5), rr = r & 15, cc = c & 31, ob = rr * 64 + cc * 2; return st * 1024 + (ob ^ (((ob >> 9) & 1) << 5)); }
__host__ __device__ __forceinline__ void stage_rc(int b, int& R, int& C) { const int st = b / 1024, sb = b % 1024, swz = sb ^ (((sb >> 9) & 1) << 5); R = (st >> 1) * 16 + swz / 64; C = (st & 1) * 32 + (swz % 64) / 2; }
__host__ __device__ __forceinline__ int perm32(int rho) { const int n = rho >> 4, i = rho & 15; return 8 * (i >> 2) + 4 * n + (i & 3); }

struct Unit { int pm, pn; };
struct Gemm { const bf16_t* A; const bf16_t* Bt; int M, N, K; };

struct StaticOrder {
    int nM, nN, nwg, G, c;
    __host__ __device__ void init(int M, int N, int G_, int c_) { nM = M / BM; nN = N / BM; nwg = nM * nN; G = G_; c = c_; }
    __host__ __device__ bool next(int i, Unit& u) const {
        const long L = (long)i * G + c; if (L >= nwg) return false;
        int wgid = (int)L; { const int q = nwg / NXCD, r = nwg % NXCD, xcd = wgid % NXCD, off = wgid / NXCD; wgid = (xcd < r ? xcd * (q + 1) : r * (q + 1) + (xcd - r) * q) + off; }
        const int nig = WGM * nN, gid = wgid / nig, fm = gid * WGM, gsz = (nM - fm) < WGM ? (nM - fm) : WGM;
        u.pm = fm + ((wgid % nig) % gsz); u.pn = (wgid % nig) / gsz; return true;
    }
    __device__ __forceinline__ void a_ready(const Unit&) const {}
    __device__ __forceinline__ void done(const Unit&) const {}
};

__device__ __forceinline__ unsigned cvt_pk_bf16(float lo, float hi) { unsigned r; asm volatile("v_cvt_pk_bf16_f32 %0, %1, %2" : "=v"(r) : "v"(lo), "v"(hi)); return r; }
typedef float f32x2 __attribute__((ext_vector_type(2)));

__device__ __forceinline__ float fsigmoid(float x) { return __builtin_amdgcn_rcpf(1.0f + __builtin_amdgcn_exp2f(-1.4426950408889634f * x)); }
__device__ __forceinline__ void unpack8(const u32x4 w, float (&f)[8]) {
#pragma unroll
    for (int i = 0; i < 4; ++i) { f[2 * i] = __uint_as_float(w[i] << 16); f[2 * i + 1] = __uint_as_float(w[i] & 0xffff0000u); }
}
__device__ __forceinline__ u32x4 pack8(const f32x4 a, const f32x4 b) { u32x4 w; w.x = cvt_pk_bf16(a[0], a[1]); w.y = cvt_pk_bf16(a[2], a[3]); w.z = cvt_pk_bf16(b[0], b[1]); w.w = cvt_pk_bf16(b[2], b[3]); return w; }

struct EpiProj {
    static constexpr bool PERM = true, AFTER_DRAIN = false;
    unsigned char* ws; float qscale;
    __device__ __forceinline__ void operator()(const f32x4 (&acc)[2][2][4][2], const Unit& u, int wr, int wc, int fr, int fq) const {
        const int pn = u.pn; const int row0 = u.pm * BM + wr * 64 + fr;
        if (pn == 52) {
            if (wc == 0) { float* sm = (float*)(ws + WS_SM);
#pragma unroll
                for (int ai = 0; ai < 2; ++ai)
#pragma unroll
                    for (int m = 0; m < 4; ++m) { float* rp = sm + (size_t)(row0 + ai * HALF + m * 16) * 32 + 8 * fq; *(f32x4*)rp = acc[ai][0][m][0]; *(f32x4*)(rp + 4) = acc[ai][0][m][1]; } }
            return;
        }
        size_t off; int ldc, ct; float sc = 1.f;
        if (pn < 4) { off = WS_GQ; ldc = 1024; ct = pn; }
        else if (pn < 8) { off = WS_GK; ldc = 1024; ct = pn - 4; }
        else if (pn < 16) { off = WS_GV; ldc = 2048; ct = pn - 8; }
        else if (pn < 24) { off = WS_GR; ldc = 2048; ct = pn - 16; }
        else if (pn < 28) { off = WS_FQ; ldc = 1024; ct = pn - 24; sc = qscale; }
        else if (pn < 32) { off = WS_FK; ldc = 1024; ct = pn - 28; }
        else if (pn < 36) { off = WS_FV; ldc = 1024; ct = pn - 32; }
        else if (pn < 44) { off = WS_MA; ldc = 2048; ct = pn - 36; }
        else { off = WS_MB; ldc = 2048; ct = pn - 44; }
        bf16_t* base = (bf16_t*)(ws + off); const int col0 = ct * BM + wc * 32 + 8 * fq;
#pragma unroll
        for (int ai = 0; ai < 2; ++ai)
#pragma unroll
            for (int m = 0; m < 4; ++m) { bf16_t* rowp = base + (size_t)(row0 + ai * HALF + m * 16) * ldc + col0;
#pragma unroll
                for (int bj = 0; bj < 2; ++bj) *(u32x4*)(rowp + bj * HALF) = pack8(acc[ai][bj][m][0] * sc, acc[ai][bj][m][1] * sc); }
    }
};
struct EpiBf {
    static constexpr bool PERM = true, AFTER_DRAIN = false;
    bf16_t* O; int ldc;
    __device__ __forceinline__ void operator()(const f32x4 (&acc)[2][2][4][2], const Unit& u, int wr, int wc, int fr, int fq) const {
        const int row0 = u.pm * BM + wr * 64 + fr, col0 = u.pn * BM + wc * 32 + 8 * fq;
#pragma unroll
        for (int ai = 0; ai < 2; ++ai)
#pragma unroll
            for (int m = 0; m < 4; ++m) { bf16_t* rowp = O + (size_t)(row0 + ai * HALF + m * 16) * ldc + col0;
#pragma unroll
                for (int bj = 0; bj < 2; ++bj) *(u32x4*)(rowp + bj * HALF) = pack8(acc[ai][bj][m][0], acc[ai][bj][m][1]); }
    }
};
template <int MODE> struct EpiEw {
    static constexpr bool PERM = true, AFTER_DRAIN = false;
    float* O32; bf16_t* Obf; const float* I32; const bf16_t* GATE; int ldc; float alpha;
    __device__ __forceinline__ void operator()(const f32x4 (&acc)[2][2][4][2], const Unit& u, int wr, int wc, int fr, int fq) const {
        const int row0 = u.pm * BM + wr * 64 + fr, col0 = u.pn * BM + wc * 32 + 8 * fq;
#pragma unroll
        for (int ai = 0; ai < 2; ++ai)
#pragma unroll
            for (int m = 0; m < 4; ++m) { const size_t ro = (size_t)(row0 + ai * HALF + m * 16) * ldc + col0;
#pragma unroll
                for (int bj = 0; bj < 2; ++bj) { const size_t o = ro + bj * HALF; f32x4 a0 = acc[ai][bj][m][0], a1 = acc[ai][bj][m][1];
                    if (MODE == 0) { *(f32x4*)(O32 + o) = a0; *(f32x4*)(O32 + o + 4) = a1; }
                    if (MODE == 1 || MODE == 2) { float g[8]; unpack8(*(const u32x4*)(GATE + o), g);
#pragma unroll
                        for (int j = 0; j < 4; ++j) { a0[j] *= fsigmoid(g[j]); a1[j] *= fsigmoid(g[4 + j]); }
                        if (MODE == 1) { *(f32x4*)(O32 + o) = a0; *(f32x4*)(O32 + o + 4) = a1; }
                        else { const f32x4 i0 = *(const f32x4*)(I32 + o), i1 = *(const f32x4*)(I32 + o + 4); *(u32x4*)(Obf + o) = pack8(a0 + i0, a1 + i1); } }
                    if (MODE == 3) { const f32x4 i0 = *(const f32x4*)(I32 + o), i1 = *(const f32x4*)(I32 + o + 4); *(f32x4*)(O32 + o) = i0 * alpha + a0; *(f32x4*)(O32 + o + 4) = i1 * alpha + a1; }
                    if (MODE == 4) { const f32x4 i0 = *(const f32x4*)(I32 + o), i1 = *(const f32x4*)(I32 + o + 4); f32x4 x0 = *(const f32x4*)(O32 + o), x1 = *(const f32x4*)(O32 + o + 4);
#pragma unroll
                        for (int j = 0; j < 4; ++j) { x0[j] += fsigmoid(a0[j]) * i0[j]; x1[j] += fsigmoid(a1[j]) * i1[j]; }
                        *(f32x4*)(O32 + o) = x0; *(f32x4*)(O32 + o + 4) = x1; }
                } }
    }
};
struct EpiUp {
    static constexpr bool PERM = true, AFTER_DRAIN = false;
    const bf16_t* G; bf16_t* H; const float* cw; const float* cb;
    __device__ __forceinline__ void operator()(const f32x4 (&acc)[2][2][4][2], const Unit& u, int wr, int wc, int fr, int fq) const {
        const int row0 = u.pm * BM + wr * 64 + fr;
#pragma unroll
        for (int bj = 0; bj < 2; ++bj) {
            const int c0 = u.pn * BM + bj * HALF + wc * 32 + 8 * fq;
            const f32x4 w0a = *(const f32x4*)(cw + c0), w0b = *(const f32x4*)(cw + c0 + 4), w1a = *(const f32x4*)(cw + FF + c0), w1b = *(const f32x4*)(cw + FF + c0 + 4);
            const f32x4 w2a = *(const f32x4*)(cw + 2 * FF + c0), w2b = *(const f32x4*)(cw + 2 * FF + c0 + 4), ba = *(const f32x4*)(cb + c0), bb = *(const f32x4*)(cb + c0 + 4);
#pragma unroll
            for (int ai = 0; ai < 2; ++ai)
#pragma unroll
                for (int m = 0; m < 4; ++m) {
                    const int r = row0 + ai * HALF + m * 16, t = r & (SEQ - 1);
                    const int r1 = t >= 1 ? r - 1 : r, r2 = t >= 2 ? r - 2 : r; const float f1 = t >= 1 ? 1.f : 0.f, f2 = t >= 2 ? 1.f : 0.f;
                    float g2[8], g1[8], g0[8];
                    unpack8(*(const u32x4*)(G + (size_t)r * FF + c0), g2); unpack8(*(const u32x4*)(G + (size_t)r1 * FF + c0), g1); unpack8(*(const u32x4*)(G + (size_t)r2 * FF + c0), g0);
                    f32x4 h0, h1;
#pragma unroll
                    for (int j = 0; j < 4; ++j) {
                        const float ca = ba[j] + w0a[j] * (g0[j] * f2) + w1a[j] * (g1[j] * f1) + w2a[j] * g2[j];
                        const float cb_ = bb[j] + w0b[j] * (g0[4 + j] * f2) + w1b[j] * (g1[4 + j] * f1) + w2b[j] * g2[4 + j];
                        const float ya = 1.5957691216057308f * (ca + 0.044715f * ca * ca * ca), yb = 1.5957691216057308f * (cb_ + 0.044715f * cb_ * cb_ * cb_);
                        h0[j] = ca * fsigmoid(ya) * acc[ai][bj][m][0][j]; h1[j] = cb_ * fsigmoid(yb) * acc[ai][bj][m][1][j];
                    }
                    *(u32x4*)(H + (size_t)r * FF + c0) = pack8(h0, h1);
                }
        }
    }
};

template <class Epi, class Sched, bool ALIGN_EPI = false, bool SP2 = false>
__device__ __forceinline__ void gemm_phase(PG8_LAS unsigned char* lds, const Gemm g, const Sched& S, const Epi& E) {
    int tid_ = threadIdx.x; asm volatile("" : "+v"(tid_));
    const int tid = tid_, wid = __builtin_amdgcn_readfirstlane(tid >> 6), lane = tid & 63, wr = wid >> 2, wc = wid & 3, fr = lane & 15, fq = lane >> 4;
    const int K = g.K, nt = K / BK;
    unsigned voffA[2], voffB[2];
#pragma unroll
    for (int i = 0; i < 2; ++i) { int R, C; stage_rc(tid * 16 + i * 8192, R, C); const int Rb = Epi::PERM ? ((R & ~31) + perm32(R & 31)) : R;
        voffA[i] = (unsigned)(R * K + C) * 2u; voffB[i] = (unsigned)(Rb * K + C) * 2u; }
    const size_t kstep = (size_t)(BK * 2);
    const size_t hstep = (size_t)HALF * K * 2;
    const size_t tstep = 2 * hstep;
    const unsigned ldsw = (unsigned)wid * 1024u;
    const int aoff = lds_byte(wr * 64 + fr, fq * 8), boff = lds_byte(wc * 32 + fr, fq * 8);
#define PG8_SA(b, h) (((b) * 2 + (h)) * HTB)
#define PG8_SB(b, h) ((4 + (b) * 2 + (h)) * HTB)
#define PG8_STAGE(bufoff, gbase, voff) do { _Pragma("unroll") for (int _i = 0; _i < 2; ++_i) \
        __builtin_amdgcn_global_load_lds((const unsigned*)((const char*)(gbase) + (voff)[_i]), (PG8_LAS unsigned*)(lds + (bufoff) + ldsw + _i * 8192), 16, 0, 0); } while (0)
#define PG8_LDA(dst, b, h) do { _Pragma("unroll") for (int m = 0; m < 4; ++m) _Pragma("unroll") for (int k = 0; k < 2; ++k) dst[m][k] = *(const PG8_LAS bf16x8*)(lds + PG8_SA(b, h) + aoff + m * 2048 + k * 1024); } while (0)
#define PG8_LDB(dst, b, h) do { _Pragma("unroll") for (int n = 0; n < 2; ++n) _Pragma("unroll") for (int k = 0; k < 2; ++k) dst[n][k] = *(const PG8_LAS bf16x8*)(lds + PG8_SB(b, h) + boff + n * 2048 + k * 1024); } while (0)
#define PG8_MMA(ai, bj, At, Bt) do { __builtin_amdgcn_s_setprio(1); _Pragma("unroll") for (int m = 0; m < 4; ++m) _Pragma("unroll") for (int n = 0; n < 2; ++n) _Pragma("unroll") for (int k = 0; k < 2; ++k) \
        acc[ai][bj][m][n] = __builtin_amdgcn_mfma_f32_16x16x32_bf16(Bt[n][k], At[m][k], acc[ai][bj][m][n], 0, 0, 0); __builtin_amdgcn_s_setprio(0); } while (0)
#define PG8_WAIT_V(n) asm volatile("s_waitcnt vmcnt(" #n ")" ::: "memory")
#define PG8_WAIT_L(n) asm volatile("s_waitcnt lgkmcnt(" #n ")" ::: "memory")
#define PG8_BAR __builtin_amdgcn_s_barrier()
#define PG8_SCHED __builtin_amdgcn_sched_barrier(0)
    Unit cur, nxt; int ui = 0;
    if (!S.next(0, cur)) return;
    f32x4 acc[2][2][4][2];
#pragma unroll
    for (int a = 0; a < 2; ++a)
#pragma unroll
        for (int b = 0; b < 2; ++b)
#pragma unroll
            for (int m = 0; m < 4; ++m)
#pragma unroll
                for (int n = 0; n < 2; ++n) acc[a][b][m][n] = (f32x4){0.f, 0.f, 0.f, 0.f};
    bf16x8 At[4][2], B0[2][2], B1[2][2];
    const char* cA = (const char*)g.A + (size_t)cur.pm * tstep; const char* cB = (const char*)g.Bt + (size_t)cur.pn * tstep;
    S.a_ready(cur);
    if constexpr (SP2) {
        PG8_STAGE(PG8_SB(0, 0), cB, voffB); PG8_STAGE(PG8_SB(0, 1), cB + hstep, voffB); PG8_STAGE(PG8_SA(0, 0), cA, voffA); PG8_STAGE(PG8_SA(0, 1), cA + hstep, voffA);
        if (wr == 1) PG8_BAR;
        PG8_WAIT_V(2); PG8_BAR;
        PG8_STAGE(PG8_SB(1, 0), cB + kstep, voffB); PG8_STAGE(PG8_SA(1, 0), cA + kstep, voffA); PG8_STAGE(PG8_SB(1, 1), cB + hstep + kstep, voffB);
        PG8_WAIT_V(6); PG8_BAR;
    } else {
        PG8_STAGE(PG8_SB(0, 0), cB, voffB); PG8_STAGE(PG8_SA(0, 0), cA, voffA); PG8_STAGE(PG8_SB(0, 1), cB + hstep, voffB); PG8_STAGE(PG8_SA(0, 1), cA + hstep, voffA);
        if (wr == 1) PG8_BAR;
        PG8_WAIT_V(4); PG8_BAR;
        PG8_STAGE(PG8_SB(1, 0), cB + kstep, voffB); PG8_STAGE(PG8_SA(1, 0), cA + kstep, voffA); PG8_STAGE(PG8_SB(1, 1), cB + hstep + kstep, voffB);
        PG8_WAIT_V(6); PG8_BAR;
    }
    for (;;) {
        const bool has_next = S.next(ui + 1, nxt);
        const char* nA = has_next ? (const char*)g.A + (size_t)nxt.pm * tstep : cA; const char* nB = has_next ? (const char*)g.Bt + (size_t)nxt.pn * tstep : cB;
        for (int t = 0; t < nt; t += 2) {
            const bool last = (t == nt - 2);
            const char* a1 = cA + (size_t)(t + 1) * kstep;
            const char* a2 = last ? nA : cA + (size_t)(t + 2) * kstep; const char* b2 = last ? nB : cB + (size_t)(t + 2) * kstep;
            const char* a3 = a2 + kstep; const char* b3 = b2 + kstep;
            if (last && has_next) S.a_ready(nxt);
            if constexpr (SP2) {
            PG8_LDB(B0, 0, 0); PG8_LDB(B1, 0, 1); PG8_SCHED; PG8_LDA(At, 0, 0); PG8_STAGE(PG8_SA(1, 1), a1 + hstep, voffA);
            PG8_WAIT_V(8); PG8_WAIT_L(0); PG8_BAR; PG8_MMA(0, 0, At, B0); PG8_MMA(0, 1, At, B1); PG8_BAR; PG8_SCHED;
            PG8_LDA(At, 0, 1); PG8_STAGE(PG8_SB(0, 0), b2, voffB); PG8_STAGE(PG8_SB(0, 1), b2 + hstep, voffB); PG8_STAGE(PG8_SA(0, 0), a2, voffA);
            PG8_WAIT_V(8); PG8_WAIT_L(0); PG8_BAR; PG8_MMA(1, 0, At, B0); PG8_MMA(1, 1, At, B1); PG8_BAR; PG8_SCHED;
            PG8_LDB(B0, 1, 0); PG8_LDB(B1, 1, 1); PG8_SCHED; PG8_LDA(At, 1, 0); PG8_STAGE(PG8_SA(0, 1), a2 + hstep, voffA);
            PG8_WAIT_V(8); PG8_WAIT_L(0); PG8_BAR; PG8_MMA(0, 0, At, B0); PG8_MMA(0, 1, At, B1); PG8_BAR; PG8_SCHED;
            PG8_LDA(At, 1, 1); PG8_STAGE(PG8_SB(1, 0), b3, voffB); PG8_STAGE(PG8_SB(1, 1), b3 + hstep, voffB); PG8_STAGE(PG8_SA(1, 0), a3, voffA);
            PG8_WAIT_V(8); PG8_WAIT_L(0); PG8_BAR; PG8_MMA(1, 0, At, B0); PG8_MMA(1, 1, At, B1); PG8_BAR; PG8_SCHED;
            } else {
            PG8_LDB(B0, 0, 0); PG8_SCHED; PG8_LDA(At, 0, 0); PG8_STAGE(PG8_SA(1, 1), a1 + hstep, voffA);
            PG8_WAIT_L(8); PG8_BAR; PG8_WAIT_L(0); PG8_MMA(0, 0, At, B0); PG8_BAR; PG8_SCHED;
            PG8_LDB(B1, 0, 1); PG8_STAGE(PG8_SB(0, 0), b2, voffB);
            PG8_BAR; PG8_WAIT_L(0); PG8_MMA(0, 1, At, B1); PG8_BAR;
            PG8_LDA(At, 0, 1); PG8_STAGE(PG8_SA(0, 0), a2, voffA);
            PG8_BAR; PG8_WAIT_L(0); PG8_MMA(1, 0, At, B0); PG8_BAR; PG8_SCHED;
            PG8_STAGE(PG8_SB(0, 1), b2 + hstep, voffB);
            PG8_WAIT_V(6); PG8_BAR; PG8_MMA(1, 1, At, B1); PG8_BAR;
            PG8_LDB(B0, 1, 0); PG8_SCHED; PG8_LDA(At, 1, 0); PG8_STAGE(PG8_SA(0, 1), a2 + hstep, voffA);
            PG8_WAIT_L(8); PG8_BAR; PG8_WAIT_L(0); PG8_MMA(0, 0, At, B0); PG8_BAR; PG8_SCHED;
            PG8_LDB(B1, 1, 1); PG8_STAGE(PG8_SB(1, 0), b3, voffB);
            PG8_BAR; PG8_WAIT_L(0); PG8_MMA(0, 1, At, B1); PG8_BAR;
            PG8_LDA(At, 1, 1); PG8_STAGE(PG8_SA(1, 0), a3, voffA);
            PG8_BAR; PG8_WAIT_L(0); PG8_MMA(1, 0, At, B0); PG8_BAR; PG8_SCHED;
            PG8_STAGE(PG8_SB(1, 1), b3 + hstep, voffB);
            PG8_WAIT_V(6); PG8_BAR; PG8_MMA(1, 1, At, B1); PG8_BAR;
            }
        }
        if constexpr (ALIGN_EPI) { if (wr == 0) PG8_BAR; }
        if constexpr (!Epi::AFTER_DRAIN) { E(acc, cur, wr, wc, fr, fq); S.done(cur); }
        if (!has_next) break;
#pragma unroll
        for (int a = 0; a < 2; ++a)
#pragma unroll
            for (int b = 0; b < 2; ++b)
#pragma unroll
                for (int m = 0; m < 4; ++m)
#pragma unroll
                    for (int n = 0; n < 2; ++n) acc[a][b][m][n] = (f32x4){0.f, 0.f, 0.f, 0.f};
        cur = nxt; cA = nA; cB = nB; ++ui;
        if constexpr (ALIGN_EPI) { if (wr == 1) PG8_BAR; }
    }
    PG8_WAIT_V(0);
    if constexpr (!ALIGN_EPI) { if (wr == 0) PG8_BAR; }
    PG8_BAR;
    if constexpr (Epi::AFTER_DRAIN) { E.fused(acc, cur, wr, wc, fr, fq, lds, wid, lane); S.done(cur); }
#undef PG8_SA
#undef PG8_SB
#undef PG8_STAGE
#undef PG8_LDA
#undef PG8_LDB
#undef PG8_MMA
#undef PG8_WAIT_V
#undef PG8_WAIT_L
#undef PG8_BAR
#undef PG8_SCHED
}
}

typedef unsigned short bf16;
typedef float v4f __attribute__((ext_vector_type(4)));
typedef float v16f __attribute__((ext_vector_type(16)));
typedef unsigned v4u __attribute__((ext_vector_type(4)));
typedef unsigned v2u __attribute__((ext_vector_type(2)));
typedef short v8s __attribute__((ext_vector_type(8)));
#define RLX_AGENT __ATOMIC_RELAXED, __HIP_MEMORY_SCOPE_AGENT
template <class T> __device__ __forceinline__ T lds_ld(lds_t p, int off) { return *(const LAS T*)(p + off); }
template <class T> __device__ __forceinline__ void lds_st(lds_t p, int off, T v) { *(LAS T*)(p + off) = v; }
__device__ __forceinline__ unsigned cvtpk(float lo, float hi) { return pg8::cvt_pk_bf16(lo, hi); }
__device__ __forceinline__ float bf_lo(unsigned w) { return __uint_as_float(w << 16); }
__device__ __forceinline__ float bf_hi(unsigned w) { return __uint_as_float(w & 0xffff0000u); }
__device__ __forceinline__ float wave_sum(float v) {
#pragma unroll
    for (int o = 1; o < 64; o <<= 1) v += __shfl_xor(v, o);
    return v;
}
#define MFMA16(a, b, c) __builtin_amdgcn_mfma_f32_16x16x32_bf16((a), (b), (c), 0, 0, 0)
#define MFMA32(a, b, c) __builtin_amdgcn_mfma_f32_32x32x16_bf16((a), (b), (c), 0, 0, 0)

#define XB_TMO      128
#define XB_XCNT(j)  (256  + 64 * (j))
#define XB_XSUB(j)  (1280 + 64 * (j))
#define XB_XGEN(j)  (2304 + 64 * (j))
#define XB_TOP      3328
#define XB_TOPGEN   3392
#define XCD_BAR_WORDS 3456
#define XB_SPIN_CAP (1u << 22)
__device__ __forceinline__ unsigned xb_ld(unsigned* p)              { return __hip_atomic_load(p, __ATOMIC_RELAXED, __HIP_MEMORY_SCOPE_AGENT); }
__device__ __forceinline__ unsigned xb_add(unsigned* p, unsigned v) { return __hip_atomic_fetch_add(p, v, __ATOMIC_RELAXED, __HIP_MEMORY_SCOPE_AGENT); }
__device__ __forceinline__ unsigned xb_xcc_id() { return (unsigned)__builtin_amdgcn_s_getreg((3 << 11) | 20) & 0xFu; }
#define XB_SPIN(cond, bar) do { unsigned _sp = 0; while (cond) { __builtin_amdgcn_s_sleep(1); \
    if ((++_sp & 255u) == 0u) { if (xb_ld(&(bar)[XB_TMO])) break; if (_sp > XB_SPIN_CAP) { atomicAdd(&(bar)[XB_TMO], 1u); break; } } } } while (0)
struct XcdBarrier { unsigned* bar; unsigned x; volatile LAS unsigned* st; };
__device__ __forceinline__ XcdBarrier xcd_barrier_post(unsigned* bar, volatile LAS unsigned* st) {
    XcdBarrier b; b.bar = bar; b.x = xb_xcc_id(); b.st = st;
    if (threadIdx.x == 0) (void)xb_add(&bar[XB_XCNT(b.x)], 1u);
    return b;
}
__device__ __forceinline__ void xcd_barrier_complete(unsigned* bar, unsigned x, unsigned& nloc, unsigned& nx) {
    const unsigned G = gridDim.x * gridDim.y * gridDim.z;
    unsigned sum, cnt, mine, sp = 0u;
    for (;;) {
        sum = 0u; cnt = 0u; mine = 0u;
#pragma unroll
        for (unsigned j = 0; j < 16; ++j) { const unsigned c = xb_ld(&bar[XB_XCNT(j)]); sum += c; cnt += (c > 0u) ? 1u : 0u; mine = (j == x) ? c : mine; }
        if (sum == G) break;
        __builtin_amdgcn_s_sleep(1);
        if ((++sp & 255u) == 0u) { if (xb_ld(&bar[XB_TMO])) break; if (sp > XB_SPIN_CAP) { atomicAdd(&bar[XB_TMO], 1u); break; } }
    }
    nloc = mine > 0u ? mine : 1u; nx = cnt > 0u ? cnt : 1u;
}
__device__ __forceinline__ void xcd_barrier(const XcdBarrier& b) {
    asm volatile("s_waitcnt vmcnt(0)" ::: "memory");
    __syncthreads();
    if (threadIdx.x == 0) {
        unsigned* bar = b.bar;
        __builtin_amdgcn_s_waitcnt(0);
        unsigned nloc = b.st[0], nx = b.st[1];
        if (nloc == 0u) { xcd_barrier_complete(bar, b.x, nloc, nx); b.st[0] = nloc; b.st[1] = nx; }
        const unsigned old = xb_add(&bar[XB_XSUB(b.x)], 1u);
        const unsigned gen = old / nloc;
        if (old + 1u == (gen + 1u) * nloc) {
            __builtin_amdgcn_fence(__ATOMIC_RELEASE, "agent");
            asm volatile("s_waitcnt vmcnt(0)" ::: "memory");
            const unsigned og = xb_add(&bar[XB_TOP], 1u);
            const unsigned tg = og / nx;
            if (og + 1u == (tg + 1u) * nx) xb_add(&bar[XB_TOPGEN], 1u);
            else XB_SPIN(xb_ld(&bar[XB_TOPGEN]) == tg, bar);
            __builtin_amdgcn_fence(__ATOMIC_ACQUIRE, "agent");
            xb_add(&bar[XB_XGEN(b.x)], 1u);
            asm volatile("s_waitcnt vmcnt(0)" ::: "memory");
        } else {
            XB_SPIN(xb_ld(&bar[XB_XGEN(b.x)]) == gen, bar);
            __builtin_amdgcn_fence(__ATOMIC_ACQUIRE, "agent");
            asm volatile("s_waitcnt vmcnt(0)" ::: "memory");
        }
    }
    __syncthreads();
}

__device__ __forceinline__ void tr_item(const float* W, int K, int Nsrc, int scol, bf16* WT, int drow, int kb, lds_t scr, int lane) {
    const int k0 = 64 * kb;
#pragma unroll 8
    for (int i = 0; i < 32; ++i) { const int kk = 2 * i + (lane >> 5); lds_st<float>(scr, (kk * 33 + (lane & 31)) * 4, W[(size_t)(k0 + kk) * Nsrc + scol + (lane & 31)]); }
    asm volatile("s_waitcnt lgkmcnt(0)" ::: "memory");
    const int c = lane & 7;
#pragma unroll
    for (int j = 0; j < 4; ++j) { const int n = (lane >> 3) + 8 * j; const int so = ((8 * c) * 33 + n) * 4;
        v4u o; o.x = cvtpk(lds_ld<float>(scr, so), lds_ld<float>(scr, so + 33 * 4)); o.y = cvtpk(lds_ld<float>(scr, so + 2 * 33 * 4), lds_ld<float>(scr, so + 3 * 33 * 4));
        o.z = cvtpk(lds_ld<float>(scr, so + 4 * 33 * 4), lds_ld<float>(scr, so + 5 * 33 * 4)); o.w = cvtpk(lds_ld<float>(scr, so + 6 * 33 * 4), lds_ld<float>(scr, so + 7 * 33 * 4));
        *(v4u*)(WT + (size_t)(drow + n) * K + k0 + 8 * c) = o; }
    asm volatile("s_waitcnt lgkmcnt(0)" ::: "memory");
}
__device__ __forceinline__ void tr_mat(const float* W, int K, int N, bf16* WT, int r, lds_t scr, int lane) { const int nblk = N / 32, kb = r / nblk, nb = r % nblk; tr_item(W, K, N, 32 * nb, WT, 32 * nb, kb, scr, lane); }

__device__ __forceinline__ void p0_prologue(lds_t lds, const float* const* in, unsigned char* ws, int G) {
    const int tid = threadIdx.x, lane = tid & 63, wave = tid >> 6;
    lds_t scr = lds + wave * 16384;
    const int gw = blockIdx.x * 8 + wave, NGW = G * 8;
    constexpr int I_WIN = 32 * 416, I_BG = 32 * 64, I_BF = 16 * 64, I_OUT = 32 * 64, I_G = 32 * 176, I_U = I_G, I_D = 88 * 64, I_PG = 32 * 64, I_PP = 4 * 64;
    constexpr int NITEMS = I_WIN + I_BG + I_BF + I_OUT + I_G + I_U + I_D + I_PG + I_PP;
    for (int it = gw; it < NITEMS; it += NGW) {
        int r = it;
        if (r < I_WIN) { const int kb = r / 416, nb = r % 416, drow = 32 * nb; const int scol = drow + (drow >= 6144 ? 16 : 0) + (drow >= 9216 ? 8 : 0);
            tr_item(in[2], 2048, N_IN, scol, (bf16*)(ws + WS_WIN), drow, kb, scr, lane); continue; } r -= I_WIN;
        if (r < I_BG) { tr_mat(in[7], 2048, 2048, (bf16*)(ws + WS_WBG), r, scr, lane); continue; } r -= I_BG;
        if (r < I_BF) { tr_mat(in[8], 1024, 2048, (bf16*)(ws + WS_WBF), r, scr, lane); continue; } r -= I_BF;
        if (r < I_OUT) { tr_mat(in[9], 2048, 2048, (bf16*)(ws + WS_WOUT), r, scr, lane); continue; } r -= I_OUT;
        if (r < I_G) { tr_mat(in[12], 2048, FF, (bf16*)(ws + WS_WG), r, scr, lane); continue; } r -= I_G;
        if (r < I_U) { tr_mat(in[13], 2048, FF, (bf16*)(ws + WS_WU), r, scr, lane); continue; } r -= I_U;
        if (r < I_D) { tr_mat(in[16], FF, 2048, (bf16*)(ws + WS_WD), r, scr, lane); continue; } r -= I_D;
        if (r < I_PG) { tr_mat(in[19], 2048, 2048, (bf16*)(ws + WS_WPG), r, scr, lane); continue; } r -= I_PG;
        tr_mat(in[20], PLE, 2048, (bf16*)(ws + WS_WPP), r, scr, lane);
    }
    const int gt = blockIdx.x * 512 + tid, NT = G * 512;
    { const float* win = in[2]; bf16* WT = (bf16*)(ws + WS_WIN);
      for (int i = gt; i < 256 * 256; i += NT) { const int j = i >> 8, kc = (i & 255) * 8; v4u o = (v4u){0u, 0u, 0u, 0u};
          if (j < 24) { const int sc = j < 16 ? 6144 + j : 9232 + (j - 16); float f[8];
#pragma unroll
              for (int e = 0; e < 8; ++e) f[e] = win[(size_t)(kc + e) * N_IN + sc];
              o.x = cvtpk(f[0], f[1]); o.y = cvtpk(f[2], f[3]); o.z = cvtpk(f[4], f[5]); o.w = cvtpk(f[6], f[7]); }
          *(v4u*)(WT + (size_t)(13312 + j) * 2048 + kc) = o; } }
    { const float* x = in[0]; bf16* XB = (bf16*)(ws + WS_XB);
      for (int i = gt; i < MTOK * DM / 8; i += NT) { const v4f a = *(const v4f*)(x + (size_t)i * 8), b = *(const v4f*)(x + (size_t)i * 8 + 4);
          v4u o; o.x = cvtpk(a[0], a[1]); o.y = cvtpk(a[2], a[3]); o.z = cvtpk(b[0], b[1]); o.w = cvtpk(b[2], b[3]); *(v4u*)(XB + (size_t)i * 8) = o; } }
    { const float* p = in[1]; bf16* PB = (bf16*)(ws + WS_PB);
      for (int i = gt; i < MTOK * PLE / 8; i += NT) { const v4f a = *(const v4f*)(p + (size_t)i * 8), b = *(const v4f*)(p + (size_t)i * 8 + 4);
          v4u o; o.x = cvtpk(a[0], a[1]); o.y = cvtpk(a[2], a[3]); o.z = cvtpk(b[0], b[1]); o.w = cvtpk(b[2], b[3]); *(v4u*)(PB + (size_t)i * 8) = o; } }
}

__device__ __forceinline__ void gla_prep_item(lds_t lds, int item, const unsigned char* ws, const float* wlr, const float* blr, int tid) {
    asm volatile("" : "+v"(tid));
    const bf16* GQ = (const bf16*)(ws + WS_GQ); const bf16* GK = (const bf16*)(ws + WS_GK); const bf16* GV = (const bf16*)(ws + WS_GV); const float* SM = (const float*)(ws + WS_SM);
    bf16* QT = (bf16*)(ws + WS_QT); bf16* KT = (bf16*)(ws + WS_KT); bf16* VT = (bf16*)(ws + WS_VT); bf16* ATT = (bf16*)(ws + WS_ATT); float* DEC = (float*)(ws + WS_DEC);
    const int c = item & 63, bh = item >> 6, h = bh & 3, b = bh >> 2;
    const size_t tok0 = (size_t)b * SEQ + 64 * c;
    constexpr int L_BC = 0, L_TOT = 65536, L_GLR = 67584, L_QS = 71680, L_KS = 105472, QROW = 528;
    const int lane = tid & 63, wid = tid >> 6, l15 = lane & 15, q4 = lane >> 4;
    __syncthreads();
    if (tid < 256) { const int row = tid >> 2, quad = tid & 3; const v4f v = *(const v4f*)(SM + (tok0 + row) * 32 + quad * 4); lds_st<v4f>(lds, L_GLR + (row * 16 + quad * 4) * 4, v); }
    const int k = tid & 255, half = tid >> 8;
    float w[16];
#pragma unroll
    for (int r = 0; r < 16; ++r) w[r] = wlr[r * 1024 + h * 256 + k];
    const float bias = blr[h * 256 + k];
    __syncthreads();
    float run = 0.f;
    for (int tt = 0; tt < 32; ++tt) { const int t = half * 32 + tt; float z = bias;
#pragma unroll
        for (int r4 = 0; r4 < 4; ++r4) { const v4f g = lds_ld<v4f>(lds, L_GLR + (t * 16 + r4 * 4) * 4); z += g[0] * w[4 * r4] + g[1] * w[4 * r4 + 1] + g[2] * w[4 * r4 + 2] + g[3] * w[4 * r4 + 3]; }
        const float ls = fminf(z, 0.f) - log1pf(expf(-fabsf(z)));
        run += ls * 0.0625f;
        lds_st<float>(lds, L_BC + (t * 256 + k) * 4, run); }
    lds_st<float>(lds, L_TOT + (half * 256 + k) * 4, run);
    __syncthreads();
    if (tid < 256) DEC[(size_t)item * 256 + tid] = expf(lds_ld<float>(lds, L_TOT + tid * 4) + lds_ld<float>(lds, L_TOT + (256 + tid) * 4));
#pragma unroll 1
    for (int i = 0; i < 4; ++i) { const int idx = tid + 512 * i, t = idx >> 5, kc = (idx & 31) * 8;
        const v4u qv = *(const v4u*)(GQ + (tok0 + t) * 1024 + h * 256 + kc), kv = *(const v4u*)(GK + (tok0 + t) * 1024 + h * 256 + kc);
        v4f b0 = lds_ld<v4f>(lds, L_BC + (t * 256 + kc) * 4), b1 = lds_ld<v4f>(lds, L_BC + (t * 256 + kc + 4) * 4);
        if (t >= 32) { b0 += lds_ld<v4f>(lds, L_TOT + kc * 4); b1 += lds_ld<v4f>(lds, L_TOT + (kc + 4) * 4); }
        float qq[8], kk[8], bc[8];
#pragma unroll
        for (int j = 0; j < 4; ++j) { qq[2 * j] = bf_lo(qv[j]); qq[2 * j + 1] = bf_hi(qv[j]); kk[2 * j] = bf_lo(kv[j]); kk[2 * j + 1] = bf_hi(kv[j]); bc[j] = b0[j]; bc[4 + j] = b1[j]; }
#pragma unroll
        for (int j = 0; j < 8; ++j) { qq[j] = qq[j] * expf(bc[j]) * 0.0625f; kk[j] = kk[j] * expf(-bc[j]); }
        v4u qp, kp; qp.x = cvtpk(qq[0], qq[1]); qp.y = cvtpk(qq[2], qq[3]); qp.z = cvtpk(qq[4], qq[5]); qp.w = cvtpk(qq[6], qq[7]);
        kp.x = cvtpk(kk[0], kk[1]); kp.y = cvtpk(kk[2], kk[3]); kp.z = cvtpk(kk[4], kk[5]); kp.w = cvtpk(kk[6], kk[7]);
        *(v4u*)(QT + (size_t)item * 16384 + t * 256 + kc) = qp;
        lds_st<v4u>(lds, L_QS + t * QROW + kc * 2, qp); lds_st<v4u>(lds, L_KS + t * QROW + kc * 2, kp); }
    __syncthreads();
#pragma unroll 1
    for (int i = 0; i < 4; ++i) { const int idx = tid + 512 * i, kk = idx >> 3, sc = (idx & 7) * 8; unsigned e[8];
#pragma unroll
        for (int j = 0; j < 8; ++j) e[j] = lds_ld<unsigned short>(lds, L_KS + (sc + j) * QROW + kk * 2);
        v4u o; o.x = e[0] | (e[1] << 16); o.y = e[2] | (e[3] << 16); o.z = e[4] | (e[5] << 16); o.w = e[6] | (e[7] << 16);
        *(v4u*)(KT + (size_t)item * 16384 + kk * 64 + sc) = o; }
    { const int mt = wid >> 1;
#pragma unroll
      for (int nn = 0; nn < 2; ++nn) { const int nt = (wid & 1) * 2 + nn; v4f acc = (v4f){0.f, 0.f, 0.f, 0.f};
          if (nt <= mt) {
#pragma unroll
              for (int ks = 0; ks < 8; ++ks) { const v8s a = lds_ld<v8s>(lds, L_QS + (16 * mt + l15) * QROW + (32 * ks + 8 * q4) * 2), bb = lds_ld<v8s>(lds, L_KS + (16 * nt + l15) * QROW + (32 * ks + 8 * q4) * 2); acc = MFMA16(a, bb, acc); } }
#pragma unroll
          for (int r = 0; r < 4; ++r) { const int t = 16 * mt + 4 * q4 + r, s = 16 * nt + l15; const float v = (s <= t) ? acc[r] : 0.f; ATT[(size_t)item * 4096 + t * 64 + s] = (bf16)(cvtpk(v, 0.f) & 0xffffu); } } }
    __syncthreads();
#pragma unroll 1
    for (int i = 0; i < 8; ++i) { const int idx = tid + 512 * i, s = idx >> 6, vc = (idx & 63) * 8; const v4u vv = *(const v4u*)(GV + (tok0 + s) * 2048 + h * 512 + vc);
#pragma unroll
        for (int j = 0; j < 4; ++j) { lds_st<unsigned short>(lds, (vc + 2 * j) * 132 + s * 2, (unsigned short)(vv[j] & 0xffffu)); lds_st<unsigned short>(lds, (vc + 2 * j + 1) * 132 + s * 2, (unsigned short)(vv[j] >> 16)); } }
    __syncthreads();
#pragma unroll 1
    for (int i = 0; i < 8; ++i) { const int idx = tid + 512 * i, v = idx >> 3, c8 = idx & 7; v4u o;
        o.x = lds_ld<unsigned>(lds, v * 132 + c8 * 16); o.y = lds_ld<unsigned>(lds, v * 132 + c8 * 16 + 4); o.z = lds_ld<unsigned>(lds, v * 132 + c8 * 16 + 8); o.w = lds_ld<unsigned>(lds, v * 132 + c8 * 16 + 12);
        *(v4u*)(VT + (size_t)item * 32768 + v * 64 + c8 * 8) = o; }
}
__device__ __forceinline__ void fv_tr_item(lds_t lds, int item, const unsigned char* ws, int tid) {
    asm volatile("" : "+v"(tid));
    const bf16* FV = (const bf16*)(ws + WS_FV); bf16* FVT = (bf16*)(ws + WS_FVT);
    const int bh = item >> 6, tt = item & 63, b = bh >> 3, h = bh & 7;
    __syncthreads();
#pragma unroll
    for (int i = 0; i < 2; ++i) { const int idx = tid + 512 * i, s = idx >> 4, dc = (idx & 15) * 8; const v4u vv = *(const v4u*)(FV + ((size_t)b * SEQ + 64 * tt + s) * 1024 + h * 128 + dc);
#pragma unroll
        for (int j = 0; j < 4; ++j) { lds_st<unsigned short>(lds, (dc + 2 * j) * 132 + s * 2, (unsigned short)(vv[j] & 0xffffu)); lds_st<unsigned short>(lds, (dc + 2 * j + 1) * 132 + s * 2, (unsigned short)(vv[j] >> 16)); } }
    __syncthreads();
#pragma unroll
    for (int i = 0; i < 2; ++i) { const int idx = tid + 512 * i, d = idx >> 3, c8 = idx & 7; v4u o;
        o.x = lds_ld<unsigned>(lds, d * 132 + c8 * 16); o.y = lds_ld<unsigned>(lds, d * 132 + c8 * 16 + 4); o.z = lds_ld<unsigned>(lds, d * 132 + c8 * 16 + 8); o.w = lds_ld<unsigned>(lds, d * 132 + c8 * 16 + 12);
        *(v4u*)(FVT + ((size_t)bh * 128 + d) * SEQ + 64 * tt + c8 * 8) = o; }
}
__device__ __forceinline__ void fox_cumsum_item(lds_t lds, int bh, const unsigned char* ws, const float* bfg, int tid) {
    asm volatile("" : "+v"(tid));
    const float* SM = (const float*)(ws + WS_SM); float* CB = (float*)(ws + WS_CB);
    const int b = bh >> 3, h = bh & 7, lane = tid & 63, wid = tid >> 6; const float bf = bfg[h];
    __syncthreads();
    float v[8]; float run = 0.f;
#pragma unroll
    for (int j = 0; j < 8; ++j) { const float z = SM[((size_t)b * SEQ + tid * 8 + j) * 32 + 16 + h] + bf; run += fminf(z, 0.f) - log1pf(expf(-fabsf(z))); v[j] = run; }
    float inc = run;
#pragma unroll
    for (int o = 1; o < 64; o <<= 1) { const float n = __shfl_up(inc, o); if (lane >= o) inc += n; }
    if (lane == 63) lds_st<float>(lds, wid * 4, inc);
    __syncthreads();
    float pre = inc - run;
    for (int w2 = 0; w2 < wid; ++w2) pre += lds_ld<float>(lds, w2 * 4);
#pragma unroll
    for (int j = 0; j < 8; ++j) CB[(size_t)bh * SEQ + tid * 8 + j] = -LOG2E * (pre + v[j]);
}

constexpr int NSEG = 8, SEGC = 64 / NSEG;
__device__ __forceinline__ void gla_scan_item(lds_t lds, int item, const unsigned char* ws, int tid) {
    asm volatile("" : "+v"(tid));
    const bf16* QT = (const bf16*)(ws + WS_QT); const bf16* KT = (const bf16*)(ws + WS_KT); const bf16* VT = (const bf16*)(ws + WS_VT); const bf16* ATT = (const bf16*)(ws + WS_ATT); const float* DEC = (const float*)(ws + WS_DEC);
    float* ORAW = (float*)(ws + WS_ORAW); bf16* LSEG = (bf16*)(ws + WS_LSEG);
    const int seg = item & (NSEG - 1), i32 = item / NSEG, vq = i32 & 3, bh4 = i32 >> 2, h = bh4 & 3, b = bh4 >> 2;
    const int lane = tid & 63, wid = tid >> 6, l15 = lane & 15, q4 = lane >> 4;
    constexpr int QROW = 528, KROW = 144, L_Q = 0, L_K = 33792, L_A = 33792 + 36864, L_D = L_A + 9216;
    const int vcol = 128 * vq + 16 * wid + l15;
    v4f S[16];
#pragma unroll
    for (int i = 0; i < 16; ++i) S[i] = (v4f){0.f, 0.f, 0.f, 0.f};
    v4u pq[4], pk[4], pa, pvf[2]; v4f pd;
#define GS_PREFETCH(cc) do { const size_t it_ = (size_t)bh4 * 64 + (cc); \
        _Pragma("unroll") for (int i = 0; i < 4; ++i) { const int idx = tid + 512 * i; pq[i] = *(const v4u*)(QT + it_ * 16384 + idx * 8); } \
        pa = *(const v4u*)(ATT + it_ * 4096 + tid * 8); \
        _Pragma("unroll") for (int kk = 0; kk < 2; ++kk) pvf[kk] = *(const v4u*)(VT + (it_ * 512 + vcol) * 64 + 32 * kk + 8 * q4); } while (0)
#define GS_PREFETCH2(cc) do { const size_t it_ = (size_t)bh4 * 64 + (cc); \
        _Pragma("unroll") for (int i = 0; i < 4; ++i) { const int idx = tid + 512 * i; pk[i] = *(const v4u*)(KT + it_ * 16384 + idx * 8); } \
        if (tid < 64) pd = *(const v4f*)(DEC + it_ * 256 + tid * 4); } while (0)
    GS_PREFETCH(seg * SEGC); GS_PREFETCH2(seg * SEGC);
    for (int c = seg * SEGC; c < (seg + 1) * SEGC; ++c) {
        __syncthreads();
#pragma unroll
        for (int i = 0; i < 4; ++i) { const int idx = tid + 512 * i; lds_st<v4u>(lds, L_Q + (idx >> 5) * QROW + (idx & 31) * 16, pq[i]); lds_st<v4u>(lds, L_K + (idx >> 3) * KROW + (idx & 7) * 16, pk[i]); }
        lds_st<v4u>(lds, L_A + (tid >> 3) * KROW + (tid & 7) * 16, pa);
        if (tid < 64) lds_st<v4f>(lds, L_D + tid * 16, pd);
        v8s vf[2]; vf[0] = __builtin_bit_cast(v8s, pvf[0]); vf[1] = __builtin_bit_cast(v8s, pvf[1]);
        __syncthreads();
        if (c + 1 < (seg + 1) * SEGC) GS_PREFETCH(c + 1);
        v4f o[4];
#pragma unroll
        for (int mt = 0; mt < 4; ++mt) o[mt] = (v4f){0.f, 0.f, 0.f, 0.f};
#pragma unroll
        for (int ks = 0; ks < 8; ++ks) {
            v4u bw; bw.x = cvtpk(S[2 * ks][0], S[2 * ks][1]); bw.y = cvtpk(S[2 * ks][2], S[2 * ks][3]); bw.z = cvtpk(S[2 * ks + 1][0], S[2 * ks + 1][1]); bw.w = cvtpk(S[2 * ks + 1][2], S[2 * ks + 1][3]);
            const v8s bfr = __builtin_bit_cast(v8s, bw);
#pragma unroll
            for (int mt = 0; mt < 4; ++mt) { const v2u lo = lds_ld<v2u>(lds, L_Q + (16 * mt + l15) * QROW + (32 * ks + 4 * q4) * 2), hi = lds_ld<v2u>(lds, L_Q + (16 * mt + l15) * QROW + (32 * ks + 16 + 4 * q4) * 2);
                const v4u aw = (v4u){lo.x, lo.y, hi.x, hi.y}; o[mt] = MFMA16(__builtin_bit_cast(v8s, aw), bfr, o[mt]); }
        }
#pragma unroll
        for (int kk = 0; kk < 2; ++kk)
#pragma unroll
            for (int mt = 0; mt < 4; ++mt) { const v8s a = lds_ld<v8s>(lds, L_A + (16 * mt + l15) * KROW + (32 * kk + 8 * q4) * 2); o[mt] = MFMA16(a, vf[kk], o[mt]); }
        { float* op = ORAW + ((size_t)b * SEQ + 64 * c) * 2048 + h * 512 + vcol;
#pragma unroll
          for (int mt = 0; mt < 4; ++mt)
#pragma unroll
              for (int r = 0; r < 4; ++r) op[(size_t)(16 * mt + 4 * q4 + r) * 2048] = o[mt][r]; }
        __builtin_amdgcn_sched_barrier(0);
        if (c + 1 < (seg + 1) * SEGC) GS_PREFETCH2(c + 1);
        __builtin_amdgcn_sched_barrier(0);
#pragma unroll
        for (int kt = 0; kt < 16; ++kt) { v4f acc = S[kt];
#pragma unroll
            for (int kk = 0; kk < 2; ++kk) { const v8s a = lds_ld<v8s>(lds, L_K + (16 * kt + l15) * KROW + (32 * kk + 8 * q4) * 2); acc = MFMA16(a, vf[kk], acc); }
            const v4f dc = lds_ld<v4f>(lds, L_D + (16 * kt + 4 * q4) * 4); S[kt] = acc * dc; }
    }
#undef GS_PREFETCH
#undef GS_PREFETCH2
    if (seg < NSEG - 1) { bf16* lp = LSEG + ((size_t)(i32 * NSEG + seg) * 128 + 16 * wid + l15) * 256 + 4 * q4;
#pragma unroll
        for (int kt = 0; kt < 16; ++kt) *(v2u*)(lp + 16 * kt) = (v2u){cvtpk(S[kt][0], S[kt][1]), cvtpk(S[kt][2], S[kt][3])}; }
}

__device__ __forceinline__ void gla_fix_item(lds_t lds, int item, const unsigned char* ws, int tid) {
    asm volatile("" : "+v"(tid));
    const bf16* QT = (const bf16*)(ws + WS_QT); const float* DEC = (const float*)(ws + WS_DEC); const bf16* LSEG = (const bf16*)(ws + WS_LSEG); float* ORAW = (float*)(ws + WS_ORAW);
    const int seg = item & (NSEG - 1), i32 = item / NSEG, vq = i32 & 3, bh4 = i32 >> 2, h = bh4 & 3, b = bh4 >> 2;
    const int lane = tid & 63, wid = tid >> 6, l15 = lane & 15, q4 = lane >> 4;
    constexpr int QROW = 528, L_Q = 0, L_DS = 33792, L_P = L_DS + 8192;
    const int vcol = 128 * vq + 16 * wid + l15;
    __syncthreads();
    if (tid < 256) {
        for (int s2 = 0; s2 < seg; ++s2) { float d = 1.f;
#pragma unroll
            for (int c = 0; c < SEGC; ++c) d *= DEC[((size_t)bh4 * 64 + s2 * SEGC + c) * 256 + tid];
            lds_st<float>(lds, L_DS + (s2 * 256 + tid) * 4, d); }
        float p = 1.f;
#pragma unroll
        for (int c = 0; c < SEGC; ++c) { lds_st<float>(lds, L_P + (c * 256 + tid) * 4, p); p *= DEC[((size_t)bh4 * 64 + seg * SEGC + c) * 256 + tid]; }
    }
    __syncthreads();
    v8s bfr[8];
#pragma unroll
    for (int ks = 0; ks < 8; ++ks) { float a[8];
#pragma unroll
        for (int j = 0; j < 8; ++j) a[j] = 0.f;
        for (int s2 = 0; s2 < seg; ++s2) { const v4u lw = *(const v4u*)(LSEG + ((size_t)(i32 * NSEG + s2) * 128 + 16 * wid + l15) * 256 + 32 * ks + 8 * q4);
            const v4f d0 = lds_ld<v4f>(lds, L_DS + (s2 * 256 + 32 * ks + 8 * q4) * 4), d1 = lds_ld<v4f>(lds, L_DS + (s2 * 256 + 32 * ks + 8 * q4 + 4) * 4);
#pragma unroll
            for (int j = 0; j < 4; ++j) { a[j] = a[j] * d0[j] + (j & 1 ? bf_hi(lw[j >> 1]) : bf_lo(lw[j >> 1])); a[4 + j] = a[4 + j] * d1[j] + (j & 1 ? bf_hi(lw[2 + (j >> 1)]) : bf_lo(lw[2 + (j >> 1)])); } }
        v4u w; w.x = cvtpk(a[0], a[1]); w.y = cvtpk(a[2], a[3]); w.z = cvtpk(a[4], a[5]); w.w = cvtpk(a[6], a[7]); bfr[ks] = __builtin_bit_cast(v8s, w); }
    v4u pq[4];
#define GF_PREFETCH(cc) do { const size_t it_ = (size_t)bh4 * 64 + (cc); \
        _Pragma("unroll") for (int i = 0; i < 4; ++i) pq[i] = *(const v4u*)(QT + it_ * 16384 + (tid + 512 * i) * 8); } while (0)
    GF_PREFETCH(seg * SEGC);
    for (int ci = 0; ci < SEGC; ++ci) { const int c = seg * SEGC + ci;
        __syncthreads();
#pragma unroll
        for (int i = 0; i < 4; ++i) { const int idx = tid + 512 * i, t = idx >> 5, kc = (idx & 31) * 8;
            const v4f p0 = lds_ld<v4f>(lds, L_P + (ci * 256 + kc) * 4), p1 = lds_ld<v4f>(lds, L_P + (ci * 256 + kc + 4) * 4);
            v4u w; w.x = cvtpk(bf_lo(pq[i].x) * p0[0], bf_hi(pq[i].x) * p0[1]); w.y = cvtpk(bf_lo(pq[i].y) * p0[2], bf_hi(pq[i].y) * p0[3]);
            w.z = cvtpk(bf_lo(pq[i].z) * p1[0], bf_hi(pq[i].z) * p1[1]); w.w = cvtpk(bf_lo(pq[i].w) * p1[2], bf_hi(pq[i].w) * p1[3]);
            lds_st<v4u>(lds, L_Q + t * QROW + kc * 2, w); }
        __syncthreads();
        if (ci + 1 < SEGC) GF_PREFETCH(c + 1);
        v4f o[4];
#pragma unroll
        for (int mt = 0; mt < 4; ++mt) o[mt] = (v4f){0.f, 0.f, 0.f, 0.f};
#pragma unroll
        for (int ks = 0; ks < 8; ++ks)
#pragma unroll
            for (int mt = 0; mt < 4; ++mt) { const v8s a = lds_ld<v8s>(lds, L_Q + (16 * mt + l15) * QROW + (32 * ks + 8 * q4) * 2); o[mt] = MFMA16(a, bfr[ks], o[mt]); }
        float* op = ORAW + ((size_t)b * SEQ + 64 * c) * 2048 + h * 512 + vcol;
#pragma unroll
        for (int mt = 0; mt < 4; ++mt)
#pragma unroll
            for (int r = 0; r < 4; ++r) op[(size_t)(16 * mt + 4 * q4 + r) * 2048] += o[mt][r];
    }
#undef GF_PREFETCH
}

__device__ __forceinline__ void fox_unit(lds_t lds, int bh, int qi, const unsigned char* ws, int tid) {
    asm volatile("" : "+v"(tid));
    const bf16* FQ = (const bf16*)(ws + WS_FQ); const bf16* FK = (const bf16*)(ws + WS_FK); const bf16* FVT = (const bf16*)(ws + WS_FVT); const float* CB = (const float*)(ws + WS_CB); bf16* OF = (bf16*)(ws + WS_OF);
    const int lane = tid & 63, wid = tid >> 6, r32 = lane & 31, hi = lane >> 5, rg = wid & 3, par = wid >> 2;
    const int b = bh >> 3, h = bh & 7; const size_t rowbase = (size_t)b * SEQ; const int q0 = qi * 128;
    constexpr int KROW = 272, VROW = 136, TILEB = 17408, L_V0 = 2 * TILEB;
    const size_t qrow = rowbase + q0 + 32 * rg + r32;
    constexpr int L_QF = 4 * TILEB;
#pragma unroll
    for (int i = 0; i < 4; ++i) { const int idx = tid + 512 * i; lds_st<v4u>(lds, L_QF + (idx >> 4) * KROW + (idx & 15) * 16, *(const v4u*)(FQ + (rowbase + q0 + (idx >> 4)) * 1024 + h * 128 + (idx & 15) * 8)); }
    const int qb = L_QF + (32 * rg + r32) * KROW + 16 * hi;
    v16f o[4];
#pragma unroll
    for (int d = 0; d < 4; ++d)
#pragma unroll
        for (int r = 0; r < 16; ++r) o[d][r] = 0.f;
    const float NEG = -__builtin_inff();
    float m = NEG, l = 0.f;
    const int niter = qi + 1;
    v4u pk[4], pv[4];
#define FX_PREFETCH(it) do { \
        _Pragma("unroll") for (int i = 0; i < 4; ++i) { const int idx = tid + 512 * i, tile = idx >> 10; \
            pk[i] = *(const v4u*)(FK + (rowbase + (size_t)(2 * (it) + tile) * 64 + ((idx >> 4) & 63)) * 1024 + h * 128 + (idx & 15) * 8); \
            pv[i] = *(const v4u*)(FVT + ((size_t)bh * 128 + ((idx >> 3) & 127)) * SEQ + (2 * (it) + tile) * 64 + (idx & 7) * 8); } } while (0)
    FX_PREFETCH(0);
    for (int it = 0; it < niter; ++it) {
        __syncthreads();
#pragma unroll
        for (int i = 0; i < 4; ++i) { const int idx = tid + 512 * i, tile = idx >> 10;
            lds_st<v4u>(lds, tile * TILEB + ((idx >> 4) & 63) * KROW + (idx & 15) * 16, pk[i]);
            const int vo = L_V0 + tile * TILEB + ((idx >> 3) & 127) * VROW + (idx & 7) * 16;
            lds_st<v2u>(lds, vo, (v2u){pv[i].x, pv[i].y}); lds_st<v2u>(lds, vo + 8, (v2u){pv[i].z, pv[i].w}); }
        __syncthreads();
        if (it + 1 < niter) FX_PREFETCH(it + 1);
        const int ks0 = (2 * it + par) * 64;
        if (ks0 <= q0 + 32 * rg) {
            v16f s0, s1;
            { const float* cb = CB + (size_t)bh * SEQ + ks0 + 4 * hi;
#pragma unroll
              for (int g = 0; g < 4; ++g) { const v4f b0 = *(const v4f*)(cb + 8 * g), b1 = *(const v4f*)(cb + 32 + 8 * g);
#pragma unroll
                  for (int j = 0; j < 4; ++j) { s0[4 * g + j] = b0[j]; s1[4 * g + j] = b1[j]; } } }
            const int kb = par * TILEB + r32 * KROW + 16 * hi;
#pragma unroll
            for (int s = 0; s < 8; ++s) { const v8s a0 = lds_ld<v8s>(lds, kb + 32 * s), a1 = lds_ld<v8s>(lds, kb + 32 * KROW + 32 * s), qv = lds_ld<v8s>(lds, qb + 32 * s); s0 = MFMA32(a0, qv, s0); s1 = MFMA32(a1, qv, s1); }
            if (ks0 + 63 > q0 + 32 * rg) { const int qabs = q0 + 32 * rg + r32;
#pragma unroll
                for (int r = 0; r < 16; ++r) { const int kv = ks0 + (r & 3) + 8 * (r >> 2) + 4 * hi; if (kv > qabs) s0[r] = NEG; if (kv + 32 > qabs) s1[r] = NEG; } }
            float rm = fmaxf(s0[0], s1[0]);
#pragma unroll
            for (int r = 1; r < 16; ++r) rm = fmaxf(rm, fmaxf(s0[r], s1[r]));
            rm = fmaxf(rm, __shfl_xor(rm, 32));
            const float mn = fmaxf(m, rm), alpha = __builtin_amdgcn_exp2f(m - mn); m = mn;
            float ps = 0.f;
#pragma unroll
            for (int r = 0; r < 16; ++r) { s0[r] = __builtin_amdgcn_exp2f(s0[r] - mn); s1[r] = __builtin_amdgcn_exp2f(s1[r] - mn); ps += s0[r] + s1[r]; }
            l = l * alpha + ps;
#pragma unroll
            for (int d = 0; d < 4; ++d)
#pragma unroll
                for (int r = 0; r < 16; ++r) o[d][r] *= alpha;
            v8s pf[4];
            { v4u w;
              w.x = cvtpk(s0[0], s0[1]); w.y = cvtpk(s0[2], s0[3]); w.z = cvtpk(s0[4], s0[5]); w.w = cvtpk(s0[6], s0[7]); pf[0] = __builtin_bit_cast(v8s, w);
              w.x = cvtpk(s0[8], s0[9]); w.y = cvtpk(s0[10], s0[11]); w.z = cvtpk(s0[12], s0[13]); w.w = cvtpk(s0[14], s0[15]); pf[1] = __builtin_bit_cast(v8s, w);
              w.x = cvtpk(s1[0], s1[1]); w.y = cvtpk(s1[2], s1[3]); w.z = cvtpk(s1[4], s1[5]); w.w = cvtpk(s1[6], s1[7]); pf[2] = __builtin_bit_cast(v8s, w);
              w.x = cvtpk(s1[8], s1[9]); w.y = cvtpk(s1[10], s1[11]); w.z = cvtpk(s1[12], s1[13]); w.w = cvtpk(s1[14], s1[15]); pf[3] = __builtin_bit_cast(v8s, w); }
            const int vb = L_V0 + par * TILEB + r32 * VROW + 8 * hi;
#pragma unroll
            for (int d = 0; d < 4; ++d)
#pragma unroll
                for (int kk = 0; kk < 4; ++kk) { const v2u lo = lds_ld<v2u>(lds, vb + 32 * d * VROW + 32 * kk), hh = lds_ld<v2u>(lds, vb + 32 * d * VROW + 32 * kk + 16);
                    const v4u aw = (v4u){lo.x, lo.y, hh.x, hh.y}; o[d] = MFMA32(__builtin_bit_cast(v8s, aw), pf[kk], o[d]); }
        }
    }
#undef FX_PREFETCH
    l += __shfl_xor(l, 32);
    __syncthreads();
    constexpr int L_ML = 65536;
    if (par == 1) {
#pragma unroll
        for (int d = 0; d < 4; ++d)
#pragma unroll
            for (int r = 0; r < 16; ++r) lds_st<float>(lds, ((rg * 64 + d * 16 + r) * 64 + lane) * 4, o[d][r]);
        lds_st<float>(lds, L_ML + (rg * 128 + lane) * 4, m); lds_st<float>(lds, L_ML + (rg * 128 + 64 + lane) * 4, l);
    }
    __syncthreads();
    if (par == 0) {
        const float m1 = lds_ld<float>(lds, L_ML + (rg * 128 + lane) * 4), l1 = lds_ld<float>(lds, L_ML + (rg * 128 + 64 + lane) * 4);
        const float mt = fmaxf(m, m1), a0 = __builtin_amdgcn_exp2f(m - mt), a1 = __builtin_amdgcn_exp2f(m1 - mt);
        const float inv = 1.0f / (l * a0 + l1 * a1);
        bf16* op = OF + qrow * 1024 + h * 128 + 4 * hi;
#pragma unroll
        for (int d = 0; d < 4; ++d)
#pragma unroll
            for (int g = 0; g < 4; ++g) { float v[4];
#pragma unroll
                for (int j = 0; j < 4; ++j) v[j] = (o[d][4 * g + j] * a0 + lds_ld<float>(lds, ((rg * 64 + d * 16 + 4 * g + j) * 64 + lane) * 4) * a1) * inv;
                *(v2u*)(op + 32 * d + 8 * g) = (v2u){cvtpk(v[0], v[1]), cvtpk(v[2], v[3])}; }
    }
}

__device__ __forceinline__ void gla_norm_pass(unsigned char* ws, const float* gng, int G) {
    const float* ORAW = (const float*)(ws + WS_ORAW); bf16* GR = (bf16*)(ws + WS_GR);
    const int lane = threadIdx.x & 63; const int gw = blockIdx.x * 8 + (threadIdx.x >> 6), NGW = G * 8;
    for (int it = gw; it < MTOK * 4; it += NGW) {
        const size_t off = (size_t)it * 512 + lane * 8;
        const v4f a = *(const v4f*)(ORAW + off), b = *(const v4f*)(ORAW + off + 4);
        float ss = (a[0] * a[0] + a[1] * a[1]) + (a[2] * a[2] + a[3] * a[3]) + (b[0] * b[0] + b[1] * b[1]) + (b[2] * b[2] + b[3] * b[3]);
        ss = wave_sum(ss);
        const float rstd = 1.0f / sqrtf(ss * (1.0f / 512.0f) + RMS_EPS);
        const v4u gw4 = *(const v4u*)(GR + off); const v4f g0 = *(const v4f*)(gng + lane * 8), g1 = *(const v4f*)(gng + lane * 8 + 4);
        float gr[8];
#pragma unroll
        for (int j = 0; j < 4; ++j) { gr[2 * j] = bf_lo(gw4[j]); gr[2 * j + 1] = bf_hi(gw4[j]); }
        float r[8];
#pragma unroll
        for (int j = 0; j < 4; ++j) { r[j] = a[j] * rstd * g0[j] * (gr[j] * pg8::fsigmoid(gr[j])); r[4 + j] = b[j] * rstd * g1[j] * (gr[4 + j] * pg8::fsigmoid(gr[4 + j])); }
        v4u o; o.x = cvtpk(r[0], r[1]); o.y = cvtpk(r[2], r[3]); o.z = cvtpk(r[4], r[5]); o.w = cvtpk(r[6], r[7]);
        *(v4u*)(GR + off) = o;
    }
}
__device__ __forceinline__ void ln_pass(const float* src, float* dst, bf16* dstb, const float* g, const float* bta, int G) {
    const int lane = threadIdx.x & 63; const int gw = blockIdx.x * 8 + (threadIdx.x >> 6), NGW = G * 8;
    for (int row = gw; row < MTOK; row += NGW) {
        const float* xr = src + (size_t)row * DM + lane * 4;
        v4f v[8]; float s = 0.f;
#pragma unroll
        for (int j = 0; j < 8; ++j) { v[j] = *(const v4f*)(xr + 256 * j); s += (v[j][0] + v[j][1]) + (v[j][2] + v[j][3]); }
        const float mean = wave_sum(s) * (1.0f / DM); float s2 = 0.f;
#pragma unroll
        for (int j = 0; j < 8; ++j) { v[j] = v[j] - mean; s2 += (v[j][0] * v[j][0] + v[j][1] * v[j][1]) + (v[j][2] * v[j][2] + v[j][3] * v[j][3]); }
        const float rstd = 1.0f / sqrtf(wave_sum(s2) * (1.0f / DM) + LN_EPS);
#pragma unroll
        for (int j = 0; j < 8; ++j) { const v4f gg = *(const v4f*)(g + lane * 4 + 256 * j), bb = *(const v4f*)(bta + lane * 4 + 256 * j); const v4f y = v[j] * rstd * gg + bb;
            *(v4f*)(dst + (size_t)row * DM + lane * 4 + 256 * j) = y;
            *(v2u*)(dstb + (size_t)row * DM + lane * 4 + 256 * j) = (v2u){cvtpk(y[0], y[1]), cvtpk(y[2], y[3])}; }
    }
}

#ifndef PH
#define PH 0xFFFF
#endif
#ifndef PROBE
#define PROBE 0
#endif
struct Args { const float* in[21]; float* out; unsigned char* ws; };
__global__ void __launch_bounds__(512, 2) mega_fwd(Args args) {
    extern __shared__ __attribute__((aligned(16))) unsigned char lds_raw[];
    lds_t lds = (lds_t)lds_raw;
    volatile LAS unsigned* MISC = (volatile LAS unsigned*)(lds + MISC_OFF);
    const int tid = threadIdx.x, G = gridDim.x;
    unsigned char* ws = args.ws;
    unsigned* ctl = (unsigned*)(ws + WS_CTL);
    if (tid < 64) MISC[tid] = 0u;
    __syncthreads();
    XcdBarrier bar = xcd_barrier_post(ctl + CW_BAR, MISC + 8);
#if PROBE
    int nstamp = 0;
#define STAMP() do { if (blockIdx.x == 0 && tid == 0) MISC[32 + nstamp] = (unsigned)__builtin_amdgcn_s_memrealtime(); ++nstamp; } while (0)
#else
#define STAMP() do { } while (0)
#endif
#define GRID_BAR() do { xcd_barrier(bar); STAMP(); } while (0)
    STAMP();

    if (PH & 1) p0_prologue(lds, args.in, ws, G);
    cg::this_grid().sync();
    STAMP();

    if (PH & 2) { pg8::Gemm g{(const pg8::bf16_t*)(ws + WS_XB), (const pg8::bf16_t*)(ws + WS_WIN), MTOK, NPAD, DM}; pg8::StaticOrder S; S.init(MTOK, NPAD, G, (int)blockIdx.x);
      pg8::EpiProj E{ws, 0.08838834764831845f * LOG2E};
      pg8::gemm_phase<pg8::EpiProj, pg8::StaticOrder, true, true>(lds, g, S, E); }
    GRID_BAR();

    if (PH & 4) for (int it = blockIdx.x; it < 512 + 1024 + 16; it += G) {
        if (it < 512) gla_prep_item(lds, it, ws, args.in[3], args.in[4], tid);
        else if (it < 1536) fv_tr_item(lds, it - 512, ws, tid);
        else fox_cumsum_item(lds, it - 1536, ws, args.in[6], tid);
    }
    GRID_BAR();

    if (PH & 8) for (int it = blockIdx.x; it < 32 * NSEG; it += G) gla_scan_item(lds, it, ws, tid);
#if PROBE
    if (blockIdx.x == 0 && tid == 0) MISC[31] = (unsigned)__builtin_amdgcn_s_memrealtime();
#endif
    if (PH & 16) for (;;) {
        __syncthreads();
        if (tid == 0) MISC[16] = __hip_atomic_fetch_add(ctl + CW_QUEUE, 1u, RLX_AGENT);
        __syncthreads();
        const int j = (int)MISC[16];
        if (j >= 512) break;
        fox_unit(lds, j & 15, 31 - (j >> 4), ws, tid);
    }
    GRID_BAR();
    if (PH & 0x4000) for (int it = blockIdx.x; it < 32 * NSEG; it += G) { if ((it & (NSEG - 1)) != 0) gla_fix_item(lds, it, ws, tid); }
    GRID_BAR();

    if (PH & 32) gla_norm_pass(ws, args.in[5], G);
    GRID_BAR();

    if (PH & 64) { pg8::StaticOrder S; S.init(MTOK, DM, G, (int)blockIdx.x);
      { pg8::Gemm g{(const pg8::bf16_t*)(ws + WS_OG), (const pg8::bf16_t*)(ws + WS_WBG), MTOK, DM, 2048};
        pg8::EpiEw<1> E{(float*)(ws + WS_YTMP), nullptr, nullptr, (const pg8::bf16_t*)(ws + WS_MA), DM, 0.f};
        pg8::gemm_phase<pg8::EpiEw<1>, pg8::StaticOrder, false, true>(lds, g, S, E); }
      asm volatile("s_waitcnt vmcnt(0)" ::: "memory"); __syncthreads();
      { pg8::Gemm g{(const pg8::bf16_t*)(ws + WS_OF), (const pg8::bf16_t*)(ws + WS_WBF), MTOK, DM, 1024};
        pg8::EpiEw<2> E{nullptr, (pg8::bf16_t*)(ws + WS_MERGED), (const float*)(ws + WS_YTMP), (const pg8::bf16_t*)(ws + WS_MB), DM, 0.f};
        pg8::gemm_phase<pg8::EpiEw<2>, pg8::StaticOrder, false, true>(lds, g, S, E); } }
    GRID_BAR();

    if (PH & 128) { pg8::StaticOrder S; S.init(MTOK, DM, G, (int)blockIdx.x);
      pg8::Gemm g{(const pg8::bf16_t*)(ws + WS_MERGED), (const pg8::bf16_t*)(ws + WS_WOUT), MTOK, DM, 2048};
      pg8::EpiEw<3> E{(float*)(ws + WS_X1), nullptr, args.in[0], nullptr, DM, ALPHA_RES};
      pg8::gemm_phase<pg8::EpiEw<3>, pg8::StaticOrder, false, true>(lds, g, S, E); }
    GRID_BAR();
    if (PH & 256) ln_pass((const float*)(ws + WS_X1), (float*)(ws + WS_X1), (bf16*)(ws + WS_XNB), args.in[10], args.in[11], G);
    GRID_BAR();

    if (PH & 512) { pg8::StaticOrder S; S.init(MTOK, FF, G, (int)blockIdx.x);
      pg8::Gemm g{(const pg8::bf16_t*)(ws + WS_XNB), (const pg8::bf16_t*)(ws + WS_WG), MTOK, FF, 2048};
      pg8::EpiBf E{(pg8::bf16_t*)(ws + WS_G), FF};
      pg8::gemm_phase<pg8::EpiBf, pg8::StaticOrder, true, true>(lds, g, S, E); }
    GRID_BAR();
    if (PH & 1024) { pg8::StaticOrder S; S.init(MTOK, FF, G, (int)blockIdx.x);
      pg8::Gemm g{(const pg8::bf16_t*)(ws + WS_XNB), (const pg8::bf16_t*)(ws + WS_WU), MTOK, FF, 2048};
      pg8::EpiUp E{(const pg8::bf16_t*)(ws + WS_G), (pg8::bf16_t*)(ws + WS_H), args.in[14], args.in[15]};
      pg8::gemm_phase<pg8::EpiUp, pg8::StaticOrder, true, true>(lds, g, S, E); }
    GRID_BAR();
    if (PH & 2048) { pg8::StaticOrder S; S.init(MTOK, DM, G, (int)blockIdx.x);
      pg8::Gemm g{(const pg8::bf16_t*)(ws + WS_H), (const pg8::bf16_t*)(ws + WS_WD), MTOK, DM, FF};
      pg8::EpiEw<3> E{(float*)(ws + WS_V2), nullptr, (const float*)(ws + WS_X1), nullptr, DM, ALPHA_RES};
      pg8::gemm_phase<pg8::EpiEw<3>, pg8::StaticOrder, false, true>(lds, g, S, E); }
    GRID_BAR();
    if (PH & 4096) ln_pass((const float*)(ws + WS_V2), args.out, (bf16*)(ws + WS_XNB), args.in[17], args.in[18], G);
    GRID_BAR();

    if (PH & 8192) { pg8::StaticOrder S; S.init(MTOK, DM, G, (int)blockIdx.x);
      { pg8::Gemm g{(const pg8::bf16_t*)(ws + WS_PB), (const pg8::bf16_t*)(ws + WS_WPP), MTOK, DM, PLE};
        pg8::EpiEw<0> E{(float*)(ws + WS_TMP), nullptr, nullptr, nullptr, DM, 0.f};
        pg8::gemm_phase<pg8::EpiEw<0>, pg8::StaticOrder, false, true>(lds, g, S, E); }
      asm volatile("s_waitcnt vmcnt(0)" ::: "memory"); __syncthreads();
      { pg8::Gemm g{(const pg8::bf16_t*)(ws + WS_XNB), (const pg8::bf16_t*)(ws + WS_WPG), MTOK, DM, 2048};
        pg8::EpiEw<4> E{args.out, nullptr, (const float*)(ws + WS_TMP), nullptr, DM, 0.f};
        pg8::gemm_phase<pg8::EpiEw<4>, pg8::StaticOrder, false, true>(lds, g, S, E); } }
#if PROBE
    GRID_BAR();
    if (blockIdx.x == 0 && tid == 0) {
        const unsigned ta = (PROBE_A == 99) ? (MISC[31] - MISC[32 + 3]) : (MISC[32 + PROBE_A + 1] - MISC[32 + PROBE_A]);
        const unsigned tb = (PROBE_B == 99) ? (MISC[31] - MISC[32 + 3]) : (MISC[32 + PROBE_B + 1] - MISC[32 + PROBE_B]);
        __hip_atomic_store(ctl + 80, ta, RLX_AGENT); __hip_atomic_store(ctl + 81, tb, RLX_AGENT);
    }
    GRID_BAR();
    { unsigned na = __hip_atomic_load(ctl + 80, RLX_AGENT) * 40u; const unsigned tb = __hip_atomic_load(ctl + 81, RLX_AGENT);
      if (na > 8000000u) na = 8000000u;
      for (unsigned i = blockIdx.x * 512 + tid; i < na; i += G * 512) args.out[i] += 0.008f;
      const unsigned long long t0 = __builtin_amdgcn_s_memrealtime();
      while (__builtin_amdgcn_s_memrealtime() - t0 < 2ull * tb) __builtin_amdgcn_s_sleep(8); }
#endif
}

extern "C" void kernel_launch(void* const* d_in, const int* in_sizes, int n_in, void* d_out, int out_size, void* d_ws, size_t ws_size, hipStream_t stream) {
    static int grid = 0;
    if (grid == 0) {
        if (n_in != 21 || in_sizes[0] != MTOK * DM || out_size != MTOK * DM || ws_size < WS_END) { fprintf(stderr, "kernel_launch: unexpected shapes (n_in %d, in0 %d, out %d, ws %zu < %zu)\n", n_in, n_in > 0 ? in_sizes[0] : -1, out_size, ws_size, (size_t)WS_END); grid = -1; return; }
        int dev = 0, cus = 0, per_cu = 0;
        if (hipGetDevice(&dev) != hipSuccess || hipDeviceGetAttribute(&cus, hipDeviceAttributeMultiprocessorCount, dev) != hipSuccess) { fprintf(stderr, "kernel_launch: device query failed\n"); grid = -1; return; }
        if (hipFuncSetAttribute((const void*)mega_fwd, hipFuncAttributeMaxDynamicSharedMemorySize, LDS_BYTES) != hipSuccess) { fprintf(stderr, "kernel_launch: hipFuncSetAttribute failed\n"); grid = -1; return; }
        if (hipOccupancyMaxActiveBlocksPerMultiprocessor(&per_cu, (const void*)mega_fwd, 512, LDS_BYTES) != hipSuccess || per_cu < 1) { fprintf(stderr, "kernel_launch: occupancy query says %d blocks per CU\n", per_cu); per_cu = 1; }
        (void)hipGetLastError();
        grid = cus;
    }
    if (grid < 0) return;
    if (hipMemsetAsync((char*)d_ws + WS_CTL, 0, CTL_ZERO_BYTES, stream) != hipSuccess) { fprintf(stderr, "kernel_launch: memset failed\n"); return; }
    Args a{};
    for (int i = 0; i < 21; ++i) a.in[i] = (const float*)d_in[i];
    a.out = (float*)d_out; a.ws = (unsigned char*)d_ws;
    void* kargs[] = {&a};
    const hipError_t e = hipLaunchCooperativeKernel((const void*)mega_fwd, dim3(grid), dim3(512), kargs, LDS_BYTES, stream);
    if (e != hipSuccess) fprintf(stderr, "kernel_launch: cooperative launch failed: %s (grid %d)\n", hipGetErrorString(e), grid);
}
```

```cpp
#include <hip/hip_runtime.h>
#include <hip/hip_cooperative_groups.h>
#include <cstdio>
#include <cstdint>
namespace cg = cooperative_groups;

constexpr int BATCH = 2, SEQ = 4096, DM = 2048, MTOK = BATCH * SEQ;
constexpr int N_IN = 13336, NPAD = 13568, FF = 5632, PLE = 256;
constexpr float ALPHA_RES = 1.189207115002721f;
constexpr float LN_EPS = 1e-5f, RMS_EPS = 1e-6f;
constexpr float LOG2E = 1.4426950408889634f;

constexpr size_t MiB = 1u << 20;
constexpr size_t WS_CTL = 0, CTL_ZERO_BYTES = 65536;
constexpr size_t WS_WBG = 1 * MiB, WS_WBF = 9 * MiB, WS_WOUT = 13 * MiB, WS_WG = 21 * MiB, WS_WU = 43 * MiB, WS_WD = 65 * MiB, WS_WPG = 87 * MiB, WS_WPP = 95 * MiB;
constexpr size_t WS_PB = 96 * MiB;
constexpr size_t WS_R1 = 100 * MiB;
constexpr size_t WS_WIN = WS_R1, WS_XB = WS_R1 + 53 * MiB;
constexpr size_t WS_QT = WS_R1, WS_KT = WS_R1 + 16 * MiB, WS_VT = WS_R1 + 32 * MiB, WS_ATT = WS_R1 + 64 * MiB, WS_DEC = WS_R1 + 68 * MiB, WS_FVT = WS_R1 + 69 * MiB, WS_CB = WS_R1 + 85 * MiB;
constexpr size_t WS_YTMP = WS_R1;
constexpr size_t WS_G = WS_R1;
constexpr size_t WS_V2 = WS_R1;
constexpr size_t WS_GQ = 188 * MiB, WS_GK = 204 * MiB, WS_GV = 220 * MiB, WS_GR = 252 * MiB, WS_FQ = 284 * MiB, WS_FK = 300 * MiB, WS_FV = 316 * MiB, WS_MB = 332 * MiB, WS_MA = 364 * MiB, WS_SM = 396 * MiB;
constexpr size_t WS_ORAW = WS_GQ;
constexpr size_t WS_X1 = WS_GQ;
constexpr size_t WS_OG = WS_GR, WS_OF = WS_FQ, WS_MERGED = WS_FK;
constexpr size_t WS_H = WS_GR;
constexpr size_t WS_TMP = WS_GR;
constexpr size_t WS_XNB = WS_MA;
constexpr size_t WS_LSEG = 397 * MiB;
constexpr size_t WS_PDEC = 413 * MiB;
constexpr size_t WS_DSEG = 413 * MiB + 512 * 1024;
constexpr size_t WS_END = 414 * MiB;
constexpr int CW_QUEUE = 64;
constexpr int CW_BAR = 4096;

constexpr int LDS_BYTES = 147456;
constexpr int MISC_OFF = LDS_BYTES - 256;
#define LAS __attribute__((address_space(3)))
typedef LAS unsigned char* lds_t;
namespace pg8 {
#define PG8_LAS __attribute__((address_space(3)))
typedef unsigned short bf16_t;
typedef short bf16x8 __attribute__((ext_vector_type(8)));
typedef float f32x4 __attribute__((ext_vector_type(4)));
typedef unsigned u32x4 __attribute__((ext_vector_type(4)));
constexpr int BM = 256, BK = 64, HALF = 128, HTB = HALF * BK * 2  , STAGE_BYTES = 8 * HTB, NXCD = 8, WGM = 8;

__host__ __device__ __forceinline__ int lds_byte(int r, int c) { const int st = (r >> 4) * 2 + (c >> 5), rr = r & 15, cc = c & 31, ob = rr * 64 + cc * 2; return st * 1024 + (ob ^ (((ob >> 9) & 1) << 5)); }
__host__ __device__ __forceinline__ void stage_rc(int b, int& R, int& C) { const int st = b / 1024, sb = b % 1024, swz = sb ^ (((sb >> 9) & 1) << 5); R = (st >> 1) * 16 + swz / 64; C = (st & 1) * 32 + (swz % 64) / 2; }
__host__ __device__ __forceinline__ int perm32(int rho) { const int n = rho >> 4, i = rho & 15; return 8 * (i >> 2) + 4 * n + (i & 3); }

struct Unit { int pm, pn; };
struct Gemm { const bf16_t* A; const bf16_t* Bt; int M, N, K; };

struct StaticOrder {
    int nM, nN, nwg, G, c;
    __host__ __device__ void init(int M, int N, int G_, int c_) { nM = M / BM; nN = N / BM; nwg = nM * nN; G = G_; c = c_; }
    __host__ __device__ bool next(int i, Unit& u) const {
        const long L = (long)i * G + c; if (L >= nwg) return false;
        int wgid = (int)L; { const int q = nwg / NXCD, r = nwg % NXCD, xcd = wgid % NXCD, off = wgid / NXCD; wgid = (xcd < r ? xcd * (q + 1) : r * (q + 1) + (xcd - r) * q) + off; }
        const int nig = WGM * nN, gid = wgid / nig, fm = gid * WGM, gsz = (nM - fm) < WGM ? (nM - fm) : WGM;
        u.pm = fm + ((wgid % nig) % gsz); u.pn = (wgid % nig) / gsz; return true;
    }
    __device__ __forceinline__ void a_ready(const Unit&) const {}
    __device__ __forceinline__ void done(const Unit&) const {}
};

__device__ __forceinline__ unsigned cvt_pk_bf16(float lo, float hi) { unsigned r; asm volatile("v_cvt_pk_bf16_f32 %0, %1, %2" : "=v"(r) : "v"(lo), "v"(hi)); return r; }
typedef float f32x2 __attribute__((ext_vector_type(2)));

__device__ __forceinline__ float fsigmoid(float x) { return __builtin_amdgcn_rcpf(1.0f + __builtin_amdgcn_exp2f(-1.4426950408889634f * x)); }
__device__ __forceinline__ void unpack8(const u32x4 w, float (&f)[8]) {
#pragma unroll
    for (int i = 0; i < 4; ++i) { f[2 * i] = __uint_as_float(w[i] << 16); f[2 * i + 1] = __uint_as_float(w[i] & 0xffff0000u); }
}
__device__ __forceinline__ u32x4 pack8(const f32x4 a, const f32x4 b) { u32x4 w; w.x = cvt_pk_bf16(a[0], a[1]); w.y = cvt_pk_bf16(a[2], a[3]); w.z = cvt_pk_bf16(b[0], b[1]); w.w = cvt_pk_bf16(b[2], b[3]); return w; }

struct EpiProj {
    static constexpr bool PERM = true, AFTER_DRAIN = false;
    unsigned char* ws; float qscale;
    __device__ __forceinline__ void operator()(const f32x4 (&acc)[2][2][4][2], const Unit& u, int wr, int wc, int fr, int fq) const {
        const int pn = u.pn; const int row0 = u.pm * BM + wr * 64 + fr;
        if (pn == 52) {
            if (wc == 0) { float* sm = (float*)(ws + WS_SM);
#pragma unroll
                for (int ai = 0; ai < 2; ++ai)
#pragma unroll
                    for (int m = 0; m < 4; ++m) { float* rp = sm + (size_t)(row0 + ai * HALF + m * 16) * 32 + 8 * fq; *(f32x4*)rp = acc[ai][0][m][0]; *(f32x4*)(rp + 4) = acc[ai][0][m][1]; } }
            return;
        }
        size_t off; int ldc, ct; float sc = 1.f;
        if (pn < 4) { off = WS_GQ; ldc = 1024; ct = pn; }
        else if (pn < 8) { off = WS_GK; ldc = 1024; ct = pn - 4; }
        else if (pn < 16) { off = WS_GV; ldc = 2048; ct = pn - 8; }
        else if (pn < 24) { off = WS_GR; ldc = 2048; ct = pn - 16; }
        else if (pn < 28) { off = WS_FQ; ldc = 1024; ct = pn - 24; sc = qscale; }
        else if (pn < 32) { off = WS_FK; ldc = 1024; ct = pn - 28; }
        else if (pn < 36) { off = WS_FV; ldc = 1024; ct = pn - 32; }
        else if (pn < 44) { off = WS_MA; ldc = 2048; ct = pn - 36; }
        else { off = WS_MB; ldc = 2048; ct = pn - 44; }
        bf16_t* base = (bf16_t*)(ws + off); const int col0 = ct * BM + wc * 32 + 8 * fq;
#pragma unroll
        for (int ai = 0; ai < 2; ++ai)
#pragma unroll
            for (int m = 0; m < 4; ++m) { bf16_t* rowp = base + (size_t)(row0 + ai * HALF + m * 16) * ldc + col0;
#pragma unroll
                for (int bj = 0; bj < 2; ++bj) *(u32x4*)(rowp + bj * HALF) = pack8(acc[ai][bj][m][0] * sc, acc[ai][bj][m][1] * sc); }
    }
};
struct EpiBf {
    static constexpr bool PERM = true, AFTER_DRAIN = false;
    bf16_t* O; int ldc;
    __device__ __forceinline__ void operator()(const f32x4 (&acc)[2][2][4][2], const Unit& u, int wr, int wc, int fr, int fq) const {
        const int row0 = u.pm * BM + wr * 64 + fr, col0 = u.pn * BM + wc * 32 + 8 * fq;
#pragma unroll
        for (int ai = 0; ai < 2; ++ai)
#pragma unroll
            for (int m = 0; m < 4; ++m) { bf16_t* rowp = O + (size_t)(row0 + ai * HALF + m * 16) * ldc + col0;
#pragma unroll
                for (int bj = 0; bj < 2; ++bj) *(u32x4*)(rowp + bj * HALF) = pack8(acc[ai][bj][m][0], acc[ai][bj][m][1]); }
    }
};
template <int MODE> struct EpiEw {
    static constexpr bool PERM = true, AFTER_DRAIN = false;
    float* O32; bf16_t* Obf; const float* I32; const bf16_t* GATE; int ldc; float alpha;
    __device__ __forceinline__ void operator()(const f32x4 (&acc)[2][2][4][2], const Unit& u, int wr, int wc, int fr, int fq) const {
        const int row0 = u.pm * BM + wr * 64 + fr, col0 = u.pn * BM + wc * 32 + 8 * fq;
#pragma unroll
        for (int ai = 0; ai < 2; ++ai)
#pragma unroll
            for (int m = 0; m < 4; ++m) { const size_t ro = (size_t)(row0 + ai * HALF + m * 16) * ldc + col0;
#pragma unroll
                for (int bj = 0; bj < 2; ++bj) { const size_t o = ro + bj * HALF; f32x4 a0 = acc[ai][bj][m][0], a1 = acc[ai][bj][m][1];
                    if (MODE == 0) { *(f32x4*)(O32 + o) = a0; *(f32x4*)(O32 + o + 4) = a1; }
                    if (MODE == 1 || MODE == 2) { float g[8]; unpack8(*(const u32x4*)(GATE + o), g);
#pragma unroll
                        for (int j = 0; j < 4; ++j) { a0[j] *= fsigmoid(g[j]); a1[j] *= fsigmoid(g[4 + j]); }
                        if (MODE == 1) { *(f32x4*)(O32 + o) = a0; *(f32x4*)(O32 + o + 4) = a1; }
                        else { const f32x4 i0 = *(const f32x4*)(I32 + o), i1 = *(const f32x4*)(I32 + o + 4); *(u32x4*)(Obf + o) = pack8(a0 + i0, a1 + i1); } }
                    if (MODE == 3) { const f32x4 i0 = *(const f32x4*)(I32 + o), i1 = *(const f32x4*)(I32 + o + 4); *(f32x4*)(O32 + o) = i0 * alpha + a0; *(f32x4*)(O32 + o + 4) = i1 * alpha + a1; }
                    if (MODE == 4) { const f32x4 i0 = *(const f32x4*)(I32 + o), i1 = *(const f32x4*)(I32 + o + 4); f32x4 x0 = *(const f32x4*)(O32 + o), x1 = *(const f32x4*)(O32 + o + 4);
#pragma unroll
                        for (int j = 0; j < 4; ++j) { x0[j] += fsigmoid(a0[j]) * i0[j]; x1[j] += fsigmoid(a1[j]) * i1[j]; }
                        *(f32x4*)(O32 + o) = x0; *(f32x4*)(O32 + o + 4) = x1; }
                } }
    }
};
struct EpiUp {
    static constexpr bool PERM = true, AFTER_DRAIN = false;
    const bf16_t* G; bf16_t* H; const float* cw; const float* cb;
    __device__ __forceinline__ void operator()(const f32x4 (&acc)[2][2][4][2], const Unit& u, int wr, int wc, int fr, int fq) const {
        const int row0 = u.pm * BM + wr * 64 + fr;
#pragma unroll
        for (int bj = 0; bj < 2; ++bj) {
            const int c0 = u.pn * BM + bj * HALF + wc * 32 + 8 * fq;
            const f32x4 w0a = *(const f32x4*)(cw + c0), w0b = *(const f32x4*)(cw + c0 + 4), w1a = *(const f32x4*)(cw + FF + c0), w1b = *(const f32x4*)(cw + FF + c0 + 4);
            const f32x4 w2a = *(const f32x4*)(cw + 2 * FF + c0), w2b = *(const f32x4*)(cw + 2 * FF + c0 + 4), ba = *(const f32x4*)(cb + c0), bb = *(const f32x4*)(cb + c0 + 4);
#pragma unroll
            for (int ai = 0; ai < 2; ++ai)
#pragma unroll
                for (int m = 0; m < 4; ++m) {
                    const int r = row0 + ai * HALF + m * 16, t = r & (SEQ - 1);
                    const int r1 = t >= 1 ? r - 1 : r, r2 = t >= 2 ? r - 2 : r; const float f1 = t >= 1 ? 1.f : 0.f, f2 = t >= 2 ? 1.f : 0.f;
                    float g2[8], g1[8], g0[8];
                    unpack8(*(const u32x4*)(G + (size_t)r * FF + c0), g2); unpack8(*(const u32x4*)(G + (size_t)r1 * FF + c0), g1); unpack8(*(const u32x4*)(G + (size_t)r2 * FF + c0), g0);
                    f32x4 h0, h1;
#pragma unroll
                    for (int j = 0; j < 4; ++j) {
                        const float ca = ba[j] + w0a[j] * (g0[j] * f2) + w1a[j] * (g1[j] * f1) + w2a[j] * g2[j];
                        const float cb_ = bb[j] + w0b[j] * (g0[4 + j] * f2) + w1b[j] * (g1[4 + j] * f1) + w2b[j] * g2[4 + j];
                        const float ya = 1.5957691216057308f * (ca + 0.044715f * ca * ca * ca), yb = 1.5957691216057308f * (cb_ + 0.044715f * cb_ * cb_ * cb_);
                        h0[j] = ca * fsigmoid(ya) * acc[ai][bj][m][0][j]; h1[j] = cb_ * fsigmoid(yb) * acc[ai][bj][m][1][j];
                    }
                    *(u32x4*)(H + (size_t)r * FF + c0) = pack8(h0, h1);
                }
        }
    }
};

template <class Epi, class Sched, bool ALIGN_EPI = false, bool SP2 = false>
__device__ __forceinline__ void gemm_phase(PG8_LAS unsigned char* lds, const Gemm g, const Sched& S, const Epi& E) {
    int tid_ = threadIdx.x; asm volatile("" : "+v"(tid_));
    const int tid = tid_, wid = __builtin_amdgcn_readfirstlane(tid >> 6), lane = tid & 63, wr = wid >> 2, wc = wid & 3, fr = lane & 15, fq = lane >> 4;
    const int K = g.K, nt = K / BK;
    unsigned voffA[2], voffB[2];
#pragma unroll
    for (int i = 0; i < 2; ++i) { int R, C; stage_rc(tid * 16 + i * 8192, R, C); const int Rb = Epi::PERM ? ((R & ~31) + perm32(R & 31)) : R;
        voffA[i] = (unsigned)(R * K + C) * 2u; voffB[i] = (unsigned)(Rb * K + C) * 2u; }
    const size_t kstep = (size_t)(BK * 2);
    const size_t hstep = (size_t)HALF * K * 2;
    const size_t tstep = 2 * hstep;
    const unsigned ldsw = (unsigned)wid * 1024u;
    const int aoff = lds_byte(wr * 64 + fr, fq * 8), boff = lds_byte(wc * 32 + fr, fq * 8);
#define PG8_SA(b, h) (((b) * 2 + (h)) * HTB)
#define PG8_SB(b, h) ((4 + (b) * 2 + (h)) * HTB)
#define PG8_STAGE(bufoff, gbase, voff) do { _Pragma("unroll") for (int _i = 0; _i < 2; ++_i) \
        __builtin_amdgcn_global_load_lds((const unsigned*)((const char*)(gbase) + (voff)[_i]), (PG8_LAS unsigned*)(lds + (bufoff) + ldsw + _i * 8192), 16, 0, 0); } while (0)
#define PG8_LDA(dst, b, h) do { _Pragma("unroll") for (int m = 0; m < 4; ++m) _Pragma("unroll") for (int k = 0; k < 2; ++k) dst[m][k] = *(const PG8_LAS bf16x8*)(lds + PG8_SA(b, h) + aoff + m * 2048 + k * 1024); } while (0)
#define PG8_LDB(dst, b, h) do { _Pragma("unroll") for (int n = 0; n < 2; ++n) _Pragma("unroll") for (int k = 0; k < 2; ++k) dst[n][k] = *(const PG8_LAS bf16x8*)(lds + PG8_SB(b, h) + boff + n * 2048 + k * 1024); } while (0)
#define PG8_MMA(ai, bj, At, Bt) do { __builtin_amdgcn_s_setprio(1); _Pragma("unroll") for (int m = 0; m < 4; ++m) _Pragma("unroll") for (int n = 0; n < 2; ++n) _Pragma("unroll") for (int k = 0; k < 2; ++k) \
        acc[ai][bj][m][n] = __builtin_amdgcn_mfma_f32_16x16x32_bf16(Bt[n][k], At[m][k], acc[ai][bj][m][n], 0, 0, 0); __builtin_amdgcn_s_setprio(0); } while (0)
#define PG8_WAIT_V(n) asm volatile("s_waitcnt vmcnt(" #n ")" ::: "memory")
#define PG8_WAIT_L(n) asm volatile("s_waitcnt lgkmcnt(" #n ")" ::: "memory")
#define PG8_BAR __builtin_amdgcn_s_barrier()
#define PG8_SCHED __builtin_amdgcn_sched_barrier(0)
    Unit cur, nxt; int ui = 0;
    if (!S.next(0, cur)) return;
    f32x4 acc[2][2][4][2];
#pragma unroll
    for (int a = 0; a < 2; ++a)
#pragma unroll
        for (int b = 0; b < 2; ++b)
#pragma unroll
            for (int m = 0; m < 4; ++m)
#pragma unroll
                for (int n = 0; n < 2; ++n) acc[a][b][m][n] = (f32x4){0.f, 0.f, 0.f, 0.f};
    bf16x8 At[4][2], B0[2][2], B1[2][2];
    const char* cA = (const char*)g.A + (size_t)cur.pm * tstep; const char* cB = (const char*)g.Bt + (size_t)cur.pn * tstep;
    S.a_ready(cur);
    if constexpr (SP2) {
        PG8_STAGE(PG8_SB(0, 0), cB, voffB); PG8_STAGE(PG8_SB(0, 1), cB + hstep, voffB); PG8_STAGE(PG8_SA(0, 0), cA, voffA); PG8_STAGE(PG8_SA(0, 1), cA + hstep, voffA);
        if (wr == 1) PG8_BAR;
        PG8_WAIT_V(2); PG8_BAR;
        PG8_STAGE(PG8_SB(1, 0), cB + kstep, voffB); PG8_STAGE(PG8_SA(1, 0), cA + kstep, voffA); PG8_STAGE(PG8_SB(1, 1), cB + hstep + kstep, voffB);
        PG8_WAIT_V(6); PG8_BAR;
    } else {
        PG8_STAGE(PG8_SB(0, 0), cB, voffB); PG8_STAGE(PG8_SA(0, 0), cA, voffA); PG8_STAGE(PG8_SB(0, 1), cB + hstep, voffB); PG8_STAGE(PG8_SA(0, 1), cA + hstep, voffA);
        if (wr == 1) PG8_BAR;
        PG8_WAIT_V(4); PG8_BAR;
        PG8_STAGE(PG8_SB(1, 0), cB + kstep, voffB); PG8_STAGE(PG8_SA(1, 0), cA + kstep, voffA); PG8_STAGE(PG8_SB(1, 1), cB + hstep + kstep, voffB);
        PG8_WAIT_V(6); PG8_BAR;
    }
    for (;;) {
        const bool has_next = S.next(ui + 1, nxt);
        const char* nA = has_next ? (const char*)g.A + (size_t)nxt.pm * tstep : cA; const char* nB = has_next ? (const char*)g.Bt + (size_t)nxt.pn * tstep : cB;
        for (int t = 0; t < nt; t += 2) {
            const bool last = (t == nt - 2);
            const char* a1 = cA + (size_t)(t + 1) * kstep;
            const char* a2 = last ? nA : cA + (size_t)(t + 2) * kstep; const char* b2 = last ? nB : cB + (size_t)(t + 2) * kstep;
            const char* a3 = a2 + kstep; const char* b3 = b2 + kstep;
            if (last && has_next) S.a_ready(nxt);
            if constexpr (SP2) {
            PG8_LDB(B0, 0, 0); PG8_LDB(B1, 0, 1); PG8_SCHED; PG8_LDA(At, 0, 0); PG8_STAGE(PG8_SA(1, 1), a1 + hstep, voffA);
            PG8_WAIT_V(8); PG8_WAIT_L(0); PG8_BAR; PG8_MMA(0, 0, At, B0); PG8_MMA(0, 1, At, B1); PG8_BAR; PG8_SCHED;
            PG8_LDA(At, 0, 1); PG8_STAGE(PG8_SB(0, 0), b2, voffB); PG8_STAGE(PG8_SB(0, 1), b2 + hstep, voffB); PG8_STAGE(PG8_SA(0, 0), a2, voffA);
            PG8_WAIT_V(8); PG8_WAIT_L(0); PG8_BAR; PG8_MMA(1, 0, At, B0); PG8_MMA(1, 1, At, B1); PG8_BAR; PG8_SCHED;
            PG8_LDB(B0, 1, 0); PG8_LDB(B1, 1, 1); PG8_SCHED; PG8_LDA(At, 1, 0); PG8_STAGE(PG8_SA(0, 1), a2 + hstep, voffA);
            PG8_WAIT_V(8); PG8_WAIT_L(0); PG8_BAR; PG8_MMA(0, 0, At, B0); PG8_MMA(0, 1, At, B1); PG8_BAR; PG8_SCHED;
            PG8_LDA(At, 1, 1); PG8_STAGE(PG8_SB(1, 0), b3, voffB); PG8_STAGE(PG8_SB(1, 1), b3 + hstep, voffB); PG8_STAGE(PG8_SA(1, 0), a3, voffA);
            PG8_WAIT_V(8); PG8_WAIT_L(0); PG8_BAR; PG8_MMA(1, 0, At, B0); PG8_MMA(1, 1, At, B1); PG8_BAR; PG8_SCHED;
            } else {
            PG8_LDB(B0, 0, 0); PG8_SCHED; PG8_LDA(At, 0, 0); PG8_STAGE(PG8_SA(1, 1), a1 + hstep, voffA);
            PG8_WAIT_L(8); PG8_BAR; PG8_WAIT_L(0); PG8_MMA(0, 0, At, B0); PG8_BAR; PG8_SCHED;
            PG8_LDB(B1, 0, 1); PG8_STAGE(PG8_SB(0, 0), b2, voffB);
            PG8_BAR; PG8_WAIT_L(0); PG8_MMA(0, 1, At, B1); PG8_BAR;
            PG8_LDA(At, 0, 1); PG8_STAGE(PG8_SA(0, 0), a2, voffA);
            PG8_BAR; PG8_WAIT_L(0); PG8_MMA(1, 0, At, B0); PG8_BAR; PG8_SCHED;
            PG8_STAGE(PG8_SB(0, 1), b2 + hstep, voffB);
            PG8_WAIT_V(6); PG8_BAR; PG8_MMA(1, 1, At, B1); PG8_BAR;
            PG8_LDB(B0, 1, 0); PG8_SCHED; PG8_LDA(At, 1, 0); PG8_STAGE(PG8_SA(0, 1), a2 + hstep, voffA);
            PG8_WAIT_L(8); PG8_BAR; PG8_WAIT_L(0); PG8_MMA(0, 0, At, B0); PG8_BAR; PG8_SCHED;
            PG8_LDB(B1, 1, 1); PG8_STAGE(PG8_SB(1, 0), b3, voffB);
            PG8_BAR; PG8_WAIT_L(0); PG8_MMA(0, 1, At, B1); PG8_BAR;
            PG8_LDA(At, 1, 1); PG8_STAGE(PG8_SA(1, 0), a3, voffA);
            PG8_BAR; PG8_WAIT_L(0); PG8_MMA(1, 0, At, B0); PG8_BAR; PG8_SCHED;
            PG8_STAGE(PG8_SB(1, 1), b3 + hstep, voffB);
            PG8_WAIT_V(6); PG8_BAR; PG8_MMA(1, 1, At, B1); PG8_BAR;
            }
        }
        if constexpr (ALIGN_EPI) { if (wr == 0) PG8_BAR; }
        if constexpr (!Epi::AFTER_DRAIN) { E(acc, cur, wr, wc, fr, fq); S.done(cur); }
        if (!has_next) break;
#pragma unroll
        for (int a = 0; a < 2; ++a)
#pragma unroll
            for (int b = 0; b < 2; ++b)
#pragma unroll
                for (int m = 0; m < 4; ++m)
#pragma unroll
                    for (int n = 0; n < 2; ++n) acc[a][b][m][n] = (f32x4){0.f, 0.f, 0.f, 0.f};
        cur = nxt; cA = nA; cB = nB; ++ui;
        if constexpr (ALIGN_EPI) { if (wr == 1) PG8_BAR; }
    }
    PG8_WAIT_V(0);
    if constexpr (!ALIGN_EPI) { if (wr == 0) PG8_BAR; }
    PG8_BAR;
    if constexpr (Epi::AFTER_DRAIN) { E.fused(acc, cur, wr, wc, fr, fq, lds, wid, lane); S.done(cur); }
#undef PG8_SA
#undef PG8_SB
#undef PG8_STAGE
#undef PG8_LDA
#undef PG8_LDB
#undef PG8_MMA
#undef PG8_WAIT_V
#undef PG8_WAIT_L
#undef PG8_BAR
#undef PG8_SCHED
}
}

typedef unsigned short bf16;
typedef float v4f __attribute__((ext_vector_type(4)));
typedef float v16f __attribute__((ext_vector_type(16)));
typedef unsigned v4u __attribute__((ext_vector_type(4)));
typedef unsigned v2u __attribute__((ext_vector_type(2)));
typedef short v8s __attribute__((ext_vector_type(8)));
#define RLX_AGENT __ATOMIC_RELAXED, __HIP_MEMORY_SCOPE_AGENT
template <class T> __device__ __forceinline__ T lds_ld(lds_t p, int off) { return *(const LAS T*)(p + off); }
template <class T> __device__ __forceinline__ void lds_st(lds_t p, int off, T v) { *(LAS T*)(p + off) = v; }
__device__ __forceinline__ unsigned cvtpk(float lo, float hi) { return pg8::cvt_pk_bf16(lo, hi); }
__device__ __forceinline__ float bf_lo(unsigned w) { return __uint_as_float(w << 16); }
__device__ __forceinline__ float bf_hi(unsigned w) { return __uint_as_float(w & 0xffff0000u); }
__device__ __forceinline__ float wave_sum(float v) {
#pragma unroll
    for (int o = 1; o < 64; o <<= 1) v += __shfl_xor(v, o);
    return v;
}
#define MFMA16(a, b, c) __builtin_amdgcn_mfma_f32_16x16x32_bf16((a), (b), (c), 0, 0, 0)
#define MFMA32(a, b, c) __builtin_amdgcn_mfma_f32_32x32x16_bf16((a), (b), (c), 0, 0, 0)

#define XB_TMO      128
#define XB_XCNT(j)  (256  + 64 * (j))
#define XB_XSUB(j)  (1280 + 64 * (j))
#define XB_XGEN(j)  (2304 + 64 * (j))
#define XB_TOP      3328
#define XB_TOPGEN   3392
#define XCD_BAR_WORDS 3456
#define XB_SPIN_CAP (1u << 22)
__device__ __forceinline__ unsigned xb_ld(unsigned* p)              { return __hip_atomic_load(p, __ATOMIC_RELAXED, __HIP_MEMORY_SCOPE_AGENT); }
__device__ __forceinline__ unsigned xb_add(unsigned* p, unsigned v) { return __hip_atomic_fetch_add(p, v, __ATOMIC_RELAXED, __HIP_MEMORY_SCOPE_AGENT); }
__device__ __forceinline__ unsigned xb_xcc_id() { return (unsigned)__builtin_amdgcn_s_getreg((3 << 11) | 20) & 0xFu; }
#define XB_SPIN(cond, bar) do { unsigned _sp = 0; while (cond) { __builtin_amdgcn_s_sleep(1); \
    if ((++_sp & 255u) == 0u) { if (xb_ld(&(bar)[XB_TMO])) break; if (_sp > XB_SPIN_CAP) { atomicAdd(&(bar)[XB_TMO], 1u); break; } } } } while (0)
struct XcdBarrier { unsigned* bar; unsigned x; volatile LAS unsigned* st; };
__device__ __forceinline__ XcdBarrier xcd_barrier_post(unsigned* bar, volatile LAS unsigned* st) {
    XcdBarrier b; b.bar = bar; b.x = xb_xcc_id(); b.st = st;
    if (threadIdx.x == 0) (void)xb_add(&bar[XB_XCNT(b.x)], 1u);
    return b;
}
__device__ __forceinline__ void xcd_barrier_complete(unsigned* bar, unsigned x, unsigned& nloc, unsigned& nx) {
    const unsigned G = gridDim.x * gridDim.y * gridDim.z;
    unsigned sum, cnt, mine, sp = 0u;
    for (;;) {
        sum = 0u; cnt = 0u; mine = 0u;
#pragma unroll
        for (unsigned j = 0; j < 16; ++j) { const unsigned c = xb_ld(&bar[XB_XCNT(j)]); sum += c; cnt += (c > 0u) ? 1u : 0u; mine = (j == x) ? c : mine; }
        if (sum == G) break;
        __builtin_amdgcn_s_sleep(1);
        if ((++sp & 255u) == 0u) { if (xb_ld(&bar[XB_TMO])) break; if (sp > XB_SPIN_CAP) { atomicAdd(&bar[XB_TMO], 1u); break; } }
    }
    nloc = mine > 0u ? mine : 1u; nx = cnt > 0u ? cnt : 1u;
}
__device__ __forceinline__ void xcd_barrier(const XcdBarrier& b) {
    asm volatile("s_waitcnt vmcnt(0)" ::: "memory");
    __syncthreads();
    if (threadIdx.x == 0) {
        unsigned* bar = b.bar;
        __builtin_amdgcn_s_waitcnt(0);
        unsigned nloc = b.st[0], nx = b.st[1];
        if (nloc == 0u) { xcd_barrier_complete(bar, b.x, nloc, nx); b.st[0] = nloc; b.st[1] = nx; }
        const unsigned old = xb_add(&bar[XB_XSUB(b.x)], 1u);
        const unsigned gen = old / nloc;
        if (old + 1u == (gen + 1u) * nloc) {
            __builtin_amdgcn_fence(__ATOMIC_RELEASE, "agent");
            asm volatile("s_waitcnt vmcnt(0)" ::: "memory");
            const unsigned og = xb_add(&bar[XB_TOP], 1u);
            const unsigned tg = og / nx;
            if (og + 1u == (tg + 1u) * nx) xb_add(&bar[XB_TOPGEN], 1u);
            else XB_SPIN(xb_ld(&bar[XB_TOPGEN]) == tg, bar);
            __builtin_amdgcn_fence(__ATOMIC_ACQUIRE, "agent");
            xb_add(&bar[XB_XGEN(b.x)], 1u);
            asm volatile("s_waitcnt vmcnt(0)" ::: "memory");
        } else {
            XB_SPIN(xb_ld(&bar[XB_XGEN(b.x)]) == gen, bar);
            __builtin_amdgcn_fence(__ATOMIC_ACQUIRE, "agent");
            asm volatile("s_waitcnt vmcnt(0)" ::: "memory");
        }
    }
    __syncthreads();
}

__device__ __forceinline__ void tr_item(const float* W, int K, int Nsrc, int scol, bf16* WT, int drow, int kb, lds_t scr, int lane) {
    const int k0 = 64 * kb;
#pragma unroll 8
    for (int i = 0; i < 32; ++i) { const int kk = 2 * i + (lane >> 5); lds_st<float>(scr, (kk * 33 + (lane & 31)) * 4, W[(size_t)(k0 + kk) * Nsrc + scol + (lane & 31)]); }
    asm volatile("s_waitcnt lgkmcnt(0)" ::: "memory");
    const int c = lane & 7;
#pragma unroll
    for (int j = 0; j < 4; ++j) { const int n = (lane >> 3) + 8 * j; const int so = ((8 * c) * 33 + n) * 4;
        v4u o; o.x = cvtpk(lds_ld<float>(scr, so), lds_ld<float>(scr, so + 33 * 4)); o.y = cvtpk(lds_ld<float>(scr, so + 2 * 33 * 4), lds_ld<float>(scr, so + 3 * 33 * 4));
        o.z = cvtpk(lds_ld<float>(scr, so + 4 * 33 * 4), lds_ld<float>(scr, so + 5 * 33 * 4)); o.w = cvtpk(lds_ld<float>(scr, so + 6 * 33 * 4), lds_ld<float>(scr, so + 7 * 33 * 4));
        *(v4u*)(WT + (size_t)(drow + n) * K + k0 + 8 * c) = o; }
    asm volatile("s_waitcnt lgkmcnt(0)" ::: "memory");
}
__device__ __forceinline__ void tr_mat(const float* W, int K, int N, bf16* WT, int r, lds_t scr, int lane) { const int nblk = N / 32, kb = r / nblk, nb = r % nblk; tr_item(W, K, N, 32 * nb, WT, 32 * nb, kb, scr, lane); }

__device__ __forceinline__ void p0_prologue(lds_t lds, const float* const* in, unsigned char* ws, int G) {
    const int tid = threadIdx.x, lane = tid & 63, wave = tid >> 6;
    lds_t scr = lds + wave * 16384;
    const int gw = blockIdx.x * 8 + wave, NGW = G * 8;
    constexpr int I_WIN = 32 * 416, I_BG = 32 * 64, I_BF = 16 * 64, I_OUT = 32 * 64, I_G = 32 * 176, I_U = I_G, I_D = 88 * 64, I_PG = 32 * 64, I_PP = 4 * 64;
    constexpr int NITEMS = I_WIN + I_BG + I_BF + I_OUT + I_G + I_U + I_D + I_PG + I_PP;
    for (int it = gw; it < NITEMS; it += NGW) {
        int r = it;
        if (r < I_WIN) { const int kb = r / 416, nb = r % 416, drow = 32 * nb; const int scol = drow + (drow >= 6144 ? 16 : 0) + (drow >= 9216 ? 8 : 0);
            tr_item(in[2], 2048, N_IN, scol, (bf16*)(ws + WS_WIN), drow, kb, scr, lane); continue; } r -= I_WIN;
        if (r < I_BG) { tr_mat(in[7], 2048, 2048, (bf16*)(ws + WS_WBG), r, scr, lane); continue; } r -= I_BG;
        if (r < I_BF) { tr_mat(in[8], 1024, 2048, (bf16*)(ws + WS_WBF), r, scr, lane); continue; } r -= I_BF;
        if (r < I_OUT) { tr_mat(in[9], 2048, 2048, (bf16*)(ws + WS_WOUT), r, scr, lane); continue; } r -= I_OUT;
        if (r < I_G) { tr_mat(in[12], 2048, FF, (bf16*)(ws + WS_WG), r, scr, lane); continue; } r -= I_G;
        if (r < I_U) { tr_mat(in[13], 2048, FF, (bf16*)(ws + WS_WU), r, scr, lane); continue; } r -= I_U;
        if (r < I_D) { tr_mat(in[16], FF, 2048, (bf16*)(ws + WS_WD), r, scr, lane); continue; } r -= I_D;
        if (r < I_PG) { tr_mat(in[19], 2048, 2048, (bf16*)(ws + WS_WPG), r, scr, lane); continue; } r -= I_PG;
        tr_mat(in[20], PLE, 2048, (bf16*)(ws + WS_WPP), r, scr, lane);
    }
    const int gt = blockIdx.x * 512 + tid, NT = G * 512;
    { const float* win = in[2]; bf16* WT = (bf16*)(ws + WS_WIN);
      for (int i = gt; i < 256 * 256; i += NT) { const int j = i >> 8, kc = (i & 255) * 8; v4u o = (v4u){0u, 0u, 0u, 0u};
          if (j < 24) { const int sc = j < 16 ? 6144 + j : 9232 + (j - 16); float f[8];
#pragma unroll
              for (int e = 0; e < 8; ++e) f[e] = win[(size_t)(kc + e) * N_IN + sc];
              o.x = cvtpk(f[0], f[1]); o.y = cvtpk(f[2], f[3]); o.z = cvtpk(f[4], f[5]); o.w = cvtpk(f[6], f[7]); }
          *(v4u*)(WT + (size_t)(13312 + j) * 2048 + kc) = o; } }
    { const float* x = in[0]; bf16* XB = (bf16*)(ws + WS_XB);
      for (int i = gt; i < MTOK * DM / 8; i += NT) { const v4f a = *(const v4f*)(x + (size_t)i * 8), b = *(const v4f*)(x + (size_t)i * 8 + 4);
          v4u o; o.x = cvtpk(a[0], a[1]); o.y = cvtpk(a[2], a[3]); o.z = cvtpk(b[0], b[1]); o.w = cvtpk(b[2], b[3]); *(v4u*)(XB + (size_t)i * 8) = o; } }
    { const float* p = in[1]; bf16* PB = (bf16*)(ws + WS_PB);
      for (int i = gt; i < MTOK * PLE / 8; i += NT) { const v4f a = *(const v4f*)(p + (size_t)i * 8), b = *(const v4f*)(p + (size_t)i * 8 + 4);
          v4u o; o.x = cvtpk(a[0], a[1]); o.y = cvtpk(a[2], a[3]); o.z = cvtpk(b[0], b[1]); o.w = cvtpk(b[2], b[3]); *(v4u*)(PB + (size_t)i * 8) = o; } }
}

__device__ __forceinline__ void gla_prep_item(lds_t lds, int item, const unsigned char* ws, const float* wlr, const float* blr, int tid) {
    asm volatile("" : "+v"(tid));
    const bf16* GQ = (const bf16*)(ws + WS_GQ); const bf16* GK = (const bf16*)(ws + WS_GK); const bf16* GV = (const bf16*)(ws + WS_GV); const float* SM = (const float*)(ws + WS_SM);
    bf16* QT = (bf16*)(ws + WS_QT); bf16* KT = (bf16*)(ws + WS_KT); bf16* VT = (bf16*)(ws + WS_VT); bf16* ATT = (bf16*)(ws + WS_ATT); float* DEC = (float*)(ws + WS_DEC);
    const int c = item & 63, bh = item >> 6, h = bh & 3, b = bh >> 2;
    const size_t tok0 = (size_t)b * SEQ + 64 * c;
    constexpr int L_BC = 0, L_TOT = 65536, L_GLR = 67584, L_QS = 71680, L_KS = 105472, QROW = 528;
    const int lane = tid & 63, wid = tid >> 6, l15 = lane & 15, q4 = lane >> 4;
    __syncthreads();
    if (tid < 256) { const int row = tid >> 2, quad = tid & 3; const v4f v = *(const v4f*)(SM + (tok0 + row) * 32 + quad * 4); lds_st<v4f>(lds, L_GLR + (row * 16 + quad * 4) * 4, v); }
    const int k = tid & 255, half = tid >> 8;
    float w[16];
#pragma unroll
    for (int r = 0; r < 16; ++r) w[r] = wlr[r * 1024 + h * 256 + k];
    const float bias = blr[h * 256 + k];
    __syncthreads();
    float run = 0.f;
    for (int tt = 0; tt < 32; ++tt) { const int t = half * 32 + tt; float z = bias;
#pragma unroll
        for (int r4 = 0; r4 < 4; ++r4) { const v4f g = lds_ld<v4f>(lds, L_GLR + (t * 16 + r4 * 4) * 4); z += g[0] * w[4 * r4] + g[1] * w[4 * r4 + 1] + g[2] * w[4 * r4 + 2] + g[3] * w[4 * r4 + 3]; }
        const float ls = fminf(z, 0.f) - log1pf(expf(-fabsf(z)));
        run += ls * 0.0625f;
        lds_st<float>(lds, L_BC + (t * 256 + k) * 4, run); }
    lds_st<float>(lds, L_TOT + (half * 256 + k) * 4, run);
    __syncthreads();
    if (tid < 256) DEC[(size_t)item * 256 + tid] = expf(lds_ld<float>(lds, L_TOT + tid * 4) + lds_ld<float>(lds, L_TOT + (256 + tid) * 4));
#pragma unroll 1
    for (int i = 0; i < 4; ++i) { const int idx = tid + 512 * i, t = idx >> 5, kc = (idx & 31) * 8;
        const v4u qv = *(const v4u*)(GQ + (tok0 + t) * 1024 + h * 256 + kc), kv = *(const v4u*)(GK + (tok0 + t) * 1024 + h * 256 + kc);
        v4f b0 = lds_ld<v4f>(lds, L_BC + (t * 256 + kc) * 4), b1 = lds_ld<v4f>(lds, L_BC + (t * 256 + kc + 4) * 4);
        if (t >= 32) { b0 += lds_ld<v4f>(lds, L_TOT + kc * 4); b1 += lds_ld<v4f>(lds, L_TOT + (kc + 4) * 4); }
        float qq[8], kk[8], bc[8];
#pragma unroll
        for (int j = 0; j < 4; ++j) { qq[2 * j] = bf_lo(qv[j]); qq[2 * j + 1] = bf_hi(qv[j]); kk[2 * j] = bf_lo(kv[j]); kk[2 * j + 1] = bf_hi(kv[j]); bc[j] = b0[j]; bc[4 + j] = b1[j]; }
#pragma unroll
        for (int j = 0; j < 8; ++j) { qq[j] = qq[j] * expf(bc[j]) * 0.0625f; kk[j] = kk[j] * expf(-bc[j]); }
        v4u qp, kp; qp.x = cvtpk(qq[0], qq[1]); qp.y = cvtpk(qq[2], qq[3]); qp.z = cvtpk(qq[4], qq[5]); qp.w = cvtpk(qq[6], qq[7]);
        kp.x = cvtpk(kk[0], kk[1]); kp.y = cvtpk(kk[2], kk[3]); kp.z = cvtpk(kk[4], kk[5]); kp.w = cvtpk(kk[6], kk[7]);
        *(v4u*)(QT + (size_t)item * 16384 + t * 256 + kc) = qp;
        lds_st<v4u>(lds, L_QS + t * QROW + kc * 2, qp); lds_st<v4u>(lds, L_KS + t * QROW + kc * 2, kp); }
    __syncthreads();
#pragma unroll 1
    for (int i = 0; i < 4; ++i) { const int idx = tid + 512 * i, kk = idx >> 3, sc = (idx & 7) * 8; unsigned e[8];
#pragma unroll
        for (int j = 0; j < 8; ++j) e[j] = lds_ld<unsigned short>(lds, L_KS + (sc + j) * QROW + kk * 2);
        v4u o; o.x = e[0] | (e[1] << 16); o.y = e[2] | (e[3] << 16); o.z = e[4] | (e[5] << 16); o.w = e[6] | (e[7] << 16);
        *(v4u*)(KT + (size_t)item * 16384 + kk * 64 + sc) = o; }
    { const int mt = wid >> 1;
#pragma unroll
      for (int nn = 0; nn < 2; ++nn) { const int nt = (wid & 1) * 2 + nn; v4f acc = (v4f){0.f, 0.f, 0.f, 0.f};
          if (nt <= mt) {
#pragma unroll
              for (int ks = 0; ks < 8; ++ks) { const v8s a = lds_ld<v8s>(lds, L_QS + (16 * mt + l15) * QROW + (32 * ks + 8 * q4) * 2), bb = lds_ld<v8s>(lds, L_KS + (16 * nt + l15) * QROW + (32 * ks + 8 * q4) * 2); acc = MFMA16(a, bb, acc); } }
#pragma unroll
          for (int r = 0; r < 4; ++r) { const int t = 16 * mt + 4 * q4 + r, s = 16 * nt + l15; const float v = (s <= t) ? acc[r] : 0.f; ATT[(size_t)item * 4096 + t * 64 + s] = (bf16)(cvtpk(v, 0.f) & 0xffffu); } } }
    __syncthreads();
#pragma unroll 1
    for (int i = 0; i < 8; ++i) { const int idx = tid + 512 * i, s = idx >> 6, vc = (idx & 63) * 8; const v4u vv = *(const v4u*)(GV + (tok0 + s) * 2048 + h * 512 + vc);
#pragma unroll
        for (int j = 0; j < 4; ++j) { lds_st<unsigned short>(lds, (vc + 2 * j) * 132 + s * 2, (unsigned short)(vv[j] & 0xffffu)); lds_st<unsigned short>(lds, (vc + 2 * j + 1) * 132 + s * 2, (unsigned short)(vv[j] >> 16)); } }
    __syncthreads();
#pragma unroll 1
    for (int i = 0; i < 8; ++i) { const int idx = tid + 512 * i, v = idx >> 3, c8 = idx & 7; v4u o;
        o.x = lds_ld<unsigned>(lds, v * 132 + c8 * 16); o.y = lds_ld<unsigned>(lds, v * 132 + c8 * 16 + 4); o.z = lds_ld<unsigned>(lds, v * 132 + c8 * 16 + 8); o.w = lds_ld<unsigned>(lds, v * 132 + c8 * 16 + 12);
        *(v4u*)(VT + (size_t)item * 32768 + v * 64 + c8 * 8) = o; }
}
__device__ __forceinline__ void fv_tr_item(lds_t lds, int item, const unsigned char* ws, int tid) {
    asm volatile("" : "+v"(tid));
    const bf16* FV = (const bf16*)(ws + WS_FV); bf16* FVT = (bf16*)(ws + WS_FVT);
    const int bh = item >> 6, tt = item & 63, b = bh >> 3, h = bh & 7;
    __syncthreads();
#pragma unroll
    for (int i = 0; i < 2; ++i) { const int idx = tid + 512 * i, s = idx >> 4, dc = (idx & 15) * 8; const v4u vv = *(const v4u*)(FV + ((size_t)b * SEQ + 64 * tt + s) * 1024 + h * 128 + dc);
#pragma unroll
        for (int j = 0; j < 4; ++j) { lds_st<unsigned short>(lds, (dc + 2 * j) * 132 + s * 2, (unsigned short)(vv[j] & 0xffffu)); lds_st<unsigned short>(lds, (dc + 2 * j + 1) * 132 + s * 2, (unsigned short)(vv[j] >> 16)); } }
    __syncthreads();
#pragma unroll
    for (int i = 0; i < 2; ++i) { const int idx = tid + 512 * i, d = idx >> 3, c8 = idx & 7; v4u o;
        o.x = lds_ld<unsigned>(lds, d * 132 + c8 * 16); o.y = lds_ld<unsigned>(lds, d * 132 + c8 * 16 + 4); o.z = lds_ld<unsigned>(lds, d * 132 + c8 * 16 + 8); o.w = lds_ld<unsigned>(lds, d * 132 + c8 * 16 + 12);
        *(v4u*)(FVT + ((size_t)bh * 128 + d) * SEQ + 64 * tt + c8 * 8) = o; }
}
__device__ __forceinline__ void fox_cumsum_item(lds_t lds, int bh, const unsigned char* ws, const float* bfg, int tid) {
    asm volatile("" : "+v"(tid));
    const float* SM = (const float*)(ws + WS_SM); float* CB = (float*)(ws + WS_CB);
    const int b = bh >> 3, h = bh & 7, lane = tid & 63, wid = tid >> 6; const float bf = bfg[h];
    __syncthreads();
    float v[8]; float run = 0.f;
#pragma unroll
    for (int j = 0; j < 8; ++j) { const float z = SM[((size_t)b * SEQ + tid * 8 + j) * 32 + 16 + h] + bf; run += fminf(z, 0.f) - log1pf(expf(-fabsf(z))); v[j] = run; }
    float inc = run;
#pragma unroll
    for (int o = 1; o < 64; o <<= 1) { const float n = __shfl_up(inc, o); if (lane >= o) inc += n; }
    if (lane == 63) lds_st<float>(lds, wid * 4, inc);
    __syncthreads();
    float pre = inc - run;
    for (int w2 = 0; w2 < wid; ++w2) pre += lds_ld<float>(lds, w2 * 4);
#pragma unroll
    for (int j = 0; j < 8; ++j) CB[(size_t)bh * SEQ + tid * 8 + j] = -LOG2E * (pre + v[j]);
}

constexpr int NSEG = 8, SEGC = 64 / NSEG;
__device__ __forceinline__ void gla_scan_item(lds_t lds, int item, const unsigned char* ws, int tid) {
    asm volatile("" : "+v"(tid));
    const bf16* QT = (const bf16*)(ws + WS_QT); const bf16* KT = (const bf16*)(ws + WS_KT); const bf16* VT = (const bf16*)(ws + WS_VT); const bf16* ATT = (const bf16*)(ws + WS_ATT); const float* DEC = (const float*)(ws + WS_DEC);
    float* ORAW = (float*)(ws + WS_ORAW); bf16* LSEG = (bf16*)(ws + WS_LSEG); float* PDEC = (float*)(ws + WS_PDEC); float* DSEG = (float*)(ws + WS_DSEG);
    float prun = 1.f;
    const int seg = item & (NSEG - 1), i32 = item / NSEG, vq = i32 & 3, bh4 = i32 >> 2, h = bh4 & 3, b = bh4 >> 2;
    const int lane = tid & 63, wid = tid >> 6, l15 = lane & 15, q4 = lane >> 4;
    constexpr int QROW = 528, KROW = 144, L_Q = 0, L_K = 33792, L_A = 33792 + 36864, L_D = L_A + 9216;
    const int vcol = 128 * vq + 16 * wid + l15;
    v4f S[16];
#pragma unroll
    for (int i = 0; i < 16; ++i) S[i] = (v4f){0.f, 0.f, 0.f, 0.f};
    v4u pq[4], pk[4], pa, pvf[2]; v4f pd;
#define GS_PREFETCH(cc) do { const size_t it_ = (size_t)bh4 * 64 + (cc); \
        _Pragma("unroll") for (int i = 0; i < 4; ++i) { const int idx = tid + 512 * i; pq[i] = *(const v4u*)(QT + it_ * 16384 + idx * 8); } \
        pa = *(const v4u*)(ATT + it_ * 4096 + tid * 8); \
        _Pragma("unroll") for (int kk = 0; kk < 2; ++kk) pvf[kk] = *(const v4u*)(VT + (it_ * 512 + vcol) * 64 + 32 * kk + 8 * q4); } while (0)
#define GS_PREFETCH2(cc) do { const size_t it_ = (size_t)bh4 * 64 + (cc); \
        _Pragma("unroll") for (int i = 0; i < 4; ++i) { const int idx = tid + 512 * i; pk[i] = *(const v4u*)(KT + it_ * 16384 + idx * 8); } \
        if (tid < 64) pd = *(const v4f*)(DEC + it_ * 256 + tid * 4); } while (0)
    GS_PREFETCH(seg * SEGC); GS_PREFETCH2(seg * SEGC);
    for (int c = seg * SEGC; c < (seg + 1) * SEGC; ++c) {
        __syncthreads();
#pragma unroll
        for (int i = 0; i < 4; ++i) { const int idx = tid + 512 * i; lds_st<v4u>(lds, L_Q + (idx >> 5) * QROW + (idx & 31) * 16, pq[i]); lds_st<v4u>(lds, L_K + (idx >> 3) * KROW + (idx & 7) * 16, pk[i]); }
        lds_st<v4u>(lds, L_A + (tid >> 3) * KROW + (tid & 7) * 16, pa);
        if (tid < 64) lds_st<v4f>(lds, L_D + tid * 16, pd);
        v8s vf[2]; vf[0] = __builtin_bit_cast(v8s, pvf[0]); vf[1] = __builtin_bit_cast(v8s, pvf[1]);
        __syncthreads();
        if (c + 1 < (seg + 1) * SEGC) GS_PREFETCH(c + 1);
        v4f o[4];
#pragma unroll
        for (int mt = 0; mt < 4; ++mt) o[mt] = (v4f){0.f, 0.f, 0.f, 0.f};
#pragma unroll
        for (int ks = 0; ks < 8; ++ks) {
            v4u bw; bw.x = cvtpk(S[2 * ks][0], S[2 * ks][1]); bw.y = cvtpk(S[2 * ks][2], S[2 * ks][3]); bw.z = cvtpk(S[2 * ks + 1][0], S[2 * ks + 1][1]); bw.w = cvtpk(S[2 * ks + 1][2], S[2 * ks + 1][3]);
            const v8s bfr = __builtin_bit_cast(v8s, bw);
#pragma unroll
            for (int mt = 0; mt < 4; ++mt) { const v2u lo = lds_ld<v2u>(lds, L_Q + (16 * mt + l15) * QROW + (32 * ks + 4 * q4) * 2), hi = lds_ld<v2u>(lds, L_Q + (16 * mt + l15) * QROW + (32 * ks + 16 + 4 * q4) * 2);
                const v4u aw = (v4u){lo.x, lo.y, hi.x, hi.y}; o[mt] = MFMA16(__builtin_bit_cast(v8s, aw), bfr, o[mt]); }
        }
#pragma unroll
        for (int kk = 0; kk < 2; ++kk)
#pragma unroll
            for (int mt = 0; mt < 4; ++mt) { const v8s a = lds_ld<v8s>(lds, L_A + (16 * mt + l15) * KROW + (32 * kk + 8 * q4) * 2); o[mt] = MFMA16(a, vf[kk], o[mt]); }
        { float* op = ORAW + ((size_t)b * SEQ + 64 * c) * 2048 + h * 512 + vcol;
#pragma unroll
          for (int mt = 0; mt < 4; ++mt)
#pragma unroll
              for (int r = 0; r < 4; ++r) op[(size_t)(16 * mt + 4 * q4 + r) * 2048] = o[mt][r]; }
        if (vq == 0 && tid < 256) { PDEC[((size_t)bh4 * 64 + c) * 256 + tid] = prun; prun *= lds_ld<float>(lds, L_D + tid * 4); }
        __builtin_amdgcn_sched_barrier(0);
        if (c + 1 < (seg + 1) * SEGC) GS_PREFETCH2(c + 1);
        __builtin_amdgcn_sched_barrier(0);
#pragma unroll
        for (int kt = 0; kt < 16; ++kt) { v4f acc = S[kt];
#pragma unroll
            for (int kk = 0; kk < 2; ++kk) { const v8s a = lds_ld<v8s>(lds, L_K + (16 * kt + l15) * KROW + (32 * kk + 8 * q4) * 2); acc = MFMA16(a, vf[kk], acc); }
            const v4f dc = lds_ld<v4f>(lds, L_D + (16 * kt + 4 * q4) * 4); S[kt] = acc * dc; }
    }
#undef GS_PREFETCH
#undef GS_PREFETCH2
    if (vq == 0 && tid < 256) DSEG[((size_t)bh4 * NSEG + seg) * 256 + tid] = prun;
    if (seg < NSEG - 1) { bf16* lp = LSEG + ((size_t)(i32 * NSEG + seg) * 128 + 16 * wid + l15) * 256 + 4 * q4;
#pragma unroll
        for (int kt = 0; kt < 16; ++kt) *(v2u*)(lp + 16 * kt) = (v2u){cvtpk(S[kt][0], S[kt][1]), cvtpk(S[kt][2], S[kt][3])}; }
}

__device__ __forceinline__ void gla_fix_item(lds_t lds, int item, const unsigned char* ws, int tid) {
    asm volatile("" : "+v"(tid));
    const bf16* QT = (const bf16*)(ws + WS_QT); const bf16* LSEG = (const bf16*)(ws + WS_LSEG); float* ORAW = (float*)(ws + WS_ORAW); const float* PDEC = (const float*)(ws + WS_PDEC); const float* DSEG = (const float*)(ws + WS_DSEG);
    const int seg = item & (NSEG - 1), i32 = item / NSEG, vq = i32 & 3, bh4 = i32 >> 2, h = bh4 & 3, b = bh4 >> 2;
    const int lane = tid & 63, wid = tid >> 6, l15 = lane & 15, q4 = lane >> 4;
    constexpr int QROW = 528, L_Q = 0;
    const int vcol = 128 * vq + 16 * wid + l15;
    float a[8][8];
#pragma unroll
    for (int ks = 0; ks < 8; ++ks)
#pragma unroll
        for (int j = 0; j < 8; ++j) a[ks][j] = 0.f;
    for (int s2 = 0; s2 < seg; ++s2) {
        const bf16* lp = LSEG + ((size_t)(i32 * NSEG + s2) * 128 + 16 * wid + l15) * 256 + 8 * q4; const float* dp = DSEG + ((size_t)bh4 * NSEG + s2) * 256 + 8 * q4;
#pragma unroll
        for (int ks = 0; ks < 8; ++ks) { const v4u lw = *(const v4u*)(lp + 32 * ks); const v4f d0 = *(const v4f*)(dp + 32 * ks), d1 = *(const v4f*)(dp + 32 * ks + 4);
            a[ks][0] = a[ks][0] * d0[0] + bf_lo(lw.x); a[ks][1] = a[ks][1] * d0[1] + bf_hi(lw.x); a[ks][2] = a[ks][2] * d0[2] + bf_lo(lw.y); a[ks][3] = a[ks][3] * d0[3] + bf_hi(lw.y);
            a[ks][4] = a[ks][4] * d1[0] + bf_lo(lw.z); a[ks][5] = a[ks][5] * d1[1] + bf_hi(lw.z); a[ks][6] = a[ks][6] * d1[2] + bf_lo(lw.w); a[ks][7] = a[ks][7] * d1[3] + bf_hi(lw.w); }
    }
    v8s bfr[8];
#pragma unroll
    for (int ks = 0; ks < 8; ++ks) { v4u w; w.x = cvtpk(a[ks][0], a[ks][1]); w.y = cvtpk(a[ks][2], a[ks][3]); w.z = cvtpk(a[ks][4], a[ks][5]); w.w = cvtpk(a[ks][6], a[ks][7]); bfr[ks] = __builtin_bit_cast(v8s, w); }
    v4u pq[4]; v4f pp[4][2];
#define GF_PREFETCH(cc) do { const size_t it_ = (size_t)bh4 * 64 + (cc); \
        _Pragma("unroll") for (int i = 0; i < 4; ++i) { const int idx = tid + 512 * i; pq[i] = *(const v4u*)(QT + it_ * 16384 + idx * 8); \
            pp[i][0] = *(const v4f*)(PDEC + it_ * 256 + (idx & 31) * 8); pp[i][1] = *(const v4f*)(PDEC + it_ * 256 + (idx & 31) * 8 + 4); } } while (0)
    GF_PREFETCH(seg * SEGC);
    for (int ci = 0; ci < SEGC; ++ci) { const int c = seg * SEGC + ci;
        __syncthreads();
#pragma unroll
        for (int i = 0; i < 4; ++i) { const int idx = tid + 512 * i, t = idx >> 5, kc = (idx & 31) * 8; const v4f p0 = pp[i][0], p1 = pp[i][1];
            v4u w; w.x = cvtpk(bf_lo(pq[i].x) * p0[0], bf_hi(pq[i].x) * p0[1]); w.y = cvtpk(bf_lo(pq[i].y) * p0[2], bf_hi(pq[i].y) * p0[3]);
            w.z = cvtpk(bf_lo(pq[i].z) * p1[0], bf_hi(pq[i].z) * p1[1]); w.w = cvtpk(bf_lo(pq[i].w) * p1[2], bf_hi(pq[i].w) * p1[3]);
            lds_st<v4u>(lds, L_Q + t * QROW + kc * 2, w); }
        __syncthreads();
        if (ci + 1 < SEGC) GF_PREFETCH(c + 1);
        float* op = ORAW + ((size_t)b * SEQ + 64 * c) * 2048 + h * 512 + vcol;
        v4f o[4];
#pragma unroll
        for (int mt = 0; mt < 4; ++mt)
#pragma unroll
            for (int r = 0; r < 4; ++r) o[mt][r] = op[(size_t)(16 * mt + 4 * q4 + r) * 2048];
#pragma unroll
        for (int ks = 0; ks < 8; ++ks)
#pragma unroll
            for (int mt = 0; mt < 4; ++mt) { const v8s aa = lds_ld<v8s>(lds, L_Q + (16 * mt + l15) * QROW + (32 * ks + 8 * q4) * 2); o[mt] = MFMA16(aa, bfr[ks], o[mt]); }
#pragma unroll
        for (int mt = 0; mt < 4; ++mt)
#pragma unroll
            for (int r = 0; r < 4; ++r) op[(size_t)(16 * mt + 4 * q4 + r) * 2048] = o[mt][r];
    }
#undef GF_PREFETCH
}

__device__ __forceinline__ void fox_unit(lds_t lds, int bh, int qi, const unsigned char* ws, int tid) {
    asm volatile("" : "+v"(tid));
    const bf16* FQ = (const bf16*)(ws + WS_FQ); const bf16* FK = (const bf16*)(ws + WS_FK); const bf16* FVT = (const bf16*)(ws + WS_FVT); const float* CB = (const float*)(ws + WS_CB); bf16* OF = (bf16*)(ws + WS_OF);
    const int lane = tid & 63, wid = tid >> 6, r32 = lane & 31, hi = lane >> 5, rg = wid & 3, par = wid >> 2;
    const int b = bh >> 3, h = bh & 7; const size_t rowbase = (size_t)b * SEQ; const int q0 = qi * 128;
    constexpr int KROW = 272, VROW = 136, TILEB = 17408, L_V0 = 2 * TILEB;
    const size_t qrow = rowbase + q0 + 32 * rg + r32;
    constexpr int L_QF = 4 * TILEB;
#pragma unroll
    for (int i = 0; i < 4; ++i) { const int idx = tid + 512 * i; lds_st<v4u>(lds, L_QF + (idx >> 4) * KROW + (idx & 15) * 16, *(const v4u*)(FQ + (rowbase + q0 + (idx >> 4)) * 1024 + h * 128 + (idx & 15) * 8)); }
    const int qb = L_QF + (32 * rg + r32) * KROW + 16 * hi;
    v16f o[4];
#pragma unroll
    for (int d = 0; d < 4; ++d)
#pragma unroll
        for (int r = 0; r < 16; ++r) o[d][r] = 0.f;
    const float NEG = -__builtin_inff();
    float m = NEG, l = 0.f;
    const int niter = qi + 1;
    v4u pk[4], pv[4]; v4f pb;
    constexpr int L_CB = L_QF + 128 * KROW;
#define FX_PREFETCH(it) do { if (tid < 32) pb = *(const v4f*)(CB + (size_t)bh * SEQ + (size_t)(it) * 128 + tid * 4); \
        _Pragma("unroll") for (int i = 0; i < 4; ++i) { const int idx = tid + 512 * i, tile = idx >> 10; \
            pk[i] = *(const v4u*)(FK + (rowbase + (size_t)(2 * (it) + tile) * 64 + ((idx >> 4) & 63)) * 1024 + h * 128 + (idx & 15) * 8); \
            pv[i] = *(const v4u*)(FVT + ((size_t)bh * 128 + ((idx >> 3) & 127)) * SEQ + (2 * (it) + tile) * 64 + (idx & 7) * 8); } } while (0)
    FX_PREFETCH(0);
    for (int it = 0; it < niter; ++it) {
        __syncthreads();
#pragma unroll
        for (int i = 0; i < 4; ++i) { const int idx = tid + 512 * i, tile = idx >> 10;
            lds_st<v4u>(lds, tile * TILEB + ((idx >> 4) & 63) * KROW + (idx & 15) * 16, pk[i]);
            const int vo = L_V0 + tile * TILEB + ((idx >> 3) & 127) * VROW + (idx & 7) * 16;
            lds_st<v2u>(lds, vo, (v2u){pv[i].x, pv[i].y}); lds_st<v2u>(lds, vo + 8, (v2u){pv[i].z, pv[i].w}); }
        if (tid < 32) lds_st<v4f>(lds, L_CB + tid * 16, pb);
        __syncthreads();
        if (it + 1 < niter) FX_PREFETCH(it + 1);
        const int ks0 = (2 * it + par) * 64;
        if (ks0 <= q0 + 32 * rg) {
            v16f s0, s1;
#pragma unroll
            for (int r = 0; r < 16; ++r) { s0[r] = 0.f; s1[r] = 0.f; }
            const int kb = par * TILEB + r32 * KROW + 16 * hi;
#pragma unroll
            for (int s = 0; s < 8; ++s) { const v8s a0 = lds_ld<v8s>(lds, kb + 32 * s), a1 = lds_ld<v8s>(lds, kb + 32 * KROW + 32 * s), qv = lds_ld<v8s>(lds, qb + 32 * s); s0 = MFMA32(a0, qv, s0); s1 = MFMA32(a1, qv, s1); }
#pragma unroll
            for (int g = 0; g < 4; ++g) { const v4f b0 = lds_ld<v4f>(lds, L_CB + (par * 64 + 8 * g + 4 * hi) * 4), b1 = lds_ld<v4f>(lds, L_CB + (par * 64 + 32 + 8 * g + 4 * hi) * 4);
#pragma unroll
                for (int j = 0; j < 4; ++j) { s0[4 * g + j] += b0[j]; s1[4 * g + j] += b1[j]; } }
            if (ks0 + 63 > q0 + 32 * rg) { const int qabs = q0 + 32 * rg + r32;
#pragma unroll
                for (int r = 0; r < 16; ++r) { const int kv = ks0 + (r & 3) + 8 * (r >> 2) + 4 * hi; if (kv > qabs) s0[r] = NEG; if (kv + 32 > qabs) s1[r] = NEG; } }
            float rm = fmaxf(s0[0], s1[0]);
#pragma unroll
            for (int r = 1; r < 16; ++r) rm = fmaxf(rm, fmaxf(s0[r], s1[r]));
            rm = fmaxf(rm, __shfl_xor(rm, 32));
            const float mn = fmaxf(m, rm), alpha = __builtin_amdgcn_exp2f(m - mn); m = mn;
            float ps = 0.f;
#pragma unroll
            for (int r = 0; r < 16; ++r) { s0[r] = __builtin_amdgcn_exp2f(s0[r] - mn); s1[r] = __builtin_amdgcn_exp2f(s1[r] - mn); ps += s0[r] + s1[r]; }
            l = l * alpha + ps;
#pragma unroll
            for (int d = 0; d < 4; ++d)
#pragma unroll
                for (int r = 0; r < 16; ++r) o[d][r] *= alpha;
            v8s pf[4];
            { v4u w;
              w.x = cvtpk(s0[0], s0[1]); w.y = cvtpk(s0[2], s0[3]); w.z = cvtpk(s0[4], s0[5]); w.w = cvtpk(s0[6], s0[7]); pf[0] = __builtin_bit_cast(v8s, w);
              w.x = cvtpk(s0[8], s0[9]); w.y = cvtpk(s0[10], s0[11]); w.z = cvtpk(s0[12], s0[13]); w.w = cvtpk(s0[14], s0[15]); pf[1] = __builtin_bit_cast(v8s, w);
              w.x = cvtpk(s1[0], s1[1]); w.y = cvtpk(s1[2], s1[3]); w.z = cvtpk(s1[4], s1[5]); w.w = cvtpk(s1[6], s1[7]); pf[2] = __builtin_bit_cast(v8s, w);
              w.x = cvtpk(s1[8], s1[9]); w.y = cvtpk(s1[10], s1[11]); w.z = cvtpk(s1[12], s1[13]); w.w = cvtpk(s1[14], s1[15]); pf[3] = __builtin_bit_cast(v8s, w); }
            const int vb = L_V0 + par * TILEB + r32 * VROW + 8 * hi;
#pragma unroll
            for (int d = 0; d < 4; ++d)
#pragma unroll
                for (int kk = 0; kk < 4; ++kk) { const v2u lo = lds_ld<v2u>(lds, vb + 32 * d * VROW + 32 * kk), hh = lds_ld<v2u>(lds, vb + 32 * d * VROW + 32 * kk + 16);
                    const v4u aw = (v4u){lo.x, lo.y, hh.x, hh.y}; o[d] = MFMA32(__builtin_bit_cast(v8s, aw), pf[kk], o[d]); }
        }
    }
#undef FX_PREFETCH
    l += __shfl_xor(l, 32);
    __syncthreads();
    constexpr int L_ML = 65536;
    if (par == 1) {
#pragma unroll
        for (int d = 0; d < 4; ++d)
#pragma unroll
            for (int r = 0; r < 16; ++r) lds_st<float>(lds, ((rg * 64 + d * 16 + r) * 64 + lane) * 4, o[d][r]);
        lds_st<float>(lds, L_ML + (rg * 128 + lane) * 4, m); lds_st<float>(lds, L_ML + (rg * 128 + 64 + lane) * 4, l);
    }
    __syncthreads();
    if (par == 0) {
        const float m1 = lds_ld<float>(lds, L_ML + (rg * 128 + lane) * 4), l1 = lds_ld<float>(lds, L_ML + (rg * 128 + 64 + lane) * 4);
        const float mt = fmaxf(m, m1), a0 = __builtin_amdgcn_exp2f(m - mt), a1 = __builtin_amdgcn_exp2f(m1 - mt);
        const float inv = 1.0f / (l * a0 + l1 * a1);
        bf16* op = OF + qrow * 1024 + h * 128 + 4 * hi;
#pragma unroll
        for (int d = 0; d < 4; ++d)
#pragma unroll
            for (int g = 0; g < 4; ++g) { float v[4];
#pragma unroll
                for (int j = 0; j < 4; ++j) v[j] = (o[d][4 * g + j] * a0 + lds_ld<float>(lds, ((rg * 64 + d * 16 + 4 * g + j) * 64 + lane) * 4) * a1) * inv;
                *(v2u*)(op + 32 * d + 8 * g) = (v2u){cvtpk(v[0], v[1]), cvtpk(v[2], v[3])}; }
    }
}

__device__ __forceinline__ void gla_norm_pass(unsigned char* ws, const float* gng, int G) {
    const float* ORAW = (const float*)(ws + WS_ORAW); bf16* GR = (bf16*)(ws + WS_GR);
    const int lane = threadIdx.x & 63; const int gw = blockIdx.x * 8 + (threadIdx.x >> 6), NGW = G * 8;
    for (int it = gw; it < MTOK * 4; it += NGW) {
        const size_t off = (size_t)it * 512 + lane * 8;
        const v4f a = *(const v4f*)(ORAW + off), b = *(const v4f*)(ORAW + off + 4);
        float ss = (a[0] * a[0] + a[1] * a[1]) + (a[2] * a[2] + a[3] * a[3]) + (b[0] * b[0] + b[1] * b[1]) + (b[2] * b[2] + b[3] * b[3]);
        ss = wave_sum(ss);
        const float rstd = 1.0f / sqrtf(ss * (1.0f / 512.0f) + RMS_EPS);
        const v4u gw4 = *(const v4u*)(GR + off); const v4f g0 = *(const v4f*)(gng + lane * 8), g1 = *(const v4f*)(gng + lane * 8 + 4);
        float gr[8];
#pragma unroll
        for (int j = 0; j < 4; ++j) { gr[2 * j] = bf_lo(gw4[j]); gr[2 * j + 1] = bf_hi(gw4[j]); }
        float r[8];
#pragma unroll
        for (int j = 0; j < 4; ++j) { r[j] = a[j] * rstd * g0[j] * (gr[j] * pg8::fsigmoid(gr[j])); r[4 + j] = b[j] * rstd * g1[j] * (gr[4 + j] * pg8::fsigmoid(gr[4 + j])); }
        v4u o; o.x = cvtpk(r[0], r[1]); o.y = cvtpk(r[2], r[3]); o.z = cvtpk(r[4], r[5]); o.w = cvtpk(r[6], r[7]);
        *(v4u*)(GR + off) = o;
    }
}
__device__ __forceinline__ void ln_pass(const float* src, float* dst, bf16* dstb, const float* g, const float* bta, int G) {
    const int lane = threadIdx.x & 63; const int gw = blockIdx.x * 8 + (threadIdx.x >> 6), NGW = G * 8;
    for (int row = gw; row < MTOK; row += NGW) {
        const float* xr = src + (size_t)row * DM + lane * 4;
        v4f v[8]; float s = 0.f;
#pragma unroll
        for (int j = 0; j < 8; ++j) { v[j] = *(const v4f*)(xr + 256 * j); s += (v[j][0] + v[j][1]) + (v[j][2] + v[j][3]); }
        const float mean = wave_sum(s) * (1.0f / DM); float s2 = 0.f;
#pragma unroll
        for (int j = 0; j < 8; ++j) { v[j] = v[j] - mean; s2 += (v[j][0] * v[j][0] + v[j][1] * v[j][1]) + (v[j][2] * v[j][2] + v[j][3] * v[j][3]); }
        const float rstd = 1.0f / sqrtf(wave_sum(s2) * (1.0f / DM) + LN_EPS);
#pragma unroll
        for (int j = 0; j < 8; ++j) { const v4f gg = *(const v4f*)(g + lane * 4 + 256 * j), bb = *(const v4f*)(bta + lane * 4 + 256 * j); const v4f y = v[j] * rstd * gg + bb;
            *(v4f*)(dst + (size_t)row * DM + lane * 4 + 256 * j) = y;
            *(v2u*)(dstb + (size_t)row * DM + lane * 4 + 256 * j) = (v2u){cvtpk(y[0], y[1]), cvtpk(y[2], y[3])}; }
    }
}

#ifndef PH
#define PH 0xFFFF
#endif
#ifndef PROBE
#define PROBE 0
#endif
struct Args { const float* in[21]; float* out; unsigned char* ws; };
__global__ void __launch_bounds__(512, 2) mega_fwd(Args args) {
    extern __shared__ __attribute__((aligned(16))) unsigned char lds_raw[];
    lds_t lds = (lds_t)lds_raw;
    volatile LAS unsigned* MISC = (volatile LAS unsigned*)(lds + MISC_OFF);
    const int tid = threadIdx.x, G = gridDim.x;
    unsigned char* ws = args.ws;
    unsigned* ctl = (unsigned*)(ws + WS_CTL);
    if (tid < 64) MISC[tid] = 0u;
    __syncthreads();
    XcdBarrier bar = xcd_barrier_post(ctl + CW_BAR, MISC + 8);
#if PROBE
    int nstamp = 0;
#define STAMP() do { if (blockIdx.x == 0 && tid == 0) MISC[32 + nstamp] = (unsigned)__builtin_amdgcn_s_memrealtime(); ++nstamp; } while (0)
#else
#define STAMP() do { } while (0)
#endif
#define GRID_BAR() do { xcd_barrier(bar); STAMP(); } while (0)
    STAMP();

    if (PH & 1) p0_prologue(lds, args.in, ws, G);
    cg::this_grid().sync();
    STAMP();

    if (PH & 2) { pg8::Gemm g{(const pg8::bf16_t*)(ws + WS_XB), (const pg8::bf16_t*)(ws + WS_WIN), MTOK, NPAD, DM}; pg8::StaticOrder S; S.init(MTOK, NPAD, G, (int)blockIdx.x);
      pg8::EpiProj E{ws, 0.08838834764831845f * LOG2E};
      pg8::gemm_phase<pg8::EpiProj, pg8::StaticOrder, true, true>(lds, g, S, E); }
    GRID_BAR();

    if (PH & 4) for (int it = blockIdx.x; it < 512 + 1024 + 16; it += G) {
        if (it < 512) gla_prep_item(lds, it, ws, args.in[3], args.in[4], tid);
        else if (it < 1536) fv_tr_item(lds, it - 512, ws, tid);
        else fox_cumsum_item(lds, it - 1536, ws, args.in[6], tid);
    }
    GRID_BAR();

    if (PH & 8) for (int it = blockIdx.x; it < 32 * NSEG; it += G) gla_scan_item(lds, it, ws, tid);
#if PROBE
    if (blockIdx.x == 0 && tid == 0) MISC[31] = (unsigned)__builtin_amdgcn_s_memrealtime();
#endif
    if (PH & 16) for (;;) {
        __syncthreads();
        if (tid == 0) MISC[16] = __hip_atomic_fetch_add(ctl + CW_QUEUE, 1u, RLX_AGENT);
        __syncthreads();
        const int j = (int)MISC[16];
        if (j >= 512) break;
        fox_unit(lds, j & 15, 31 - (j >> 4), ws, tid);
    }
    GRID_BAR();
    if (PH & 0x4000) for (int it = blockIdx.x; it < 32 * NSEG; it += G) { if ((it & (NSEG - 1)) != 0) gla_fix_item(lds, it, ws, tid); }
    GRID_BAR();

    if (PH & 32) gla_norm_pass(ws, args.in[5], G);
    GRID_BAR();

    if (PH & 64) { pg8::StaticOrder S; S.init(MTOK, DM, G, (int)blockIdx.x);
      { pg8::Gemm g{(const pg8::bf16_t*)(ws + WS_OG), (const pg8::bf16_t*)(ws + WS_WBG), MTOK, DM, 2048};
        pg8::EpiEw<1> E{(float*)(ws + WS_YTMP), nullptr, nullptr, (const pg8::bf16_t*)(ws + WS_MA), DM, 0.f};
        pg8::gemm_phase<pg8::EpiEw<1>, pg8::StaticOrder, false, true>(lds, g, S, E); }
      asm volatile("s_waitcnt vmcnt(0)" ::: "memory"); __syncthreads();
      { pg8::Gemm g{(const pg8::bf16_t*)(ws + WS_OF), (const pg8::bf16_t*)(ws + WS_WBF), MTOK, DM, 1024};
        pg8::EpiEw<2> E{nullptr, (pg8::bf16_t*)(ws + WS_MERGED), (const float*)(ws + WS_YTMP), (const pg8::bf16_t*)(ws + WS_MB), DM, 0.f};
        pg8::gemm_phase<pg8::EpiEw<2>, pg8::StaticOrder, false, true>(lds, g, S, E); } }
    GRID_BAR();

    if (PH & 128) { pg8::StaticOrder S; S.init(MTOK, DM, G, (int)blockIdx.x);
      pg8::Gemm g{(const pg8::bf16_t*)(ws + WS_MERGED), (const pg8::bf16_t*)(ws + WS_WOUT), MTOK, DM, 2048};
      pg8::EpiEw<3> E{(float*)(ws + WS_X1), nullptr, args.in[0], nullptr, DM, ALPHA_RES};
      pg8::gemm_phase<pg8::EpiEw<3>, pg8::StaticOrder, false, true>(lds, g, S, E); }
    GRID_BAR();
    if (PH & 256) ln_pass((const float*)(ws + WS_X1), (float*)(ws + WS_X1), (bf16*)(ws + WS_XNB), args.in[10], args.in[11], G);
    GRID_BAR();

    if (PH & 512) { pg8::StaticOrder S; S.init(MTOK, FF, G, (int)blockIdx.x);
      pg8::Gemm g{(const pg8::bf16_t*)(ws + WS_XNB), (const pg8::bf16_t*)(ws + WS_WG), MTOK, FF, 2048};
      pg8::EpiBf E{(pg8::bf16_t*)(ws + WS_G), FF};
      pg8::gemm_phase<pg8::EpiBf, pg8::StaticOrder, true, true>(lds, g, S, E); }
    GRID_BAR();
    if (PH & 1024) { pg8::StaticOrder S; S.init(MTOK, FF, G, (int)blockIdx.x);
      pg8::Gemm g{(const pg8::bf16_t*)(ws + WS_XNB), (const pg8::bf16_t*)(ws + WS_WU), MTOK, FF, 2048};
      pg8::EpiUp E{(const pg8::bf16_t*)(ws + WS_G), (pg8::bf16_t*)(ws + WS_H), args.in[14], args.in[15]};
      pg8::gemm_phase<pg8::EpiUp, pg8::StaticOrder, true, true>(lds, g, S, E); }
    GRID_BAR();
    if (PH & 2048) { pg8::StaticOrder S; S.init(MTOK, DM, G, (int)blockIdx.x);
      pg8::Gemm g{(const pg8::bf16_t*)(ws + WS_H), (const pg8::bf16_t*)(ws + WS_WD), MTOK, DM, FF};
      pg8::EpiEw<3> E{(float*)(ws + WS_V2), nullptr, (const float*)(ws + WS_X1), nullptr, DM, ALPHA_RES};
      pg8::gemm_phase<pg8::EpiEw<3>, pg8::StaticOrder, false, true>(lds, g, S, E); }
    GRID_BAR();
    if (PH & 4096) ln_pass((const float*)(ws + WS_V2), args.out, (bf16*)(ws + WS_XNB), args.in[17], args.in[18], G);
    GRID_BAR();

    if (PH & 8192) { pg8::StaticOrder S; S.init(MTOK, DM, G, (int)blockIdx.x);
      { pg8::Gemm g{(const pg8::bf16_t*)(ws + WS_PB), (const pg8::bf16_t*)(ws + WS_WPP), MTOK, DM, PLE};
        pg8::EpiEw<0> E{(float*)(ws + WS_TMP), nullptr, nullptr, nullptr, DM, 0.f};
        pg8::gemm_phase<pg8::EpiEw<0>, pg8::StaticOrder, false, true>(lds, g, S, E); }
      asm volatile("s_waitcnt vmcnt(0)" ::: "memory"); __syncthreads();
      { pg8::Gemm g{(const pg8::bf16_t*)(ws + WS_XNB), (const pg8::bf16_t*)(ws + WS_WPG), MTOK, DM, 2048};
        pg8::EpiEw<4> E{args.out, nullptr, (const float*)(ws + WS_TMP), nullptr, DM, 0.f};
        pg8::gemm_phase<pg8::EpiEw<4>, pg8::StaticOrder, false, true>(lds, g, S, E); } }
#if PROBE
    GRID_BAR();
    if (blockIdx.x == 0 && tid == 0) {
        const unsigned ta = (PROBE_A == 99) ? (MISC[31] - MISC[32 + 3]) : (MISC[32 + PROBE_A + 1] - MISC[32 + PROBE_A]);
        const unsigned tb = (PROBE_B == 99) ? (MISC[31] - MISC[32 + 3]) : (MISC[32 + PROBE_B + 1] - MISC[32 + PROBE_B]);
        __hip_atomic_store(ctl + 80, ta, RLX_AGENT); __hip_atomic_store(ctl + 81, tb, RLX_AGENT);
    }
    GRID_BAR();
    { unsigned na = __hip_atomic_load(ctl + 80, RLX_AGENT) * 40u; const unsigned tb = __hip_atomic_load(ctl + 81, RLX_AGENT);
      if (na > 8000000u) na = 8000000u;
      for (unsigned i = blockIdx.x * 512 + tid; i < na; i += G * 512) args.out[i] += 0.008f;
      const unsigned long long t0 = __builtin_amdgcn_s_memrealtime();
      while (__builtin_amdgcn_s_memrealtime() - t0 < 2ull * tb) __builtin_amdgcn_s_sleep(8); }
#endif
}

extern "C" void kernel_launch(void* const* d_in, const int* in_sizes, int n_in, void* d_out, int out_size, void* d_ws, size_t ws_size, hipStream_t stream) {
    static int grid = 0;
    if (grid == 0) {
        if (n_in != 21 || in_sizes[0] != MTOK * DM || out_size != MTOK * DM || ws_size < WS_END) { fprintf(stderr, "kernel_launch: unexpected shapes (n_in %d, in0 %d, out %d, ws %zu < %zu)\n", n_in, n_in > 0 ? in_sizes[0] : -1, out_size, ws_size, (size_t)WS_END); grid = -1; return; }
        int dev = 0, cus = 0, per_cu = 0;
        if (hipGetDevice(&dev) != hipSuccess || hipDeviceGetAttribute(&cus, hipDeviceAttributeMultiprocessorCount, dev) != hipSuccess) { fprintf(stderr, "kernel_launch: device query failed\n"); grid = -1; return; }
        if (hipFuncSetAttribute((const void*)mega_fwd, hipFuncAttributeMaxDynamicSharedMemorySize, LDS_BYTES) != hipSuccess) { fprintf(stderr, "kernel_launch: hipFuncSetAttribute failed\n"); grid = -1; return; }
        if (hipOccupancyMaxActiveBlocksPerMultiprocessor(&per_cu, (const void*)mega_fwd, 512, LDS_BYTES) != hipSuccess || per_cu < 1) { fprintf(stderr, "kernel_launch: occupancy query says %d blocks per CU\n", per_cu); per_cu = 1; }
        (void)hipGetLastError();
        grid = cus;
    }
    if (grid < 0) return;
    if (hipMemsetAsync((char*)d_ws + WS_CTL, 0, CTL_ZERO_BYTES, stream) != hipSuccess) { fprintf(stderr, "kernel_launch: memset failed\n"); return; }
    Args a{};
    for (int i = 0; i < 21; ++i) a.in[i] = (const float*)d_in[i];
    a.out = (float*)d_out; a.ws = (unsigned char*)d_ws;
    void* kargs[] = {&a};
    const hipError_t e = hipLaunchCooperativeKernel((const void*)mega_fwd, dim3(grid), dim3(512), kargs, LDS_BYTES, stream);
    if (e != hipSuccess) fprintf(stderr, "kernel_launch: cooperative launch failed: %s (grid %d)\n", hipGetErrorString(e), grid);
}
```

```cpp
#include <hip/hip_runtime.h>
#include <hip/hip_cooperative_groups.h>
#include <cstdio>
#include <cstdint>
namespace cg = cooperative_groups;

constexpr int BATCH = 2, SEQ = 4096, DM = 2048, MTOK = BATCH * SEQ;
constexpr int N_IN = 13336, NPAD = 13568, FF = 5632, PLE = 256;
constexpr float ALPHA_RES = 1.189207115002721f;
constexpr float LN_EPS = 1e-5f, RMS_EPS = 1e-6f;
constexpr float LOG2E = 1.4426950408889634f;

constexpr size_t MiB = 1u << 20;
constexpr size_t WS_CTL = 0, CTL_ZERO_BYTES = 65536;
constexpr size_t WS_WBG = 1 * MiB, WS_WBF = 9 * MiB, WS_WOUT = 13 * MiB, WS_WG = 21 * MiB, WS_WU = 43 * MiB, WS_WD = 65 * MiB, WS_WPG = 87 * MiB, WS_WPP = 95 * MiB;
constexpr size_t WS_PB = 96 * MiB;
constexpr size_t WS_R1 = 100 * MiB;
constexpr size_t WS_WIN = WS_R1, WS_XB = WS_R1 + 53 * MiB;
constexpr size_t WS_QT = WS_R1, WS_KT = WS_R1 + 16 * MiB, WS_VT = WS_R1 + 32 * MiB, WS_ATT = WS_R1 + 64 * MiB, WS_DEC = WS_R1 + 68 * MiB, WS_FVT = WS_R1 + 69 * MiB, WS_CB = WS_R1 + 85 * MiB;
constexpr size_t WS_YTMP = WS_R1;
constexpr size_t WS_G = WS_R1;
constexpr size_t WS_V2 = WS_R1;
constexpr size_t WS_GQ = 188 * MiB, WS_GK = 204 * MiB, WS_GV = 220 * MiB, WS_GR = 252 * MiB, WS_FQ = 284 * MiB, WS_FK = 300 * MiB, WS_FV = 316 * MiB, WS_MB = 332 * MiB, WS_MA = 364 * MiB, WS_SM = 396 * MiB;
constexpr size_t WS_ORAW = WS_GQ;
constexpr size_t WS_X1 = WS_GQ;
constexpr size_t WS_OG = WS_GR, WS_OF = WS_FQ, WS_MERGED = WS_FK;
constexpr size_t WS_H = WS_GR;
constexpr size_t WS_TMP = WS_GR;
constexpr size_t WS_XNB = WS_MA;
constexpr size_t WS_LSEG = 397 * MiB;
constexpr size_t WS_PDEC = 413 * MiB;
constexpr size_t WS_DSEG = 413 * MiB + 512 * 1024;
constexpr size_t WS_END = 414 * MiB;
constexpr int CW_QUEUE = 64, CW_QUEUE2 = 128;
constexpr int CW_BAR = 4096;

constexpr int LDS_BYTES = 147456;
constexpr int MISC_OFF = LDS_BYTES - 256;
#define LAS __attribute__((address_space(3)))
typedef LAS unsigned char* lds_t;
namespace pg8 {
#define PG8_LAS __attribute__((address_space(3)))
typedef unsigned short bf16_t;
typedef short bf16x8 __attribute__((ext_vector_type(8)));
typedef float f32x4 __attribute__((ext_vector_type(4)));
typedef unsigned u32x4 __attribute__((ext_vector_type(4)));
constexpr int BM = 256, BK = 64, HALF = 128, HTB = HALF * BK * 2  , STAGE_BYTES = 8 * HTB, NXCD = 8, WGM = 8;

__host__ __device__ __forceinline__ int lds_byte(int r, int c) { const int st = (r >> 4) * 2 + (c >> 5), rr = r & 15, cc = c & 31, ob = rr * 64 + cc * 2; return st * 1024 + (ob ^ (((ob >> 9) & 1) << 5)); }
__host__ __device__ __forceinline__ void stage_rc(int b, int& R, int& C) { const int st = b / 1024, sb = b % 1024, swz = sb ^ (((sb >> 9) & 1) << 5); R = (st >> 1) * 16 + swz / 64; C = (st & 1) * 32 + (swz % 64) / 2; }
__host__ __device__ __forceinline__ int perm32(int rho) { const int n = rho >> 4, i = rho & 15; return 8 * (i >> 2) + 4 * n + (i & 3); }

struct Unit { int pm, pn; };
struct Gemm { const bf16_t* A; const bf16_t* Bt; int M, N, K; };

struct StaticOrder {
    int nM, nN, nwg, G, c;
    __host__ __device__ void init(int M, int N, int G_, int c_) { nM = M / BM; nN = N / BM; nwg = nM * nN; G = G_; c = c_; }
    __host__ __device__ bool next(int i, Unit& u) const {
        const long L = (long)i * G + c; if (L >= nwg) return false;
        int wgid = (int)L; { const int q = nwg / NXCD, r = nwg % NXCD, xcd = wgid % NXCD, off = wgid / NXCD; wgid = (xcd < r ? xcd * (q + 1) : r * (q + 1) + (xcd - r) * q) + off; }
        const int nig = WGM * nN, gid = wgid / nig, fm = gid * WGM, gsz = (nM - fm) < WGM ? (nM - fm) : WGM;
        u.pm = fm + ((wgid % nig) % gsz); u.pn = (wgid % nig) / gsz; return true;
    }
    __device__ __forceinline__ void a_ready(const Unit&) const {}
    __device__ __forceinline__ void done(const Unit&) const {}
};

__device__ __forceinline__ unsigned cvt_pk_bf16(float lo, float hi) { unsigned r; asm volatile("v_cvt_pk_bf16_f32 %0, %1, %2" : "=v"(r) : "v"(lo), "v"(hi)); return r; }
typedef float f32x2 __attribute__((ext_vector_type(2)));

__device__ __forceinline__ float fsigmoid(float x) { return __builtin_amdgcn_rcpf(1.0f + __builtin_amdgcn_exp2f(-1.4426950408889634f * x)); }
__device__ __forceinline__ void unpack8(const u32x4 w, float (&f)[8]) {
#pragma unroll
    for (int i = 0; i < 4; ++i) { f[2 * i] = __uint_as_float(w[i] << 16); f[2 * i + 1] = __uint_as_float(w[i] & 0xffff0000u); }
}
__device__ __forceinline__ u32x4 pack8(const f32x4 a, const f32x4 b) { u32x4 w; w.x = cvt_pk_bf16(a[0], a[1]); w.y = cvt_pk_bf16(a[2], a[3]); w.z = cvt_pk_bf16(b[0], b[1]); w.w = cvt_pk_bf16(b[2], b[3]); return w; }

struct EpiProj {
    static constexpr bool PERM = true, AFTER_DRAIN = false;
    unsigned char* ws; float qscale;
    __device__ __forceinline__ void operator()(const f32x4 (&acc)[2][2][4][2], const Unit& u, int wr, int wc, int fr, int fq) const {
        const int pn = u.pn; const int row0 = u.pm * BM + wr * 64 + fr;
        if (pn == 52) {
            if (wc == 0) { float* sm = (float*)(ws + WS_SM);
#pragma unroll
                for (int ai = 0; ai < 2; ++ai)
#pragma unroll
                    for (int m = 0; m < 4; ++m) { float* rp = sm + (size_t)(row0 + ai * HALF + m * 16) * 32 + 8 * fq; *(f32x4*)rp = acc[ai][0][m][0]; *(f32x4*)(rp + 4) = acc[ai][0][m][1]; } }
            return;
        }
        size_t off; int ldc, ct; float sc = 1.f;
        if (pn < 4) { off = WS_GQ; ldc = 1024; ct = pn; }
        else if (pn < 8) { off = WS_GK; ldc = 1024; ct = pn - 4; }
        else if (pn < 16) { off = WS_GV; ldc = 2048; ct = pn - 8; }
        else if (pn < 24) { off = WS_GR; ldc = 2048; ct = pn - 16; }
        else if (pn < 28) { off = WS_FQ; ldc = 1024; ct = pn - 24; sc = qscale; }
        else if (pn < 32) { off = WS_FK; ldc = 1024; ct = pn - 28; }
        else if (pn < 36) { off = WS_FV; ldc = 1024; ct = pn - 32; }
        else if (pn < 44) { off = WS_MA; ldc = 2048; ct = pn - 36; }
        else { off = WS_MB; ldc = 2048; ct = pn - 44; }
        bf16_t* base = (bf16_t*)(ws + off); const int col0 = ct * BM + wc * 32 + 8 * fq;
#pragma unroll
        for (int ai = 0; ai < 2; ++ai)
#pragma unroll
            for (int m = 0; m < 4; ++m) { bf16_t* rowp = base + (size_t)(row0 + ai * HALF + m * 16) * ldc + col0;
#pragma unroll
                for (int bj = 0; bj < 2; ++bj) *(u32x4*)(rowp + bj * HALF) = pack8(acc[ai][bj][m][0] * sc, acc[ai][bj][m][1] * sc); }
    }
};
struct EpiBf {
    static constexpr bool PERM = true, AFTER_DRAIN = false;
    bf16_t* O; int ldc;
    __device__ __forceinline__ void operator()(const f32x4 (&acc)[2][2][4][2], const Unit& u, int wr, int wc, int fr, int fq) const {
        const int row0 = u.pm * BM + wr * 64 + fr, col0 = u.pn * BM + wc * 32 + 8 * fq;
#pragma unroll
        for (int ai = 0; ai < 2; ++ai)
#pragma unroll
            for (int m = 0; m < 4; ++m) { bf16_t* rowp = O + (size_t)(row0 + ai * HALF + m * 16) * ldc + col0;
#pragma unroll
                for (int bj = 0; bj < 2; ++bj) *(u32x4*)(rowp + bj * HALF) = pack8(acc[ai][bj][m][0], acc[ai][bj][m][1]); }
    }
};
template <int MODE> struct EpiEw {
    static constexpr bool PERM = true, AFTER_DRAIN = false;
    float* O32; bf16_t* Obf; const float* I32; const bf16_t* GATE; int ldc; float alpha;
    __device__ __forceinline__ void operator()(const f32x4 (&acc)[2][2][4][2], const Unit& u, int wr, int wc, int fr, int fq) const {
        const int row0 = u.pm * BM + wr * 64 + fr, col0 = u.pn * BM + wc * 32 + 8 * fq;
#pragma unroll
        for (int ai = 0; ai < 2; ++ai)
#pragma unroll
            for (int m = 0; m < 4; ++m) { const size_t ro = (size_t)(row0 + ai * HALF + m * 16) * ldc + col0;
#pragma unroll
                for (int bj = 0; bj < 2; ++bj) { const size_t o = ro + bj * HALF; f32x4 a0 = acc[ai][bj][m][0], a1 = acc[ai][bj][m][1];
                    if (MODE == 0) { *(f32x4*)(O32 + o) = a0; *(f32x4*)(O32 + o + 4) = a1; }
                    if (MODE == 1 || MODE == 2) { float g[8]; unpack8(*(const u32x4*)(GATE + o), g);
#pragma unroll
                        for (int j = 0; j < 4; ++j) { a0[j] *= fsigmoid(g[j]); a1[j] *= fsigmoid(g[4 + j]); }
                        if (MODE == 1) { *(f32x4*)(O32 + o) = a0; *(f32x4*)(O32 + o + 4) = a1; }
                        else { const f32x4 i0 = *(const f32x4*)(I32 + o), i1 = *(const f32x4*)(I32 + o + 4); *(u32x4*)(Obf + o) = pack8(a0 + i0, a1 + i1); } }
                    if (MODE == 3) { const f32x4 i0 = *(const f32x4*)(I32 + o), i1 = *(const f32x4*)(I32 + o + 4); *(f32x4*)(O32 + o) = i0 * alpha + a0; *(f32x4*)(O32 + o + 4) = i1 * alpha + a1; }
                    if (MODE == 4) { const f32x4 i0 = *(const f32x4*)(I32 + o), i1 = *(const f32x4*)(I32 + o + 4); f32x4 x0 = *(const f32x4*)(O32 + o), x1 = *(const f32x4*)(O32 + o + 4);
#pragma unroll
                        for (int j = 0; j < 4; ++j) { x0[j] += fsigmoid(a0[j]) * i0[j]; x1[j] += fsigmoid(a1[j]) * i1[j]; }
                        *(f32x4*)(O32 + o) = x0; *(f32x4*)(O32 + o + 4) = x1; }
                } }
    }
};
struct EpiUp {
    static constexpr bool PERM = true, AFTER_DRAIN = false;
    const bf16_t* G; bf16_t* H; const float* cw; const float* cb;
    __device__ __forceinline__ void operator()(const f32x4 (&acc)[2][2][4][2], const Unit& u, int wr, int wc, int fr, int fq) const {
        const int row0 = u.pm * BM + wr * 64 + fr;
#pragma unroll
        for (int bj = 0; bj < 2; ++bj) {
            const int c0 = u.pn * BM + bj * HALF + wc * 32 + 8 * fq;
            const f32x4 w0a = *(const f32x4*)(cw + c0), w0b = *(const f32x4*)(cw + c0 + 4), w1a = *(const f32x4*)(cw + FF + c0), w1b = *(const f32x4*)(cw + FF + c0 + 4);
            const f32x4 w2a = *(const f32x4*)(cw + 2 * FF + c0), w2b = *(const f32x4*)(cw + 2 * FF + c0 + 4), ba = *(const f32x4*)(cb + c0), bb = *(const f32x4*)(cb + c0 + 4);
#pragma unroll
            for (int ai = 0; ai < 2; ++ai)
#pragma unroll
                for (int m = 0; m < 4; ++m) {
                    const int r = row0 + ai * HALF + m * 16, t = r & (SEQ - 1);
                    const int r1 = t >= 1 ? r - 1 : r, r2 = t >= 2 ? r - 2 : r; const float f1 = t >= 1 ? 1.f : 0.f, f2 = t >= 2 ? 1.f : 0.f;
                    float g2[8], g1[8], g0[8];
                    unpack8(*(const u32x4*)(G + (size_t)r * FF + c0), g2); unpack8(*(const u32x4*)(G + (size_t)r1 * FF + c0), g1); unpack8(*(const u32x4*)(G + (size_t)r2 * FF + c0), g0);
                    f32x4 h0, h1;
#pragma unroll
                    for (int j = 0; j < 4; ++j) {
                        const float ca = ba[j] + w0a[j] * (g0[j] * f2) + w1a[j] * (g1[j] * f1) + w2a[j] * g2[j];
                        const float cb_ = bb[j] + w0b[j] * (g0[4 + j] * f2) + w1b[j] * (g1[4 + j] * f1) + w2b[j] * g2[4 + j];
                        const float ya = 1.5957691216057308f * (ca + 0.044715f * ca * ca * ca), yb = 1.5957691216057308f * (cb_ + 0.044715f * cb_ * cb_ * cb_);
                        h0[j] = ca * fsigmoid(ya) * acc[ai][bj][m][0][j]; h1[j] = cb_ * fsigmoid(yb) * acc[ai][bj][m][1][j];
                    }
                    *(u32x4*)(H + (size_t)r * FF + c0) = pack8(h0, h1);
                }
        }
    }
};

template <class Epi, class Sched, bool ALIGN_EPI = false, bool SP2 = false>
__device__ __forceinline__ void gemm_phase(PG8_LAS unsigned char* lds, const Gemm g, const Sched& S, const Epi& E) {
    int tid_ = threadIdx.x; asm volatile("" : "+v"(tid_));
    const int tid = tid_, wid = __builtin_amdgcn_readfirstlane(tid >> 6), lane = tid & 63, wr = wid >> 2, wc = wid & 3, fr = lane & 15, fq = lane >> 4;
    const int K = g.K, nt = K / BK;
    unsigned voffA[2], voffB[2];
#pragma unroll
    for (int i = 0; i < 2; ++i) { int R, C; stage_rc(tid * 16 + i * 8192, R, C); const int Rb = Epi::PERM ? ((R & ~31) + perm32(R & 31)) : R;
        voffA[i] = (unsigned)(R * K + C) * 2u; voffB[i] = (unsigned)(Rb * K + C) * 2u; }
    const size_t kstep = (size_t)(BK * 2);
    const size_t hstep = (size_t)HALF * K * 2;
    const size_t tstep = 2 * hstep;
    const unsigned ldsw = (unsigned)wid * 1024u;
    const int aoff = lds_byte(wr * 64 + fr, fq * 8), boff = lds_byte(wc * 32 + fr, fq * 8);
#define PG8_SA(b, h) (((b) * 2 + (h)) * HTB)
#define PG8_SB(b, h) ((4 + (b) * 2 + (h)) * HTB)
#define PG8_STAGE(bufoff, gbase, voff) do { _Pragma("unroll") for (int _i = 0; _i < 2; ++_i) \
        __builtin_amdgcn_global_load_lds((const unsigned*)((const char*)(gbase) + (voff)[_i]), (PG8_LAS unsigned*)(lds + (bufoff) + ldsw + _i * 8192), 16, 0, 0); } while (0)
#define PG8_LDA(dst, b, h) do { _Pragma("unroll") for (int m = 0; m < 4; ++m) _Pragma("unroll") for (int k = 0; k < 2; ++k) dst[m][k] = *(const PG8_LAS bf16x8*)(lds + PG8_SA(b, h) + aoff + m * 2048 + k * 1024); } while (0)
#define PG8_LDB(dst, b, h) do { _Pragma("unroll") for (int n = 0; n < 2; ++n) _Pragma("unroll") for (int k = 0; k < 2; ++k) dst[n][k] = *(const PG8_LAS bf16x8*)(lds + PG8_SB(b, h) + boff + n * 2048 + k * 1024); } while (0)
#define PG8_MMA(ai, bj, At, Bt) do { __builtin_amdgcn_s_setprio(1); _Pragma("unroll") for (int m = 0; m < 4; ++m) _Pragma("unroll") for (int n = 0; n < 2; ++n) _Pragma("unroll") for (int k = 0; k < 2; ++k) \
        acc[ai][bj][m][n] = __builtin_amdgcn_mfma_f32_16x16x32_bf16(Bt[n][k], At[m][k], acc[ai][bj][m][n], 0, 0, 0); __builtin_amdgcn_s_setprio(0); } while (0)
#define PG8_WAIT_V(n) asm volatile("s_waitcnt vmcnt(" #n ")" ::: "memory")
#define PG8_WAIT_L(n) asm volatile("s_waitcnt lgkmcnt(" #n ")" ::: "memory")
#define PG8_BAR __builtin_amdgcn_s_barrier()
#define PG8_SCHED __builtin_amdgcn_sched_barrier(0)
    Unit cur, nxt; int ui = 0;
    if (!S.next(0, cur)) return;
    f32x4 acc[2][2][4][2];
#pragma unroll
    for (int a = 0; a < 2; ++a)
#pragma unroll
        for (int b = 0; b < 2; ++b)
#pragma unroll
            for (int m = 0; m < 4; ++m)
#pragma unroll
                for (int n = 0; n < 2; ++n) acc[a][b][m][n] = (f32x4){0.f, 0.f, 0.f, 0.f};
    bf16x8 At[4][2], B0[2][2], B1[2][2];
    const char* cA = (const char*)g.A + (size_t)cur.pm * tstep; const char* cB = (const char*)g.Bt + (size_t)cur.pn * tstep;
    S.a_ready(cur);
    if constexpr (SP2) {
        PG8_STAGE(PG8_SB(0, 0), cB, voffB); PG8_STAGE(PG8_SB(0, 1), cB + hstep, voffB); PG8_STAGE(PG8_SA(0, 0), cA, voffA); PG8_STAGE(PG8_SA(0, 1), cA + hstep, voffA);
        if (wr == 1) PG8_BAR;
        PG8_WAIT_V(2); PG8_BAR;
        PG8_STAGE(PG8_SB(1, 0), cB + kstep, voffB); PG8_STAGE(PG8_SA(1, 0), cA + kstep, voffA); PG8_STAGE(PG8_SB(1, 1), cB + hstep + kstep, voffB);
        PG8_WAIT_V(6); PG8_BAR;
    } else {
        PG8_STAGE(PG8_SB(0, 0), cB, voffB); PG8_STAGE(PG8_SA(0, 0), cA, voffA); PG8_STAGE(PG8_SB(0, 1), cB + hstep, voffB); PG8_STAGE(PG8_SA(0, 1), cA + hstep, voffA);
        if (wr == 1) PG8_BAR;
        PG8_WAIT_V(4); PG8_BAR;
        PG8_STAGE(PG8_SB(1, 0), cB + kstep, voffB); PG8_STAGE(PG8_SA(1, 0), cA + kstep, voffA); PG8_STAGE(PG8_SB(1, 1), cB + hstep + kstep, voffB);
        PG8_WAIT_V(6); PG8_BAR;
    }
    for (;;) {
        const bool has_next = S.next(ui + 1, nxt);
        const char* nA = has_next ? (const char*)g.A + (size_t)nxt.pm * tstep : cA; const char* nB = has_next ? (const char*)g.Bt + (size_t)nxt.pn * tstep : cB;
        for (int t = 0; t < nt; t += 2) {
            const bool last = (t == nt - 2);
            const char* a1 = cA + (size_t)(t + 1) * kstep;
            const char* a2 = last ? nA : cA + (size_t)(t + 2) * kstep; const char* b2 = last ? nB : cB + (size_t)(t + 2) * kstep;
            const char* a3 = a2 + kstep; const char* b3 = b2 + kstep;
            if (last && has_next) S.a_ready(nxt);
            if constexpr (SP2) {
            PG8_LDB(B0, 0, 0); PG8_LDB(B1, 0, 1); PG8_SCHED; PG8_LDA(At, 0, 0); PG8_STAGE(PG8_SA(1, 1), a1 + hstep, voffA);
            PG8_WAIT_V(8); PG8_WAIT_L(0); PG8_BAR; PG8_MMA(0, 0, At, B0); PG8_MMA(0, 1, At, B1); PG8_BAR; PG8_SCHED;
            PG8_LDA(At, 0, 1); PG8_STAGE(PG8_SB(0, 0), b2, voffB); PG8_STAGE(PG8_SB(0, 1), b2 + hstep, voffB); PG8_STAGE(PG8_SA(0, 0), a2, voffA);
            PG8_WAIT_V(8); PG8_WAIT_L(0); PG8_BAR; PG8_MMA(1, 0, At, B0); PG8_MMA(1, 1, At, B1); PG8_BAR; PG8_SCHED;
            PG8_LDB(B0, 1, 0); PG8_LDB(B1, 1, 1); PG8_SCHED; PG8_LDA(At, 1, 0); PG8_STAGE(PG8_SA(0, 1), a2 + hstep, voffA);
            PG8_WAIT_V(8); PG8_WAIT_L(0); PG8_BAR; PG8_MMA(0, 0, At, B0); PG8_MMA(0, 1, At, B1); PG8_BAR; PG8_SCHED;
            PG8_LDA(At, 1, 1); PG8_STAGE(PG8_SB(1, 0), b3, voffB); PG8_STAGE(PG8_SB(1, 1), b3 + hstep, voffB); PG8_STAGE(PG8_SA(1, 0), a3, voffA);
            PG8_WAIT_V(8); PG8_WAIT_L(0); PG8_BAR; PG8_MMA(1, 0, At, B0); PG8_MMA(1, 1, At, B1); PG8_BAR; PG8_SCHED;
            } else {
            PG8_LDB(B0, 0, 0); PG8_SCHED; PG8_LDA(At, 0, 0); PG8_STAGE(PG8_SA(1, 1), a1 + hstep, voffA);
            PG8_WAIT_L(8); PG8_BAR; PG8_WAIT_L(0); PG8_MMA(0, 0, At, B0); PG8_BAR; PG8_SCHED;
            PG8_LDB(B1, 0, 1); PG8_STAGE(PG8_SB(0, 0), b2, voffB);
            PG8_BAR; PG8_WAIT_L(0); PG8_MMA(0, 1, At, B1); PG8_BAR;
            PG8_LDA(At, 0, 1); PG8_STAGE(PG8_SA(0, 0), a2, voffA);
            PG8_BAR; PG8_WAIT_L(0); PG8_MMA(1, 0, At, B0); PG8_BAR; PG8_SCHED;
            PG8_STAGE(PG8_SB(0, 1), b2 + hstep, voffB);
            PG8_WAIT_V(6); PG8_BAR; PG8_MMA(1, 1, At, B1); PG8_BAR;
            PG8_LDB(B0, 1, 0); PG8_SCHED; PG8_LDA(At, 1, 0); PG8_STAGE(PG8_SA(0, 1), a2 + hstep, voffA);
            PG8_WAIT_L(8); PG8_BAR; PG8_WAIT_L(0); PG8_MMA(0, 0, At, B0); PG8_BAR; PG8_SCHED;
            PG8_LDB(B1, 1, 1); PG8_STAGE(PG8_SB(1, 0), b3, voffB);
            PG8_BAR; PG8_WAIT_L(0); PG8_MMA(0, 1, At, B1); PG8_BAR;
            PG8_LDA(At, 1, 1); PG8_STAGE(PG8_SA(1, 0), a3, voffA);
            PG8_BAR; PG8_WAIT_L(0); PG8_MMA(1, 0, At, B0); PG8_BAR; PG8_SCHED;
            PG8_STAGE(PG8_SB(1, 1), b3 + hstep, voffB);
            PG8_WAIT_V(6); PG8_BAR; PG8_MMA(1, 1, At, B1); PG8_BAR;
            }
        }
        if constexpr (ALIGN_EPI) { if (wr == 0) PG8_BAR; }
        if constexpr (!Epi::AFTER_DRAIN) { E(acc, cur, wr, wc, fr, fq); S.done(cur); }
        if (!has_next) break;
#pragma unroll
        for (int a = 0; a < 2; ++a)
#pragma unroll
            for (int b = 0; b < 2; ++b)
#pragma unroll
                for (int m = 0; m < 4; ++m)
#pragma unroll
                    for (int n = 0; n < 2; ++n) acc[a][b][m][n] = (f32x4){0.f, 0.f, 0.f, 0.f};
        cur = nxt; cA = nA; cB = nB; ++ui;
        if constexpr (ALIGN_EPI) { if (wr == 1) PG8_BAR; }
    }
    PG8_WAIT_V(0);
    if constexpr (!ALIGN_EPI) { if (wr == 0) PG8_BAR; }
    PG8_BAR;
    if constexpr (Epi::AFTER_DRAIN) { E.fused(acc, cur, wr, wc, fr, fq, lds, wid, lane); S.done(cur); }
#undef PG8_SA
#undef PG8_SB
#undef PG8_STAGE
#undef PG8_LDA
#undef PG8_LDB
#undef PG8_MMA
#undef PG8_WAIT_V
#undef PG8_WAIT_L
#undef PG8_BAR
#undef PG8_SCHED
}
}

typedef unsigned short bf16;
typedef float v4f __attribute__((ext_vector_type(4)));
typedef float v16f __attribute__((ext_vector_type(16)));
typedef unsigned v4u __attribute__((ext_vector_type(4)));
typedef unsigned v2u __attribute__((ext_vector_type(2)));
typedef short v8s __attribute__((ext_vector_type(8)));
#define RLX_AGENT __ATOMIC_RELAXED, __HIP_MEMORY_SCOPE_AGENT
template <class T> __device__ __forceinline__ T lds_ld(lds_t p, int off) { return *(const LAS T*)(p + off); }
template <class T> __device__ __forceinline__ void lds_st(lds_t p, int off, T v) { *(LAS T*)(p + off) = v; }
__device__ __forceinline__ unsigned cvtpk(float lo, float hi) { return pg8::cvt_pk_bf16(lo, hi); }
__device__ __forceinline__ float bf_lo(unsigned w) { return __uint_as_float(w << 16); }
__device__ __forceinline__ float bf_hi(unsigned w) { return __uint_as_float(w & 0xffff0000u); }
__device__ __forceinline__ float wave_sum(float v) {
#pragma unroll
    for (int o = 1; o < 64; o <<= 1) v += __shfl_xor(v, o);
    return v;
}
#define MFMA16(a, b, c) __builtin_amdgcn_mfma_f32_16x16x32_bf16((a), (b), (c), 0, 0, 0)
#define MFMA32(a, b, c) __builtin_amdgcn_mfma_f32_32x32x16_bf16((a), (b), (c), 0, 0, 0)

#define XB_TMO      128
#define XB_XCNT(j)  (256  + 64 * (j))
#define XB_XSUB(j)  (1280 + 64 * (j))
#define XB_XGEN(j)  (2304 + 64 * (j))
#define XB_TOP      3328
#define XB_TOPGEN   3392
#define XCD_BAR_WORDS 3456
#define XB_SPIN_CAP (1u << 22)
__device__ __forceinline__ unsigned xb_ld(unsigned* p)              { return __hip_atomic_load(p, __ATOMIC_RELAXED, __HIP_MEMORY_SCOPE_AGENT); }
__device__ __forceinline__ unsigned xb_add(unsigned* p, unsigned v) { return __hip_atomic_fetch_add(p, v, __ATOMIC_RELAXED, __HIP_MEMORY_SCOPE_AGENT); }
__device__ __forceinline__ unsigned xb_xcc_id() { return (unsigned)__builtin_amdgcn_s_getreg((3 << 11) | 20) & 0xFu; }
#define XB_SPIN(cond, bar) do { unsigned _sp = 0; while (cond) { __builtin_amdgcn_s_sleep(1); \
    if ((++_sp & 255u) == 0u) { if (xb_ld(&(bar)[XB_TMO])) break; if (_sp > XB_SPIN_CAP) { atomicAdd(&(bar)[XB_TMO], 1u); break; } } } } while (0)
struct XcdBarrier { unsigned* bar; unsigned x; volatile LAS unsigned* st; };
__device__ __forceinline__ XcdBarrier xcd_barrier_post(unsigned* bar, volatile LAS unsigned* st) {
    XcdBarrier b; b.bar = bar; b.x = xb_xcc_id(); b.st = st;
    if (threadIdx.x == 0) (void)xb_add(&bar[XB_XCNT(b.x)], 1u);
    return b;
}
__device__ __forceinline__ void xcd_barrier_complete(unsigned* bar, unsigned x, unsigned& nloc, unsigned& nx) {
    const unsigned G = gridDim.x * gridDim.y * gridDim.z;
    unsigned sum, cnt, mine, sp = 0u;
    for (;;) {
        sum = 0u; cnt = 0u; mine = 0u;
#pragma unroll
        for (unsigned j = 0; j < 16; ++j) { const unsigned c = xb_ld(&bar[XB_XCNT(j)]); sum += c; cnt += (c > 0u) ? 1u : 0u; mine = (j == x) ? c : mine; }
        if (sum == G) break;
        __builtin_amdgcn_s_sleep(1);
        if ((++sp & 255u) == 0u) { if (xb_ld(&bar[XB_TMO])) break; if (sp > XB_SPIN_CAP) { atomicAdd(&bar[XB_TMO], 1u); break; } }
    }
    nloc = mine > 0u ? mine : 1u; nx = cnt > 0u ? cnt : 1u;
}
__device__ __forceinline__ void xcd_barrier(const XcdBarrier& b) {
    asm volatile("s_waitcnt vmcnt(0)" ::: "memory");
    __syncthreads();
    if (threadIdx.x == 0) {
        unsigned* bar = b.bar;
        __builtin_amdgcn_s_waitcnt(0);
        unsigned nloc = b.st[0], nx = b.st[1];
        if (nloc == 0u) { xcd_barrier_complete(bar, b.x, nloc, nx); b.st[0] = nloc; b.st[1] = nx; }
        const unsigned old = xb_add(&bar[XB_XSUB(b.x)], 1u);
        const unsigned gen = old / nloc;
        if (old + 1u == (gen + 1u) * nloc) {
            __builtin_amdgcn_fence(__ATOMIC_RELEASE, "agent");
            asm volatile("s_waitcnt vmcnt(0)" ::: "memory");
            const unsigned og = xb_add(&bar[XB_TOP], 1u);
            const unsigned tg = og / nx;
            if (og + 1u == (tg + 1u) * nx) xb_add(&bar[XB_TOPGEN], 1u);
            else XB_SPIN(xb_ld(&bar[XB_TOPGEN]) == tg, bar);
            __builtin_amdgcn_fence(__ATOMIC_ACQUIRE, "agent");
            xb_add(&bar[XB_XGEN(b.x)], 1u);
            asm volatile("s_waitcnt vmcnt(0)" ::: "memory");
        } else {
            XB_SPIN(xb_ld(&bar[XB_XGEN(b.x)]) == gen, bar);
            __builtin_amdgcn_fence(__ATOMIC_ACQUIRE, "agent");
            asm volatile("s_waitcnt vmcnt(0)" ::: "memory");
        }
    }
    __syncthreads();
}

__device__ __forceinline__ void tr_item(const float* W, int K, int Nsrc, int scol, bf16* WT, int drow, int kb, lds_t scr, int lane) {
    const int k0 = 64 * kb;
#pragma unroll 8
    for (int i = 0; i < 32; ++i) { const int kk = 2 * i + (lane >> 5); lds_st<float>(scr, (kk * 33 + (lane & 31)) * 4, W[(size_t)(k0 + kk) * Nsrc + scol + (lane & 31)]); }
    asm volatile("s_waitcnt lgkmcnt(0)" ::: "memory");
    const int c = lane & 7;
#pragma unroll
    for (int j = 0; j < 4; ++j) { const int n = (lane >> 3) + 8 * j; const int so = ((8 * c) * 33 + n) * 4;
        v4u o; o.x = cvtpk(lds_ld<float>(scr, so), lds_ld<float>(scr, so + 33 * 4)); o.y = cvtpk(lds_ld<float>(scr, so + 2 * 33 * 4), lds_ld<float>(scr, so + 3 * 33 * 4));
        o.z = cvtpk(lds_ld<float>(scr, so + 4 * 33 * 4), lds_ld<float>(scr, so + 5 * 33 * 4)); o.w = cvtpk(lds_ld<float>(scr, so + 6 * 33 * 4), lds_ld<float>(scr, so + 7 * 33 * 4));
        *(v4u*)(WT + (size_t)(drow + n) * K + k0 + 8 * c) = o; }
    asm volatile("s_waitcnt lgkmcnt(0)" ::: "memory");
}
__device__ __forceinline__ void tr_mat(const float* W, int K, int N, bf16* WT, int r, lds_t scr, int lane) { const int nblk = N / 32, kb = r / nblk, nb = r % nblk; tr_item(W, K, N, 32 * nb, WT, 32 * nb, kb, scr, lane); }

constexpr int I_WIN = 32 * 416, I_BG = 32 * 64, I_BF = 16 * 64, I_OUT = 32 * 64, I_G = 32 * 176, I_U = I_G, I_D = 88 * 64, I_PG = 32 * 64, I_PP = 4 * 64;
constexpr int I_REST = I_BG + I_BF + I_OUT + I_G + I_U + I_D + I_PG + I_PP;
__device__ __forceinline__ void rest_item(int r, const float* const* in, unsigned char* ws, lds_t scr, int lane) {
    if (r < I_BG) { tr_mat(in[7], 2048, 2048, (bf16*)(ws + WS_WBG), r, scr, lane); return; } r -= I_BG;
    if (r < I_BF) { tr_mat(in[8], 1024, 2048, (bf16*)(ws + WS_WBF), r, scr, lane); return; } r -= I_BF;
    if (r < I_OUT) { tr_mat(in[9], 2048, 2048, (bf16*)(ws + WS_WOUT), r, scr, lane); return; } r -= I_OUT;
    if (r < I_G) { tr_mat(in[12], 2048, FF, (bf16*)(ws + WS_WG), r, scr, lane); return; } r -= I_G;
    if (r < I_U) { tr_mat(in[13], 2048, FF, (bf16*)(ws + WS_WU), r, scr, lane); return; } r -= I_U;
    if (r < I_D) { tr_mat(in[16], FF, 2048, (bf16*)(ws + WS_WD), r, scr, lane); return; } r -= I_D;
    if (r < I_PG) { tr_mat(in[19], 2048, 2048, (bf16*)(ws + WS_WPG), r, scr, lane); return; } r -= I_PG;
    tr_mat(in[20], PLE, 2048, (bf16*)(ws + WS_WPP), r, scr, lane);
}
__device__ __forceinline__ void rest_queue(lds_t lds, volatile LAS unsigned* MISC, unsigned* ctl, const float* const* in, unsigned char* ws) {
    int tid = threadIdx.x; asm volatile("" : "+v"(tid));
    const int lane = tid & 63, wave = tid >> 6; lds_t scr = lds + wave * 16384;
    for (;;) {
        __syncthreads();
        if (tid == 0) MISC[17] = __hip_atomic_fetch_add(ctl + CW_QUEUE2, 1u, RLX_AGENT);
        __syncthreads();
        const int base = (int)MISC[17] * 32;
        if (base >= I_REST) break;
#pragma unroll 1
        for (int j = 0; j < 4; ++j) { const int r = base + j * 8 + wave; if (r < I_REST) rest_item(r, in, ws, scr, lane); }
    }
}
__device__ __forceinline__ void p0_prologue(lds_t lds, const float* const* in, unsigned char* ws, int G) {
    const int tid = threadIdx.x, lane = tid & 63, wave = tid >> 6;
    lds_t scr = lds + wave * 16384;
    const int gw = blockIdx.x * 8 + wave, NGW = G * 8;
    for (int it = gw; it < I_WIN; it += NGW) {
        const int kb = it / 416, nb = it % 416, drow = 32 * nb; const int scol = drow + (drow >= 6144 ? 16 : 0) + (drow >= 9216 ? 8 : 0);
        tr_item(in[2], 2048, N_IN, scol, (bf16*)(ws + WS_WIN), drow, kb, scr, lane);
    }
    const int gt = blockIdx.x * 512 + tid, NT = G * 512;
    { const float* win = in[2]; bf16* WT = (bf16*)(ws + WS_WIN);
      for (int i = gt; i < 256 * 256; i += NT) { const int j = i >> 8, kc = (i & 255) * 8; v4u o = (v4u){0u, 0u, 0u, 0u};
          if (j < 24) { const int sc = j < 16 ? 6144 + j : 9232 + (j - 16); float f[8];
#pragma unroll
              for (int e = 0; e < 8; ++e) f[e] = win[(size_t)(kc + e) * N_IN + sc];
              o.x = cvtpk(f[0], f[1]); o.y = cvtpk(f[2], f[3]); o.z = cvtpk(f[4], f[5]); o.w = cvtpk(f[6], f[7]); }
          *(v4u*)(WT + (size_t)(13312 + j) * 2048 + kc) = o; } }
    { const float* x = in[0]; bf16* XB = (bf16*)(ws + WS_XB);
      for (int i = gt; i < MTOK * DM / 8; i += NT) { const v4f a = *(const v4f*)(x + (size_t)i * 8), b = *(const v4f*)(x + (size_t)i * 8 + 4);
          v4u o; o.x = cvtpk(a[0], a[1]); o.y = cvtpk(a[2], a[3]); o.z = cvtpk(b[0], b[1]); o.w = cvtpk(b[2], b[3]); *(v4u*)(XB + (size_t)i * 8) = o; } }
    { const float* p = in[1]; bf16* PB = (bf16*)(ws + WS_PB);
      for (int i = gt; i < MTOK * PLE / 8; i += NT) { const v4f a = *(const v4f*)(p + (size_t)i * 8), b = *(const v4f*)(p + (size_t)i * 8 + 4);
          v4u o; o.x = cvtpk(a[0], a[1]); o.y = cvtpk(a[2], a[3]); o.z = cvtpk(b[0], b[1]); o.w = cvtpk(b[2], b[3]); *(v4u*)(PB + (size_t)i * 8) = o; } }
}

__device__ __forceinline__ float log_sigmoid_fast(float z) { return fminf(z, 0.f) - __logf(1.0f + __expf(-fabsf(z))); }
__device__ __forceinline__ void gla_prep_item(lds_t lds, int item, const unsigned char* ws, const float* wlr, const float* blr, int tid) {
    asm volatile("" : "+v"(tid));
    const bf16* GQ = (const bf16*)(ws + WS_GQ); const bf16* GK = (const bf16*)(ws + WS_GK); const bf16* GV = (const bf16*)(ws + WS_GV); const float* SM = (const float*)(ws + WS_SM);
    bf16* QT = (bf16*)(ws + WS_QT); bf16* KT = (bf16*)(ws + WS_KT); bf16* VT = (bf16*)(ws + WS_VT); bf16* ATT = (bf16*)(ws + WS_ATT); float* DEC = (float*)(ws + WS_DEC);
    const int c = item & 63, bh = item >> 6, h = bh & 3, b = bh >> 2;
    const size_t tok0 = (size_t)b * SEQ + 64 * c;
    constexpr int L_BC = 0, L_TOT = 65536, L_GLR = 67584, L_QS = 71680, L_KS = 105472, QROW = 528;
    const int lane = tid & 63, wid = tid >> 6, l15 = lane & 15, q4 = lane >> 4;
    const int k = tid & 255, half = tid >> 8;
    v4f glv = (v4f){0.f, 0.f, 0.f, 0.f};
    if (tid < 256) glv = *(const v4f*)(SM + (tok0 + (tid >> 2)) * 32 + (tid & 3) * 4);
    float w[16];
#pragma unroll
    for (int r = 0; r < 16; ++r) w[r] = wlr[r * 1024 + h * 256 + k];
    const float bias = blr[h * 256 + k];
    v4u qv[4], kv[4], vv[8];
#pragma unroll
    for (int i = 0; i < 4; ++i) { const int idx = tid + 512 * i, t = idx >> 5, kc = (idx & 31) * 8; qv[i] = *(const v4u*)(GQ + (tok0 + t) * 1024 + h * 256 + kc); kv[i] = *(const v4u*)(GK + (tok0 + t) * 1024 + h * 256 + kc); }
#pragma unroll
    for (int i = 0; i < 8; ++i) { const int idx = tid + 512 * i; vv[i] = *(const v4u*)(GV + (tok0 + (idx >> 6)) * 2048 + h * 512 + (idx & 63) * 8); }
    __syncthreads();
    if (tid < 256) lds_st<v4f>(lds, L_GLR + ((tid >> 2) * 16 + (tid & 3) * 4) * 4, glv);
    __syncthreads();
    float run = 0.f;
    for (int tt = 0; tt < 32; ++tt) { const int t = half * 32 + tt; float z = bias;
#pragma unroll
        for (int r4 = 0; r4 < 4; ++r4) { const v4f g = lds_ld<v4f>(lds, L_GLR + (t * 16 + r4 * 4) * 4); z += g[0] * w[4 * r4] + g[1] * w[4 * r4 + 1] + g[2] * w[4 * r4 + 2] + g[3] * w[4 * r4 + 3]; }
        run += log_sigmoid_fast(z) * 0.0625f;
        lds_st<float>(lds, L_BC + (t * 256 + k) * 4, run); }
    lds_st<float>(lds, L_TOT + (half * 256 + k) * 4, run);
    __syncthreads();
    if (tid < 256) DEC[(size_t)item * 256 + tid] = __expf(lds_ld<float>(lds, L_TOT + tid * 4) + lds_ld<float>(lds, L_TOT + (256 + tid) * 4));
#pragma unroll
    for (int i = 0; i < 4; ++i) { const int idx = tid + 512 * i, t = idx >> 5, kc = (idx & 31) * 8;
        v4f b0 = lds_ld<v4f>(lds, L_BC + (t * 256 + kc) * 4), b1 = lds_ld<v4f>(lds, L_BC + (t * 256 + kc + 4) * 4);
        if (t >= 32) { b0 += lds_ld<v4f>(lds, L_TOT + kc * 4); b1 += lds_ld<v4f>(lds, L_TOT + (kc + 4) * 4); }
        float qq[8], kk[8], bc[8];
#pragma unroll
        for (int j = 0; j < 4; ++j) { qq[2 * j] = bf_lo(qv[i][j]); qq[2 * j + 1] = bf_hi(qv[i][j]); kk[2 * j] = bf_lo(kv[i][j]); kk[2 * j + 1] = bf_hi(kv[i][j]); bc[j] = b0[j]; bc[4 + j] = b1[j]; }
#pragma unroll
        for (int j = 0; j < 8; ++j) { qq[j] = qq[j] * __expf(bc[j]) * 0.0625f; kk[j] = kk[j] * __expf(-bc[j]); }
        v4u qp, kp; qp.x = cvtpk(qq[0], qq[1]); qp.y = cvtpk(qq[2], qq[3]); qp.z = cvtpk(qq[4], qq[5]); qp.w = cvtpk(qq[6], qq[7]);
        kp.x = cvtpk(kk[0], kk[1]); kp.y = cvtpk(kk[2], kk[3]); kp.z = cvtpk(kk[4], kk[5]); kp.w = cvtpk(kk[6], kk[7]);
        *(v4u*)(QT + (size_t)item * 16384 + t * 256 + kc) = qp;
        lds_st<v4u>(lds, L_QS + t * QROW + kc * 2, qp); lds_st<v4u>(lds, L_KS + t * QROW + kc * 2, kp); }
    __syncthreads();
#pragma unroll
    for (int i = 0; i < 4; ++i) { const int idx = tid + 512 * i, kk = idx >> 3, sc = (idx & 7) * 8; unsigned e[8];
#pragma unroll
        for (int j = 0; j < 8; ++j) e[j] = lds_ld<unsigned short>(lds, L_KS + (sc + j) * QROW + kk * 2);
        v4u o; o.x = e[0] | (e[1] << 16); o.y = e[2] | (e[3] << 16); o.z = e[4] | (e[5] << 16); o.w = e[6] | (e[7] << 16);
        *(v4u*)(KT + (size_t)item * 16384 + kk * 64 + sc) = o; }
    { const int mt = wid >> 1;
#pragma unroll
      for (int nn = 0; nn < 2; ++nn) { const int nt = (wid & 1) * 2 + nn; v4f acc = (v4f){0.f, 0.f, 0.f, 0.f};
          if (nt <= mt) {
#pragma unroll
              for (int ks = 0; ks < 8; ++ks) { const v8s a = lds_ld<v8s>(lds, L_QS + (16 * mt + l15) * QROW + (32 * ks + 8 * q4) * 2), bb = lds_ld<v8s>(lds, L_KS + (16 * nt + l15) * QROW + (32 * ks + 8 * q4) * 2); acc = MFMA16(a, bb, acc); } }
#pragma unroll
          for (int r = 0; r < 4; ++r) { const int t = 16 * mt + 4 * q4 + r, s2 = 16 * nt + l15; const float v = (s2 <= t) ? acc[r] : 0.f; ATT[(size_t)item * 4096 + t * 64 + s2] = (bf16)(cvtpk(v, 0.f) & 0xffffu); } } }
    __syncthreads();
#pragma unroll
    for (int i = 0; i < 8; ++i) { const int idx = tid + 512 * i, s2 = idx >> 6, vc = (idx & 63) * 8;
#pragma unroll
        for (int j = 0; j < 4; ++j) { lds_st<unsigned short>(lds, (vc + 2 * j) * 132 + s2 * 2, (unsigned short)(vv[i][j] & 0xffffu)); lds_st<unsigned short>(lds, (vc + 2 * j + 1) * 132 + s2 * 2, (unsigned short)(vv[i][j] >> 16)); } }
    __syncthreads();
#pragma unroll
    for (int i = 0; i < 8; ++i) { const int idx = tid + 512 * i, v = idx >> 3, c8 = idx & 7; v4u o;
        o.x = lds_ld<unsigned>(lds, v * 132 + c8 * 16); o.y = lds_ld<unsigned>(lds, v * 132 + c8 * 16 + 4); o.z = lds_ld<unsigned>(lds, v * 132 + c8 * 16 + 8); o.w = lds_ld<unsigned>(lds, v * 132 + c8 * 16 + 12);
        *(v4u*)(VT + (size_t)item * 32768 + v * 64 + c8 * 8) = o; }
}
__device__ __forceinline__ void fv_tr_item(lds_t lds, int item, const unsigned char* ws, int tid) {
    asm volatile("" : "+v"(tid));
    const bf16* FV = (const bf16*)(ws + WS_FV); bf16* FVT = (bf16*)(ws + WS_FVT);
    const int bh = item >> 4, tt = item & 15, b = bh >> 3, h = bh & 7;
    v4u vv[8];
#pragma unroll
    for (int i = 0; i < 8; ++i) { const int idx = tid + 512 * i; vv[i] = *(const v4u*)(FV + ((size_t)b * SEQ + 256 * tt + (idx >> 4)) * 1024 + h * 128 + (idx & 15) * 8); }
    __syncthreads();
#pragma unroll
    for (int i = 0; i < 8; ++i) { const int idx = tid + 512 * i, s = idx >> 4, dc = (idx & 15) * 8;
#pragma unroll
        for (int j = 0; j < 4; ++j) { lds_st<unsigned short>(lds, (dc + 2 * j) * 516 + s * 2, (unsigned short)(vv[i][j] & 0xffffu)); lds_st<unsigned short>(lds, (dc + 2 * j + 1) * 516 + s * 2, (unsigned short)(vv[i][j] >> 16)); } }
    __syncthreads();
#pragma unroll
    for (int i = 0; i < 8; ++i) { const int idx = tid + 512 * i, d = idx >> 5, c8 = idx & 31; v4u o;
        o.x = lds_ld<unsigned>(lds, d * 516 + c8 * 16); o.y = lds_ld<unsigned>(lds, d * 516 + c8 * 16 + 4); o.z = lds_ld<unsigned>(lds, d * 516 + c8 * 16 + 8); o.w = lds_ld<unsigned>(lds, d * 516 + c8 * 16 + 12);
        *(v4u*)(FVT + ((size_t)bh * 128 + d) * SEQ + 256 * tt + c8 * 8) = o; }
}
__device__ __forceinline__ void fox_cumsum_item(lds_t lds, int bh, const unsigned char* ws, const float* bfg, int tid) {
    asm volatile("" : "+v"(tid));
    const float* SM = (const float*)(ws + WS_SM); float* CB = (float*)(ws + WS_CB);
    const int b = bh >> 3, h = bh & 7, lane = tid & 63, wid = tid >> 6; const float bf = bfg[h];
    __syncthreads();
    float v[8]; float run = 0.f;
#pragma unroll
    for (int j = 0; j < 8; ++j) { const float z = SM[((size_t)b * SEQ + tid * 8 + j) * 32 + 16 + h] + bf; run += log_sigmoid_fast(z); v[j] = run; }
    float inc = run;
#pragma unroll
    for (int o = 1; o < 64; o <<= 1) { const float n = __shfl_up(inc, o); if (lane >= o) inc += n; }
    if (lane == 63) lds_st<float>(lds, wid * 4, inc);
    __syncthreads();
    float pre = inc - run;
    for (int w2 = 0; w2 < wid; ++w2) pre += lds_ld<float>(lds, w2 * 4);
#pragma unroll
    for (int j = 0; j < 8; ++j) CB[(size_t)bh * SEQ + tid * 8 + j] = -LOG2E * (pre + v[j]);
}

constexpr int NSEG = 8, SEGC = 64 / NSEG;
__device__ __forceinline__ void gla_scan_item(lds_t lds, int item, const unsigned char* ws, int tid) {
    asm volatile("" : "+v"(tid));
    const bf16* QT = (const bf16*)(ws + WS_QT); const bf16* KT = (const bf16*)(ws + WS_KT); const bf16* VT = (const bf16*)(ws + WS_VT); const bf16* ATT = (const bf16*)(ws + WS_ATT); const float* DEC = (const float*)(ws + WS_DEC);
    float* ORAW = (float*)(ws + WS_ORAW); bf16* LSEG = (bf16*)(ws + WS_LSEG); float* PDEC = (float*)(ws + WS_PDEC); float* DSEG = (float*)(ws + WS_DSEG);
    float prun = 1.f;
    const int seg = item & (NSEG - 1), i32 = item / NSEG, vq = i32 & 3, bh4 = i32 >> 2, h = bh4 & 3, b = bh4 >> 2;
    const int lane = tid & 63, wid = tid >> 6, l15 = lane & 15, q4 = lane >> 4;
    constexpr int QROW = 528, KROW = 144, L_Q = 0, L_K = 33792, L_A = 33792 + 36864, L_D = L_A + 9216;
    const int vcol = 128 * vq + 16 * wid + l15;
    v4f S[16];
#pragma unroll
    for (int i = 0; i < 16; ++i) S[i] = (v4f){0.f, 0.f, 0.f, 0.f};
    v4u pq[4], pk[4], pa, pvf[2]; v4f pd;
#define GS_PREFETCH(cc) do { const size_t it_ = (size_t)bh4 * 64 + (cc); \
        _Pragma("unroll") for (int i = 0; i < 4; ++i) { const int idx = tid + 512 * i; pq[i] = *(const v4u*)(QT + it_ * 16384 + idx * 8); } \
        pa = *(const v4u*)(ATT + it_ * 4096 + tid * 8); \
        _Pragma("unroll") for (int kk = 0; kk < 2; ++kk) pvf[kk] = *(const v4u*)(VT + (it_ * 512 + vcol) * 64 + 32 * kk + 8 * q4); } while (0)
#define GS_PREFETCH2(cc) do { const size_t it_ = (size_t)bh4 * 64 + (cc); \
        _Pragma("unroll") for (int i = 0; i < 4; ++i) { const int idx = tid + 512 * i; pk[i] = *(const v4u*)(KT + it_ * 16384 + idx * 8); } \
        if (tid < 64) pd = *(const v4f*)(DEC + it_ * 256 + tid * 4); } while (0)
    GS_PREFETCH(seg * SEGC); GS_PREFETCH2(seg * SEGC);
    for (int c = seg * SEGC; c < (seg + 1) * SEGC; ++c) {
        __syncthreads();
#pragma unroll
        for (int i = 0; i < 4; ++i) { const int idx = tid + 512 * i; lds_st<v4u>(lds, L_Q + (idx >> 5) * QROW + (idx & 31) * 16, pq[i]); lds_st<v4u>(lds, L_K + (idx >> 3) * KROW + (idx & 7) * 16, pk[i]); }
        lds_st<v4u>(lds, L_A + (tid >> 3) * KROW + (tid & 7) * 16, pa);
        if (tid < 64) lds_st<v4f>(lds, L_D + tid * 16, pd);
        v8s vf[2]; vf[0] = __builtin_bit_cast(v8s, pvf[0]); vf[1] = __builtin_bit_cast(v8s, pvf[1]);
        __syncthreads();
        if (c + 1 < (seg + 1) * SEGC) GS_PREFETCH(c + 1);
        v4f o[4];
#pragma unroll
        for (int mt = 0; mt < 4; ++mt) o[mt] = (v4f){0.f, 0.f, 0.f, 0.f};
#pragma unroll
        for (int ks = 0; ks < 8; ++ks) {
            v4u bw; bw.x = cvtpk(S[2 * ks][0], S[2 * ks][1]); bw.y = cvtpk(S[2 * ks][2], S[2 * ks][3]); bw.z = cvtpk(S[2 * ks + 1][0], S[2 * ks + 1][1]); bw.w = cvtpk(S[2 * ks + 1][2], S[2 * ks + 1][3]);
            const v8s bfr = __builtin_bit_cast(v8s, bw);
#pragma unroll
            for (int mt = 0; mt < 4; ++mt) { const v2u lo = lds_ld<v2u>(lds, L_Q + (16 * mt + l15) * QROW + (32 * ks + 4 * q4) * 2), hi = lds_ld<v2u>(lds, L_Q + (16 * mt + l15) * QROW + (32 * ks + 16 + 4 * q4) * 2);
                const v4u aw = (v4u){lo.x, lo.y, hi.x, hi.y}; o[mt] = MFMA16(__builtin_bit_cast(v8s, aw), bfr, o[mt]); }
        }
#pragma unroll
        for (int kk = 0; kk < 2; ++kk)
#pragma unroll
            for (int mt = 0; mt < 4; ++mt) { const v8s a = lds_ld<v8s>(lds, L_A + (16 * mt + l15) * KROW + (32 * kk + 8 * q4) * 2); o[mt] = MFMA16(a, vf[kk], o[mt]); }
        { float* op = ORAW + ((size_t)b * SEQ + 64 * c) * 2048 + h * 512 + vcol;
#pragma unroll
          for (int mt = 0; mt < 4; ++mt)
#pragma unroll
              for (int r = 0; r < 4; ++r) op[(size_t)(16 * mt + 4 * q4 + r) * 2048] = o[mt][r]; }
        if (vq == 0 && tid < 256) { PDEC[((size_t)bh4 * 64 + c) * 256 + tid] = prun; prun *= lds_ld<float>(lds, L_D + tid * 4); }
        __builtin_amdgcn_sched_barrier(0);
        if (c + 1 < (seg + 1) * SEGC) GS_PREFETCH2(c + 1);
        __builtin_amdgcn_sched_barrier(0);
#pragma unroll
        for (int kt = 0; kt < 16; ++kt) { v4f acc = S[kt];
#pragma unroll
            for (int kk = 0; kk < 2; ++kk) { const v8s a = lds_ld<v8s>(lds, L_K + (16 * kt + l15) * KROW + (32 * kk + 8 * q4) * 2); acc = MFMA16(a, vf[kk], acc); }
            const v4f dc = lds_ld<v4f>(lds, L_D + (16 * kt + 4 * q4) * 4); S[kt] = acc * dc; }
    }
#undef GS_PREFETCH
#undef GS_PREFETCH2
    if (vq == 0 && tid < 256) DSEG[((size_t)bh4 * NSEG + seg) * 256 + tid] = prun;
    if (seg < NSEG - 1) { bf16* lp = LSEG + ((size_t)(i32 * NSEG + seg) * 128 + 16 * wid + l15) * 256 + 4 * q4;
#pragma unroll
        for (int kt = 0; kt < 16; ++kt) *(v2u*)(lp + 16 * kt) = (v2u){cvtpk(S[kt][0], S[kt][1]), cvtpk(S[kt][2], S[kt][3])}; }
}

__device__ __forceinline__ void gla_fix_item(lds_t lds, int item, const unsigned char* ws, int tid) {
    asm volatile("" : "+v"(tid));
    const bf16* QT = (const bf16*)(ws + WS_QT); const bf16* LSEG = (const bf16*)(ws + WS_LSEG); float* ORAW = (float*)(ws + WS_ORAW); const float* PDEC = (const float*)(ws + WS_PDEC); const float* DSEG = (const float*)(ws + WS_DSEG);
    const int seg = item & (NSEG - 1), i32 = item / NSEG, vq = i32 & 3, bh4 = i32 >> 2, h = bh4 & 3, b = bh4 >> 2;
    const int lane = tid & 63, wid = tid >> 6, l15 = lane & 15, q4 = lane >> 4;
    constexpr int QROW = 528, L_Q = 0;
    const int vcol = 128 * vq + 16 * wid + l15;
    float a[8][8];
#pragma unroll
    for (int ks = 0; ks < 8; ++ks)
#pragma unroll
        for (int j = 0; j < 8; ++j) a[ks][j] = 0.f;
    for (int s2 = 0; s2 < seg; ++s2) {
        const bf16* lp = LSEG + ((size_t)(i32 * NSEG + s2) * 128 + 16 * wid + l15) * 256 + 8 * q4; const float* dp = DSEG + ((size_t)bh4 * NSEG + s2) * 256 + 8 * q4;
#pragma unroll
        for (int ks = 0; ks < 8; ++ks) { const v4u lw = *(const v4u*)(lp + 32 * ks); const v4f d0 = *(const v4f*)(dp + 32 * ks), d1 = *(const v4f*)(dp + 32 * ks + 4);
            a[ks][0] = a[ks][0] * d0[0] + bf_lo(lw.x); a[ks][1] = a[ks][1] * d0[1] + bf_hi(lw.x); a[ks][2] = a[ks][2] * d0[2] + bf_lo(lw.y); a[ks][3] = a[ks][3] * d0[3] + bf_hi(lw.y);
            a[ks][4] = a[ks][4] * d1[0] + bf_lo(lw.z); a[ks][5] = a[ks][5] * d1[1] + bf_hi(lw.z); a[ks][6] = a[ks][6] * d1[2] + bf_lo(lw.w); a[ks][7] = a[ks][7] * d1[3] + bf_hi(lw.w); }
    }
    v8s bfr[8];
#pragma unroll
    for (int ks = 0; ks < 8; ++ks) { v4u w; w.x = cvtpk(a[ks][0], a[ks][1]); w.y = cvtpk(a[ks][2], a[ks][3]); w.z = cvtpk(a[ks][4], a[ks][5]); w.w = cvtpk(a[ks][6], a[ks][7]); bfr[ks] = __builtin_bit_cast(v8s, w); }
    v4u pq[4]; v4f pp[4][2];
#define GF_PREFETCH(cc) do { const size_t it_ = (size_t)bh4 * 64 + (cc); \
        _Pragma("unroll") for (int i = 0; i < 4; ++i) { const int idx = tid + 512 * i; pq[i] = *(const v4u*)(QT + it_ * 16384 + idx * 8); \
            pp[i][0] = *(const v4f*)(PDEC + it_ * 256 + (idx & 31) * 8); pp[i][1] = *(const v4f*)(PDEC + it_ * 256 + (idx & 31) * 8 + 4); } } while (0)
    GF_PREFETCH(seg * SEGC);
    for (int ci = 0; ci < SEGC; ++ci) { const int c = seg * SEGC + ci;
        __syncthreads();
#pragma unroll
        for (int i = 0; i < 4; ++i) { const int idx = tid + 512 * i, t = idx >> 5, kc = (idx & 31) * 8; const v4f p0 = pp[i][0], p1 = pp[i][1];
            v4u w; w.x = cvtpk(bf_lo(pq[i].x) * p0[0], bf_hi(pq[i].x) * p0[1]); w.y = cvtpk(bf_lo(pq[i].y) * p0[2], bf_hi(pq[i].y) * p0[3]);
            w.z = cvtpk(bf_lo(pq[i].z) * p1[0], bf_hi(pq[i].z) * p1[1]); w.w = cvtpk(bf_lo(pq[i].w) * p1[2], bf_hi(pq[i].w) * p1[3]);
            lds_st<v4u>(lds, L_Q + t * QROW + kc * 2, w); }
        __syncthreads();
        if (ci + 1 < SEGC) GF_PREFETCH(c + 1);
        float* op = ORAW + ((size_t)b * SEQ + 64 * c) * 2048 + h * 512 + vcol;
        v4f o[4];
#pragma unroll
        for (int mt = 0; mt < 4; ++mt)
#pragma unroll
            for (int r = 0; r < 4; ++r) o[mt][r] = op[(size_t)(16 * mt + 4 * q4 + r) * 2048];
#pragma unroll
        for (int ks = 0; ks < 8; ++ks)
#pragma unroll
            for (int mt = 0; mt < 4; ++mt) { const v8s aa = lds_ld<v8s>(lds, L_Q + (16 * mt + l15) * QROW + (32 * ks + 8 * q4) * 2); o[mt] = MFMA16(aa, bfr[ks], o[mt]); }
#pragma unroll
        for (int mt = 0; mt < 4; ++mt)
#pragma unroll
            for (int r = 0; r < 4; ++r) op[(size_t)(16 * mt + 4 * q4 + r) * 2048] = o[mt][r];
    }
#undef GF_PREFETCH
}

__device__ __forceinline__ void fox_unit(lds_t lds, int bh, int qi, const unsigned char* ws, int tid) {
    asm volatile("" : "+v"(tid));
    const bf16* FQ = (const bf16*)(ws + WS_FQ); const bf16* FK = (const bf16*)(ws + WS_FK); const bf16* FVT = (const bf16*)(ws + WS_FVT); const float* CB = (const float*)(ws + WS_CB); bf16* OF = (bf16*)(ws + WS_OF);
    const int lane = tid & 63, wid = tid >> 6, r32 = lane & 31, hi = lane >> 5, rg = wid & 3, par = wid >> 2;
    const int b = bh >> 3, h = bh & 7; const size_t rowbase = (size_t)b * SEQ; const int q0 = qi * 128;
    constexpr int KROW = 272, VROW = 136, TILEB = 17408, L_V0 = 2 * TILEB;
    const size_t qrow = rowbase + q0 + 32 * rg + r32;
    constexpr int L_QF = 4 * TILEB;
#pragma unroll
    for (int i = 0; i < 4; ++i) { const int idx = tid + 512 * i; lds_st<v4u>(lds, L_QF + (idx >> 4) * KROW + (idx & 15) * 16, *(const v4u*)(FQ + (rowbase + q0 + (idx >> 4)) * 1024 + h * 128 + (idx & 15) * 8)); }
    const int qb = L_QF + (32 * rg + r32) * KROW + 16 * hi;
    v16f o[4];
#pragma unroll
    for (int d = 0; d < 4; ++d)
#pragma unroll
        for (int r = 0; r < 16; ++r) o[d][r] = 0.f;
    const float NEG = -__builtin_inff();
    float m = NEG, l = 0.f;
    const int niter = qi + 1;
    v4u pk[4], pv[4]; v4f pb;
    constexpr int L_CB = L_QF + 128 * KROW;
#define FX_PREFETCH(it) do { if (tid < 32) pb = *(const v4f*)(CB + (size_t)bh * SEQ + (size_t)(it) * 128 + tid * 4); \
        _Pragma("unroll") for (int i = 0; i < 4; ++i) { const int idx = tid + 512 * i, tile = idx >> 10; \
            pk[i] = *(const v4u*)(FK + (rowbase + (size_t)(2 * (it) + tile) * 64 + ((idx >> 4) & 63)) * 1024 + h * 128 + (idx & 15) * 8); \
            pv[i] = *(const v4u*)(FVT + ((size_t)bh * 128 + ((idx >> 3) & 127)) * SEQ + (2 * (it) + tile) * 64 + (idx & 7) * 8); } } while (0)
    FX_PREFETCH(0);
    for (int it = 0; it < niter; ++it) {
        __syncthreads();
#pragma unroll
        for (int i = 0; i < 4; ++i) { const int idx = tid + 512 * i, tile = idx >> 10;
            lds_st<v4u>(lds, tile * TILEB + ((idx >> 4) & 63) * KROW + (idx & 15) * 16, pk[i]);
            const int vo = L_V0 + tile * TILEB + ((idx >> 3) & 127) * VROW + (idx & 7) * 16;
            lds_st<v2u>(lds, vo, (v2u){pv[i].x, pv[i].y}); lds_st<v2u>(lds, vo + 8, (v2u){pv[i].z, pv[i].w}); }
        if (tid < 32) lds_st<v4f>(lds, L_CB + tid * 16, pb);
        __syncthreads();
        if (it + 1 < niter) FX_PREFETCH(it + 1);
        const int ks0 = (2 * it + par) * 64;
        if (ks0 <= q0 + 32 * rg) {
            v16f s0, s1;
#pragma unroll
            for (int r = 0; r < 16; ++r) { s0[r] = 0.f; s1[r] = 0.f; }
            const int kb = par * TILEB + r32 * KROW + 16 * hi;
            { v8s qv[8];
#pragma unroll
              for (int s = 0; s < 8; ++s) qv[s] = lds_ld<v8s>(lds, qb + 32 * s);
              v8s a0 = lds_ld<v8s>(lds, kb), a1 = lds_ld<v8s>(lds, kb + 32 * KROW);
#pragma unroll
              for (int s = 0; s < 8; ++s) { v8s n0 = a0, n1 = a1;
                  if (s < 7) { n0 = lds_ld<v8s>(lds, kb + 32 * (s + 1)); n1 = lds_ld<v8s>(lds, kb + 32 * KROW + 32 * (s + 1)); }
                  __builtin_amdgcn_sched_barrier(0);
                  s0 = MFMA32(a0, qv[s], s0); s1 = MFMA32(a1, qv[s], s1);
                  __builtin_amdgcn_sched_barrier(0);
                  a0 = n0; a1 = n1; } }
#pragma unroll
            for (int g = 0; g < 4; ++g) { const v4f b0 = lds_ld<v4f>(lds, L_CB + (par * 64 + 8 * g + 4 * hi) * 4), b1 = lds_ld<v4f>(lds, L_CB + (par * 64 + 32 + 8 * g + 4 * hi) * 4);
#pragma unroll
                for (int j = 0; j < 4; ++j) { s0[4 * g + j] += b0[j]; s1[4 * g + j] += b1[j]; } }
            if (ks0 + 63 > q0 + 32 * rg) { const int qabs = q0 + 32 * rg + r32;
#pragma unroll
                for (int r = 0; r < 16; ++r) { const int kv = ks0 + (r & 3) + 8 * (r >> 2) + 4 * hi; if (kv > qabs) s0[r] = NEG; if (kv + 32 > qabs) s1[r] = NEG; } }
            float rm = fmaxf(s0[0], s1[0]);
#pragma unroll
            for (int r = 1; r < 16; ++r) rm = fmaxf(rm, fmaxf(s0[r], s1[r]));
            rm = fmaxf(rm, __shfl_xor(rm, 32));
            const float mn = fmaxf(m, rm), alpha = __builtin_amdgcn_exp2f(m - mn); m = mn;
            float ps = 0.f;
#pragma unroll
            for (int r = 0; r < 16; ++r) { s0[r] = __builtin_amdgcn_exp2f(s0[r] - mn); s1[r] = __builtin_amdgcn_exp2f(s1[r] - mn); ps += s0[r] + s1[r]; }
            l = l * alpha + ps;
#pragma unroll
            for (int d = 0; d < 4; ++d)
#pragma unroll
                for (int r = 0; r < 16; ++r) o[d][r] *= alpha;
            v8s pf[4];
            { v4u w;
              w.x = cvtpk(s0[0], s0[1]); w.y = cvtpk(s0[2], s0[3]); w.z = cvtpk(s0[4], s0[5]); w.w = cvtpk(s0[6], s0[7]); pf[0] = __builtin_bit_cast(v8s, w);
              w.x = cvtpk(s0[8], s0[9]); w.y = cvtpk(s0[10], s0[11]); w.z = cvtpk(s0[12], s0[13]); w.w = cvtpk(s0[14], s0[15]); pf[1] = __builtin_bit_cast(v8s, w);
              w.x = cvtpk(s1[0], s1[1]); w.y = cvtpk(s1[2], s1[3]); w.z = cvtpk(s1[4], s1[5]); w.w = cvtpk(s1[6], s1[7]); pf[2] = __builtin_bit_cast(v8s, w);
              w.x = cvtpk(s1[8], s1[9]); w.y = cvtpk(s1[10], s1[11]); w.z = cvtpk(s1[12], s1[13]); w.w = cvtpk(s1[14], s1[15]); pf[3] = __builtin_bit_cast(v8s, w); }
            const int vb = L_V0 + par * TILEB + r32 * VROW + 8 * hi;
#define FX_VLD(i) ({ const int d_ = (i) & 3, kk_ = (i) >> 2; const v2u lo_ = lds_ld<v2u>(lds, vb + 32 * d_ * VROW + 32 * kk_), hh_ = lds_ld<v2u>(lds, vb + 32 * d_ * VROW + 32 * kk_ + 16); (v4u){lo_.x, lo_.y, hh_.x, hh_.y}; })
            { v4u f0 = FX_VLD(0), f1 = FX_VLD(1), f2 = FX_VLD(2);
#pragma unroll
              for (int i = 0; i < 16; ++i) { v4u f3 = f0;
                  if (i + 3 < 16) f3 = FX_VLD(i + 3);
                  __builtin_amdgcn_sched_barrier(0);
                  o[i & 3] = MFMA32(__builtin_bit_cast(v8s, f0), pf[i >> 2], o[i & 3]);
                  __builtin_amdgcn_sched_barrier(0);
                  f0 = f1; f1 = f2; f2 = f3; } }
#undef FX_VLD
        }
    }
#undef FX_PREFETCH
    l += __shfl_xor(l, 32);
    __syncthreads();
    constexpr int L_ML = 65536;
    if (par == 1) {
#pragma unroll
        for (int d = 0; d < 4; ++d)
#pragma unroll
            for (int r = 0; r < 16; ++r) lds_st<float>(lds, ((rg * 64 + d * 16 + r) * 64 + lane) * 4, o[d][r]);
        lds_st<float>(lds, L_ML + (rg * 128 + lane) * 4, m); lds_st<float>(lds, L_ML + (rg * 128 + 64 + lane) * 4, l);
    }
    __syncthreads();
    if (par == 0) {
        const float m1 = lds_ld<float>(lds, L_ML + (rg * 128 + lane) * 4), l1 = lds_ld<float>(lds, L_ML + (rg * 128 + 64 + lane) * 4);
        const float mt = fmaxf(m, m1), a0 = __builtin_amdgcn_exp2f(m - mt), a1 = __builtin_amdgcn_exp2f(m1 - mt);
        const float inv = 1.0f / (l * a0 + l1 * a1);
        bf16* op = OF + qrow * 1024 + h * 128 + 4 * hi;
#pragma unroll
        for (int d = 0; d < 4; ++d)
#pragma unroll
            for (int g = 0; g < 4; ++g) { float v[4];
#pragma unroll
                for (int j = 0; j < 4; ++j) v[j] = (o[d][4 * g + j] * a0 + lds_ld<float>(lds, ((rg * 64 + d * 16 + 4 * g + j) * 64 + lane) * 4) * a1) * inv;
                *(v2u*)(op + 32 * d + 8 * g) = (v2u){cvtpk(v[0], v[1]), cvtpk(v[2], v[3])}; }
    }
}

__device__ __forceinline__ void gla_norm_pass(unsigned char* ws, const float* gng, int G) {
    const float* ORAW = (const float*)(ws + WS_ORAW); bf16* GR = (bf16*)(ws + WS_GR);
    const int lane = threadIdx.x & 63; const int gw = blockIdx.x * 8 + (threadIdx.x >> 6), NGW = G * 8;
    for (int it = gw; it < MTOK * 4; it += NGW) {
        const size_t off = (size_t)it * 512 + lane * 8;
        const v4f a = *(const v4f*)(ORAW + off), b = *(const v4f*)(ORAW + off + 4);
        float ss = (a[0] * a[0] + a[1] * a[1]) + (a[2] * a[2] + a[3] * a[3]) + (b[0] * b[0] + b[1] * b[1]) + (b[2] * b[2] + b[3] * b[3]);
        ss = wave_sum(ss);
        const float rstd = 1.0f / sqrtf(ss * (1.0f / 512.0f) + RMS_EPS);
        const v4u gw4 = *(const v4u*)(GR + off); const v4f g0 = *(const v4f*)(gng + lane * 8), g1 = *(const v4f*)(gng + lane * 8 + 4);
        float gr[8];
#pragma unroll
        for (int j = 0; j < 4; ++j) { gr[2 * j] = bf_lo(gw4[j]); gr[2 * j + 1] = bf_hi(gw4[j]); }
        float r[8];
#pragma unroll
        for (int j = 0; j < 4; ++j) { r[j] = a[j] * rstd * g0[j] * (gr[j] * pg8::fsigmoid(gr[j])); r[4 + j] = b[j] * rstd * g1[j] * (gr[4 + j] * pg8::fsigmoid(gr[4 + j])); }
        v4u o; o.x = cvtpk(r[0], r[1]); o.y = cvtpk(r[2], r[3]); o.z = cvtpk(r[4], r[5]); o.w = cvtpk(r[6], r[7]);
        *(v4u*)(GR + off) = o;
    }
}
__device__ __forceinline__ void ln_pass(const float* src, float* dst, bf16* dstb, const float* g, const float* bta, int G) {
    const int lane = threadIdx.x & 63; const int gw = blockIdx.x * 8 + (threadIdx.x >> 6), NGW = G * 8;
    for (int row = gw; row < MTOK; row += NGW) {
        const float* xr = src + (size_t)row * DM + lane * 4;
        v4f v[8]; float s = 0.f;
#pragma unroll
        for (int j = 0; j < 8; ++j) { v[j] = *(const v4f*)(xr + 256 * j); s += (v[j][0] + v[j][1]) + (v[j][2] + v[j][3]); }
        const float mean = wave_sum(s) * (1.0f / DM); float s2 = 0.f;
#pragma unroll
        for (int j = 0; j < 8; ++j) { v[j] = v[j] - mean; s2 += (v[j][0] * v[j][0] + v[j][1] * v[j][1]) + (v[j][2] * v[j][2] + v[j][3] * v[j][3]); }
        const float rstd = 1.0f / sqrtf(wave_sum(s2) * (1.0f / DM) + LN_EPS);
#pragma unroll
        for (int j = 0; j < 8; ++j) { const v4f gg = *(const v4f*)(g + lane * 4 + 256 * j), bb = *(const v4f*)(bta + lane * 4 + 256 * j); const v4f y = v[j] * rstd * gg + bb;
            *(v4f*)(dst + (size_t)row * DM + lane * 4 + 256 * j) = y;
            *(v2u*)(dstb + (size_t)row * DM + lane * 4 + 256 * j) = (v2u){cvtpk(y[0], y[1]), cvtpk(y[2], y[3])}; }
    }
}

#ifndef PH
#define PH 0xFFFF
#endif
#ifndef PROBE
#define PROBE 0
#endif
struct Args { const float* in[21]; float* out; unsigned char* ws; };
__global__ void __launch_bounds__(512, 2) mega_fwd(Args args) {
    extern __shared__ __attribute__((aligned(16))) unsigned char lds_raw[];
    lds_t lds = (lds_t)lds_raw;
    volatile LAS unsigned* MISC = (volatile LAS unsigned*)(lds + MISC_OFF);
    const int tid = threadIdx.x, G = gridDim.x;
    unsigned char* ws = args.ws;
    unsigned* ctl = (unsigned*)(ws + WS_CTL);
    if (tid < 64) MISC[tid] = 0u;
    __syncthreads();
    XcdBarrier bar = xcd_barrier_post(ctl + CW_BAR, MISC + 8);
#if PROBE
    int nstamp = 0;
#define STAMP() do { if (blockIdx.x == 0 && tid == 0) MISC[32 + nstamp] = (unsigned)__builtin_amdgcn_s_memrealtime(); ++nstamp; } while (0)
#else
#define STAMP() do { } while (0)
#endif
#define GRID_BAR() do { xcd_barrier(bar); STAMP(); } while (0)
    STAMP();

    if (PH & 1) p0_prologue(lds, args.in, ws, G);
    cg::this_grid().sync();
    STAMP();

    if (PH & 2) { pg8::Gemm g{(const pg8::bf16_t*)(ws + WS_XB), (const pg8::bf16_t*)(ws + WS_WIN), MTOK, NPAD, DM}; pg8::StaticOrder S; S.init(MTOK, NPAD, G, (int)blockIdx.x);
      pg8::EpiProj E{ws, 0.08838834764831845f * LOG2E};
      pg8::gemm_phase<pg8::EpiProj, pg8::StaticOrder, true, true>(lds, g, S, E); }
    if (PH & 1) rest_queue(lds, MISC, ctl, args.in, ws);
    GRID_BAR();

    if (PH & 4) for (int it = blockIdx.x; it < 512 + 256 + 16; it += G) {
        if (it < 512) gla_prep_item(lds, it, ws, args.in[3], args.in[4], tid);
        else if (it < 768) fv_tr_item(lds, it - 512, ws, tid);
        else fox_cumsum_item(lds, it - 768, ws, args.in[6], tid);
    }
    GRID_BAR();

    if (PH & 8) for (int it = blockIdx.x; it < 32 * NSEG; it += G) gla_scan_item(lds, it, ws, tid);
#if PROBE
    if (blockIdx.x == 0 && tid == 0) MISC[31] = (unsigned)__builtin_amdgcn_s_memrealtime();
#endif
    if (PH & 16) for (;;) {
        __syncthreads();
        if (tid == 0) MISC[16] = __hip_atomic_fetch_add(ctl + CW_QUEUE, 1u, RLX_AGENT);
        __syncthreads();
        const int j = (int)MISC[16];
        if (j >= 512) break;
        fox_unit(lds, j & 15, 31 - (j >> 4), ws, tid);
    }
    GRID_BAR();
    if (PH & 0x4000) for (int it = blockIdx.x; it < 32 * NSEG; it += G) { if ((it & (NSEG - 1)) != 0) gla_fix_item(lds, it, ws, tid); }
    GRID_BAR();

    if (PH & 32) gla_norm_pass(ws, args.in[5], G);
    GRID_BAR();

    if (PH & 64) { pg8::StaticOrder S; S.init(MTOK, DM, G, (int)blockIdx.x);
      { pg8::Gemm g{(const pg8::bf16_t*)(ws + WS_OG), (const pg8::bf16_t*)(ws + WS_WBG), MTOK, DM, 2048};
        pg8::EpiEw<1> E{(float*)(ws + WS_YTMP), nullptr, nullptr, (const pg8::bf16_t*)(ws + WS_MA), DM, 0.f};
        pg8::gemm_phase<pg8::EpiEw<1>, pg8::StaticOrder, false, true>(lds, g, S, E); }
      asm volatile("s_waitcnt vmcnt(0)" ::: "memory"); __syncthreads();
      { pg8::Gemm g{(const pg8::bf16_t*)(ws + WS_OF), (const pg8::bf16_t*)(ws + WS_WBF), MTOK, DM, 1024};
        pg8::EpiEw<2> E{nullptr, (pg8::bf16_t*)(ws + WS_MERGED), (const float*)(ws + WS_YTMP), (const pg8::bf16_t*)(ws + WS_MB), DM, 0.f};
        pg8::gemm_phase<pg8::EpiEw<2>, pg8::StaticOrder, false, true>(lds, g, S, E); } }
    GRID_BAR();

    if (PH & 128) { pg8::StaticOrder S; S.init(MTOK, DM, G, (int)blockIdx.x);
      pg8::Gemm g{(const pg8::bf16_t*)(ws + WS_MERGED), (const pg8::bf16_t*)(ws + WS_WOUT), MTOK, DM, 2048};
      pg8::EpiEw<3> E{(float*)(ws + WS_X1), nullptr, args.in[0], nullptr, DM, ALPHA_RES};
      pg8::gemm_phase<pg8::EpiEw<3>, pg8::StaticOrder, false, true>(lds, g, S, E); }
    GRID_BAR();
    if (PH & 256) ln_pass((const float*)(ws + WS_X1), (float*)(ws + WS_X1), (bf16*)(ws + WS_XNB), args.in[10], args.in[11], G);
    GRID_BAR();

    if (PH & 512) { pg8::StaticOrder S; S.init(MTOK, FF, G, (int)blockIdx.x);
      pg8::Gemm g{(const pg8::bf16_t*)(ws + WS_XNB), (const pg8::bf16_t*)(ws + WS_WG), MTOK, FF, 2048};
      pg8::EpiBf E{(pg8::bf16_t*)(ws + WS_G), FF};
      pg8::gemm_phase<pg8::EpiBf, pg8::StaticOrder, true, true>(lds, g, S, E); }
    GRID_BAR();
    if (PH & 1024) { pg8::StaticOrder S; S.init(MTOK, FF, G, (int)blockIdx.x);
      pg8::Gemm g{(const pg8::bf16_t*)(ws + WS_XNB), (const pg8::bf16_t*)(ws + WS_WU), MTOK, FF, 2048};
      pg8::EpiUp E{(const pg8::bf16_t*)(ws + WS_G), (pg8::bf16_t*)(ws + WS_H), args.in[14], args.in[15]};
      pg8::gemm_phase<pg8::EpiUp, pg8::StaticOrder, true, true>(lds, g, S, E); }
    GRID_BAR();
    if (PH & 2048) { pg8::StaticOrder S; S.init(MTOK, DM, G, (int)blockIdx.x);
      pg8::Gemm g{(const pg8::bf16_t*)(ws + WS_H), (const pg8::bf16_t*)(ws + WS_WD), MTOK, DM, FF};
      pg8::EpiEw<3> E{(float*)(ws + WS_V2), nullptr, (const float*)(ws + WS_X1), nullptr, DM, ALPHA_RES};
      pg8::gemm_phase<pg8::EpiEw<3>, pg8::StaticOrder, false, true>(lds, g, S, E); }
    GRID_BAR();
    if (PH & 4096) ln_pass((const float*)(ws + WS_V2), args.out, (bf16*)(ws + WS_XNB), args.in[17], args.in[18], G);
    GRID_BAR();

    if (PH & 8192) { pg8::StaticOrder S; S.init(MTOK, DM, G, (int)blockIdx.x);
      { pg8::Gemm g{(const pg8::bf16_t*)(ws + WS_PB), (const pg8::bf16_t*)(ws + WS_WPP), MTOK, DM, PLE};
        pg8::EpiEw<0> E{(float*)(ws + WS_TMP), nullptr, nullptr, nullptr, DM, 0.f};
        pg8::gemm_phase<pg8::EpiEw<0>, pg8::StaticOrder, false, true>(lds, g, S, E); }
      asm volatile("s_waitcnt vmcnt(0)" ::: "memory"); __syncthreads();
      { pg8::Gemm g{(const pg8::bf16_t*)(ws + WS_XNB), (const pg8::bf16_t*)(ws + WS_WPG), MTOK, DM, 2048};
        pg8::EpiEw<4> E{args.out, nullptr, (const float*)(ws + WS_TMP), nullptr, DM, 0.f};
        pg8::gemm_phase<pg8::EpiEw<4>, pg8::StaticOrder, false, true>(lds, g, S, E); } }
#if PROBE
    GRID_BAR();
    if (blockIdx.x == 0 && tid == 0) {
        const unsigned ta = (PROBE_A == 99) ? (MISC[31] - MISC[32 + 3]) : (MISC[32 + PROBE_A + 1] - MISC[32 + PROBE_A]);
        const unsigned tb = (PROBE_B == 99) ? (MISC[31] - MISC[32 + 3]) : (MISC[32 + PROBE_B + 1] - MISC[32 + PROBE_B]);
        __hip_atomic_store(ctl + 80, ta, RLX_AGENT); __hip_atomic_store(ctl + 81, tb, RLX_AGENT);
    }
    GRID_BAR();
    { unsigned na = __hip_atomic_load(ctl + 80, RLX_AGENT) * 40u; const unsigned tb = __hip_atomic_load(ctl + 81, RLX_AGENT);
      if (na > 8000000u) na = 8000000u;
      for (unsigned i = blockIdx.x * 512 + tid; i < na; i += G * 512) args.out[i] += 0.008f;
      const unsigned long long t0 = __builtin_amdgcn_s_memrealtime();
      while (__builtin_amdgcn_s_memrealtime() - t0 < 2ull * tb) __builtin_amdgcn_s_sleep(8); }
#endif
}

extern "C" void kernel_launch(void* const* d_in, const int* in_sizes, int n_in, void* d_out, int out_size, void* d_ws, size_t ws_size, hipStream_t stream) {
    static int grid = 0;
    if (grid == 0) {
        if (n_in != 21 || in_sizes[0] != MTOK * DM || out_size != MTOK * DM || ws_size < WS_END) { fprintf(stderr, "kernel_launch: unexpected shapes (n_in %d, in0 %d, out %d, ws %zu < %zu)\n", n_in, n_in > 0 ? in_sizes[0] : -1, out_size, ws_size, (size_t)WS_END); grid = -1; return; }
        int dev = 0, cus = 0, per_cu = 0;
        if (hipGetDevice(&dev) != hipSuccess || hipDeviceGetAttribute(&cus, hipDeviceAttributeMultiprocessorCount, dev) != hipSuccess) { fprintf(stderr, "kernel_launch: device query failed\n"); grid = -1; return; }
        if (hipFuncSetAttribute((const void*)mega_fwd, hipFuncAttributeMaxDynamicSharedMemorySize, LDS_BYTES) != hipSuccess) { fprintf(stderr, "kernel_launch: hipFuncSetAttribute failed\n"); grid = -1; return; }
        if (hipOccupancyMaxActiveBlocksPerMultiprocessor(&per_cu, (const void*)mega_fwd, 512, LDS_BYTES) != hipSuccess || per_cu < 1) { fprintf(stderr, "kernel_launch: occupancy query says %d blocks per CU\n", per_cu); per_cu = 1; }
        (void)hipGetLastError();
        grid = cus;
    }
    if (grid < 0) return;
    if (hipMemsetAsync((char*)d_ws + WS_CTL, 0, CTL_ZERO_BYTES, stream) != hipSuccess) { fprintf(stderr, "kernel_launch: memset failed\n"); return; }
    Args a{};
    for (int i = 0; i < 21; ++i) a.in[i] = (const float*)d_in[i];
    a.out = (float*)d_out; a.ws = (unsigned char*)d_ws;
    void* kargs[] = {&a};
    const hipError_t e = hipLaunchCooperativeKernel((const void*)mega_fwd, dim3(grid), dim3(512), kargs, LDS_BYTES, stream);
    if (e != hipSuccess) fprintf(stderr, "kernel_launch: cooperative launch failed: %s (grid %d)\n", hipGetErrorString(e), grid);
}
```

```cpp
#include <hip/hip_runtime.h>
#include <hip/hip_cooperative_groups.h>
#include <cstdio>
#include <cstdint>
namespace cg = cooperative_groups;

constexpr int BATCH = 2, SEQ = 4096, DM = 2048, MTOK = BATCH * SEQ;
constexpr int N_IN = 13336, NPAD = 13568, FF = 5632, PLE = 256;
constexpr float ALPHA_RES = 1.189207115002721f;
constexpr float LN_EPS = 1e-5f, RMS_EPS = 1e-6f;
constexpr float LOG2E = 1.4426950408889634f;

constexpr size_t MiB = 1u << 20;
constexpr size_t WS_CTL = 0, CTL_ZERO_BYTES = 65536;
constexpr size_t WS_WBG = 1 * MiB, WS_WBF = 9 * MiB, WS_WOUT = 13 * MiB, WS_WG = 21 * MiB, WS_WU = 43 * MiB, WS_WD = 65 * MiB, WS_WPG = 87 * MiB, WS_WPP = 95 * MiB;
constexpr size_t WS_PB = 96 * MiB;
constexpr size_t WS_R1 = 100 * MiB;
constexpr size_t WS_WIN = WS_R1, WS_XB = WS_R1 + 53 * MiB;
constexpr size_t WS_QT = WS_R1, WS_KT = WS_R1 + 16 * MiB, WS_VT = WS_R1 + 32 * MiB, WS_ATT = WS_R1 + 64 * MiB, WS_DEC = WS_R1 + 68 * MiB, WS_FVT = WS_R1 + 69 * MiB, WS_CB = WS_R1 + 85 * MiB;
constexpr size_t WS_YTMP = WS_R1;
constexpr size_t WS_G = WS_R1;
constexpr size_t WS_V2 = WS_R1;
constexpr size_t WS_GQ = 188 * MiB, WS_GK = 204 * MiB, WS_GV = 220 * MiB, WS_GR = 252 * MiB, WS_FQ = 284 * MiB, WS_FK = 300 * MiB, WS_FV = 316 * MiB, WS_MB = 332 * MiB, WS_MA = 364 * MiB, WS_SM = 396 * MiB;
constexpr size_t WS_ORAW = WS_GQ;
constexpr size_t WS_X1 = WS_GQ;
constexpr size_t WS_OG = WS_GR, WS_OF = WS_FQ, WS_MERGED = WS_FK;
constexpr size_t WS_H = WS_GR;
constexpr size_t WS_TMP = WS_GR;
constexpr size_t WS_XNB = WS_MA;
constexpr size_t WS_LSEG = 397 * MiB;
constexpr size_t WS_PDEC = 413 * MiB;
constexpr size_t WS_DSEG = 413 * MiB + 512 * 1024;
constexpr size_t WS_END = 414 * MiB;
constexpr int CW_QUEUE = 64, CW_QUEUE2 = 128;
constexpr int CW_BAR = 4096;

constexpr int LDS_BYTES = 147456;
constexpr int MISC_OFF = LDS_BYTES - 256;
#define LAS __attribute__((address_space(3)))
typedef LAS unsigned char* lds_t;
namespace pg8 {
#define PG8_LAS __attribute__((address_space(3)))
typedef unsigned short bf16_t;
typedef short bf16x8 __attribute__((ext_vector_type(8)));
typedef float f32x4 __attribute__((ext_vector_type(4)));
typedef unsigned u32x4 __attribute__((ext_vector_type(4)));
constexpr int BM = 256, BK = 64, HALF = 128, HTB = HALF * BK * 2  , STAGE_BYTES = 8 * HTB, NXCD = 8, WGM = 8;

__host__ __device__ __forceinline__ int lds_byte(int r, int c) { const int st = (r >> 4) * 2 + (c >> 5), rr = r & 15, cc = c & 31, ob = rr * 64 + cc * 2; return st * 1024 + (ob ^ (((ob >> 9) & 1) << 5)); }
__host__ __device__ __forceinline__ void stage_rc(int b, int& R, int& C) { const int st = b / 1024, sb = b % 1024, swz = sb ^ (((sb >> 9) & 1) << 5); R = (st >> 1) * 16 + swz / 64; C = (st & 1) * 32 + (swz % 64) / 2; }
__host__ __device__ __forceinline__ int perm32(int rho) { const int n = rho >> 4, i = rho & 15; return 8 * (i >> 2) + 4 * n + (i & 3); }

struct Unit { int pm, pn; };
struct Gemm { const bf16_t* A; const bf16_t* Bt; int M, N, K; };

struct StaticOrder {
    int nM, nN, nwg, G, c;
    __host__ __device__ void init(int M, int N, int G_, int c_) { nM = M / BM; nN = N / BM; nwg = nM * nN; G = G_; c = c_; }
    __host__ __device__ bool next(int i, Unit& u) const {
        const long L = (long)i * G + c; if (L >= nwg) return false;
        int wgid = (int)L; { const int q = nwg / NXCD, r = nwg % NXCD, xcd = wgid % NXCD, off = wgid / NXCD; wgid = (xcd < r ? xcd * (q + 1) : r * (q + 1) + (xcd - r) * q) + off; }
        const int nig = WGM * nN, gid = wgid / nig, fm = gid * WGM, gsz = (nM - fm) < WGM ? (nM - fm) : WGM;
        u.pm = fm + ((wgid % nig) % gsz); u.pn = (wgid % nig) / gsz; return true;
    }
    __device__ __forceinline__ void a_ready(const Unit&) const {}
    __device__ __forceinline__ void done(const Unit&) const {}
};

__device__ __forceinline__ unsigned cvt_pk_bf16(float lo, float hi) { unsigned r; asm volatile("v_cvt_pk_bf16_f32 %0, %1, %2" : "=v"(r) : "v"(lo), "v"(hi)); return r; }
typedef float f32x2 __attribute__((ext_vector_type(2)));

__device__ __forceinline__ float fsigmoid(float x) { return __builtin_amdgcn_rcpf(1.0f + __builtin_amdgcn_exp2f(-1.4426950408889634f * x)); }
__device__ __forceinline__ void unpack8(const u32x4 w, float (&f)[8]) {
#pragma unroll
    for (int i = 0; i < 4; ++i) { f[2 * i] = __uint_as_float(w[i] << 16); f[2 * i + 1] = __uint_as_float(w[i] & 0xffff0000u); }
}
__device__ __forceinline__ u32x4 pack8(const f32x4 a, const f32x4 b) { u32x4 w; w.x = cvt_pk_bf16(a[0], a[1]); w.y = cvt_pk_bf16(a[2], a[3]); w.z = cvt_pk_bf16(b[0], b[1]); w.w = cvt_pk_bf16(b[2], b[3]); return w; }

struct EpiProj {
    static constexpr bool PERM = true, AFTER_DRAIN = false;
    unsigned char* ws; float qscale;
    __device__ __forceinline__ void operator()(const f32x4 (&acc)[2][2][4][2], const Unit& u, int wr, int wc, int fr, int fq) const {
        const int pn = u.pn; const int row0 = u.pm * BM + wr * 64 + fr;
        if (pn == 52) {
            if (wc == 0) { float* sm = (float*)(ws + WS_SM);
#pragma unroll
                for (int ai = 0; ai < 2; ++ai)
#pragma unroll
                    for (int m = 0; m < 4; ++m) { float* rp = sm + (size_t)(row0 + ai * HALF + m * 16) * 32 + 8 * fq; *(f32x4*)rp = acc[ai][0][m][0]; *(f32x4*)(rp + 4) = acc[ai][0][m][1]; } }
            return;
        }
        size_t off; int ldc, ct; float sc = 1.f;
        if (pn < 4) { off = WS_GQ; ldc = 1024; ct = pn; }
        else if (pn < 8) { off = WS_GK; ldc = 1024; ct = pn - 4; }
        else if (pn < 16) { off = WS_GV; ldc = 2048; ct = pn - 8; }
        else if (pn < 24) { off = WS_GR; ldc = 2048; ct = pn - 16; }
        else if (pn < 28) { off = WS_FQ; ldc = 1024; ct = pn - 24; sc = qscale; }
        else if (pn < 32) { off = WS_FK; ldc = 1024; ct = pn - 28; }
        else if (pn < 36) { off = WS_FV; ldc = 1024; ct = pn - 32; }
        else if (pn < 44) { off = WS_MA; ldc = 2048; ct = pn - 36; }
        else { off = WS_MB; ldc = 2048; ct = pn - 44; }
        bf16_t* base = (bf16_t*)(ws + off); const int col0 = ct * BM + wc * 32 + 8 * fq;
#pragma unroll
        for (int ai = 0; ai < 2; ++ai)
#pragma unroll
            for (int m = 0; m < 4; ++m) { bf16_t* rowp = base + (size_t)(row0 + ai * HALF + m * 16) * ldc + col0;
#pragma unroll
                for (int bj = 0; bj < 2; ++bj) *(u32x4*)(rowp + bj * HALF) = pack8(acc[ai][bj][m][0] * sc, acc[ai][bj][m][1] * sc); }
    }
};
struct EpiBf {
    static constexpr bool PERM = true, AFTER_DRAIN = false;
    bf16_t* O; int ldc;
    __device__ __forceinline__ void operator()(const f32x4 (&acc)[2][2][4][2], const Unit& u, int wr, int wc, int fr, int fq) const {
        const int row0 = u.pm * BM + wr * 64 + fr, col0 = u.pn * BM + wc * 32 + 8 * fq;
#pragma unroll
        for (int ai = 0; ai < 2; ++ai)
#pragma unroll
            for (int m = 0; m < 4; ++m) { bf16_t* rowp = O + (size_t)(row0 + ai * HALF + m * 16) * ldc + col0;
#pragma unroll
                for (int bj = 0; bj < 2; ++bj) *(u32x4*)(rowp + bj * HALF) = pack8(acc[ai][bj][m][0], acc[ai][bj][m][1]); }
    }
};
template <int MODE> struct EpiEw {
    static constexpr bool PERM = true, AFTER_DRAIN = false;
    float* O32; bf16_t* Obf; const float* I32; const bf16_t* GATE; int ldc; float alpha;
    __device__ __forceinline__ void operator()(const f32x4 (&acc)[2][2][4][2], const Unit& u, int wr, int wc, int fr, int fq) const {
        const int row0 = u.pm * BM + wr * 64 + fr, col0 = u.pn * BM + wc * 32 + 8 * fq;
#pragma unroll
        for (int ai = 0; ai < 2; ++ai)
#pragma unroll
            for (int m = 0; m < 4; ++m) { const size_t ro = (size_t)(row0 + ai * HALF + m * 16) * ldc + col0;
#pragma unroll
                for (int bj = 0; bj < 2; ++bj) { const size_t o = ro + bj * HALF; f32x4 a0 = acc[ai][bj][m][0], a1 = acc[ai][bj][m][1];
                    if (MODE == 0) { *(f32x4*)(O32 + o) = a0; *(f32x4*)(O32 + o + 4) = a1; }
                    if (MODE == 1 || MODE == 2) { float g[8]; unpack8(*(const u32x4*)(GATE + o), g);
#pragma unroll
                        for (int j = 0; j < 4; ++j) { a0[j] *= fsigmoid(g[j]); a1[j] *= fsigmoid(g[4 + j]); }
                        if (MODE == 1) { *(f32x4*)(O32 + o) = a0; *(f32x4*)(O32 + o + 4) = a1; }
                        else { const f32x4 i0 = *(const f32x4*)(I32 + o), i1 = *(const f32x4*)(I32 + o + 4); *(u32x4*)(Obf + o) = pack8(a0 + i0, a1 + i1); } }
                    if (MODE == 3) { const f32x4 i0 = *(const f32x4*)(I32 + o), i1 = *(const f32x4*)(I32 + o + 4); *(f32x4*)(O32 + o) = i0 * alpha + a0; *(f32x4*)(O32 + o + 4) = i1 * alpha + a1; }
                    if (MODE == 4) { const f32x4 i0 = *(const f32x4*)(I32 + o), i1 = *(const f32x4*)(I32 + o + 4); f32x4 x0 = *(const f32x4*)(O32 + o), x1 = *(const f32x4*)(O32 + o + 4);
#pragma unroll
                        for (int j = 0; j < 4; ++j) { x0[j] += fsigmoid(a0[j]) * i0[j]; x1[j] += fsigmoid(a1[j]) * i1[j]; }
                        *(f32x4*)(O32 + o) = x0; *(f32x4*)(O32 + o + 4) = x1; }
                } }
    }
};
struct EpiUp {
    static constexpr bool PERM = true, AFTER_DRAIN = false;
    const bf16_t* G; bf16_t* H; const float* cw; const float* cb;
    __device__ __forceinline__ void operator()(const f32x4 (&acc)[2][2][4][2], const Unit& u, int wr, int wc, int fr, int fq) const {
        const int row0 = u.pm * BM + wr * 64 + fr;
#pragma unroll
        for (int bj = 0; bj < 2; ++bj) {
            const int c0 = u.pn * BM + bj * HALF + wc * 32 + 8 * fq;
            const f32x4 w0a = *(const f32x4*)(cw + c0), w0b = *(const f32x4*)(cw + c0 + 4), w1a = *(const f32x4*)(cw + FF + c0), w1b = *(const f32x4*)(cw + FF + c0 + 4);
            const f32x4 w2a = *(const f32x4*)(cw + 2 * FF + c0), w2b = *(const f32x4*)(cw + 2 * FF + c0 + 4), ba = *(const f32x4*)(cb + c0), bb = *(const f32x4*)(cb + c0 + 4);
#pragma unroll
            for (int ai = 0; ai < 2; ++ai)
#pragma unroll
                for (int m = 0; m < 4; ++m) {
                    const int r = row0 + ai * HALF + m * 16, t = r & (SEQ - 1);
                    const int r1 = t >= 1 ? r - 1 : r, r2 = t >= 2 ? r - 2 : r; const float f1 = t >= 1 ? 1.f : 0.f, f2 = t >= 2 ? 1.f : 0.f;
                    float g2[8], g1[8], g0[8];
                    unpack8(*(const u32x4*)(G + (size_t)r * FF + c0), g2); unpack8(*(const u32x4*)(G + (size_t)r1 * FF + c0), g1); unpack8(*(const u32x4*)(G + (size_t)r2 * FF + c0), g0);
                    f32x4 h0, h1;
#pragma unroll
                    for (int j = 0; j < 4; ++j) {
                        const float ca = ba[j] + w0a[j] * (g0[j] * f2) + w1a[j] * (g1[j] * f1) + w2a[j] * g2[j];
                        const float cb_ = bb[j] + w0b[j] * (g0[4 + j] * f2) + w1b[j] * (g1[4 + j] * f1) + w2b[j] * g2[4 + j];
                        const float ya = 1.5957691216057308f * (ca + 0.044715f * ca * ca * ca), yb = 1.5957691216057308f * (cb_ + 0.044715f * cb_ * cb_ * cb_);
                        h0[j] = ca * fsigmoid(ya) * acc[ai][bj][m][0][j]; h1[j] = cb_ * fsigmoid(yb) * acc[ai][bj][m][1][j];
                    }
                    *(u32x4*)(H + (size_t)r * FF + c0) = pack8(h0, h1);
                }
        }
    }
};

template <class Epi, class Sched, bool ALIGN_EPI = false, bool SP2 = false>
__device__ __forceinline__ void gemm_phase(PG8_LAS unsigned char* lds, const Gemm g, const Sched& S, const Epi& E) {
    int tid_ = threadIdx.x; asm volatile("" : "+v"(tid_));
    const int tid = tid_, wid = __builtin_amdgcn_readfirstlane(tid >> 6), lane = tid & 63, wr = wid >> 2, wc = wid & 3, fr = lane & 15, fq = lane >> 4;
    const int K = g.K, nt = K / BK;
    unsigned voffA[2], voffB[2];
#pragma unroll
    for (int i = 0; i < 2; ++i) { int R, C; stage_rc(tid * 16 + i * 8192, R, C); const int Rb = Epi::PERM ? ((R & ~31) + perm32(R & 31)) : R;
        voffA[i] = (unsigned)(R * K + C) * 2u; voffB[i] = (unsigned)(Rb * K + C) * 2u; }
    const size_t kstep = (size_t)(BK * 2);
    const size_t hstep = (size_t)HALF * K * 2;
    const size_t tstep = 2 * hstep;
    const unsigned ldsw = (unsigned)wid * 1024u;
    const int aoff = lds_byte(wr * 64 + fr, fq * 8), boff = lds_byte(wc * 32 + fr, fq * 8);
#define PG8_SA(b, h) (((b) * 2 + (h)) * HTB)
#define PG8_SB(b, h) ((4 + (b) * 2 + (h)) * HTB)
#define PG8_STAGE(bufoff, gbase, voff) do { _Pragma("unroll") for (int _i = 0; _i < 2; ++_i) \
        __builtin_amdgcn_global_load_lds((const unsigned*)((const char*)(gbase) + (voff)[_i]), (PG8_LAS unsigned*)(lds + (bufoff) + ldsw + _i * 8192), 16, 0, 0); } while (0)
#define PG8_LDA(dst, b, h) do { _Pragma("unroll") for (int m = 0; m < 4; ++m) _Pragma("unroll") for (int k = 0; k < 2; ++k) dst[m][k] = *(const PG8_LAS bf16x8*)(lds + PG8_SA(b, h) + aoff + m * 2048 + k * 1024); } while (0)
#define PG8_LDB(dst, b, h) do { _Pragma("unroll") for (int n = 0; n < 2; ++n) _Pragma("unroll") for (int k = 0; k < 2; ++k) dst[n][k] = *(const PG8_LAS bf16x8*)(lds + PG8_SB(b, h) + boff + n * 2048 + k * 1024); } while (0)
#define PG8_MMA(ai, bj, At, Bt) do { __builtin_amdgcn_s_setprio(1); _Pragma("unroll") for (int m = 0; m < 4; ++m) _Pragma("unroll") for (int n = 0; n < 2; ++n) _Pragma("unroll") for (int k = 0; k < 2; ++k) \
        acc[ai][bj][m][n] = __builtin_amdgcn_mfma_f32_16x16x32_bf16(Bt[n][k], At[m][k], acc[ai][bj][m][n], 0, 0, 0); __builtin_amdgcn_s_setprio(0); } while (0)
#define PG8_WAIT_V(n) asm volatile("s_waitcnt vmcnt(" #n ")" ::: "memory")
#define PG8_WAIT_L(n) asm volatile("s_waitcnt lgkmcnt(" #n ")" ::: "memory")
#define PG8_BAR __builtin_amdgcn_s_barrier()
#define PG8_SCHED __builtin_amdgcn_sched_barrier(0)
    Unit cur, nxt; int ui = 0;
    if (!S.next(0, cur)) return;
    f32x4 acc[2][2][4][2];
#pragma unroll
    for (int a = 0; a < 2; ++a)
#pragma unroll
        for (int b = 0; b < 2; ++b)
#pragma unroll
            for (int m = 0; m < 4; ++m)
#pragma unroll
                for (int n = 0; n < 2; ++n) acc[a][b][m][n] = (f32x4){0.f, 0.f, 0.f, 0.f};
    bf16x8 At[4][2], B0[2][2], B1[2][2];
    const char* cA = (const char*)g.A + (size_t)cur.pm * tstep; const char* cB = (const char*)g.Bt + (size_t)cur.pn * tstep;
    S.a_ready(cur);
    if constexpr (SP2) {
        PG8_STAGE(PG8_SB(0, 0), cB, voffB); PG8_STAGE(PG8_SB(0, 1), cB + hstep, voffB); PG8_STAGE(PG8_SA(0, 0), cA, voffA); PG8_STAGE(PG8_SA(0, 1), cA + hstep, voffA);
        if (wr == 1) PG8_BAR;
        PG8_WAIT_V(2); PG8_BAR;
        PG8_STAGE(PG8_SB(1, 0), cB + kstep, voffB); PG8_STAGE(PG8_SA(1, 0), cA + kstep, voffA); PG8_STAGE(PG8_SB(1, 1), cB + hstep + kstep, voffB);
        PG8_WAIT_V(6); PG8_BAR;
    } else {
        PG8_STAGE(PG8_SB(0, 0), cB, voffB); PG8_STAGE(PG8_SA(0, 0), cA, voffA); PG8_STAGE(PG8_SB(0, 1), cB + hstep, voffB); PG8_STAGE(PG8_SA(0, 1), cA + hstep, voffA);
        if (wr == 1) PG8_BAR;
        PG8_WAIT_V(4); PG8_BAR;
        PG8_STAGE(PG8_SB(1, 0), cB + kstep, voffB); PG8_STAGE(PG8_SA(1, 0), cA + kstep, voffA); PG8_STAGE(PG8_SB(1, 1), cB + hstep + kstep, voffB);
        PG8_WAIT_V(6); PG8_BAR;
    }
    for (;;) {
        const bool has_next = S.next(ui + 1, nxt);
        const char* nA = has_next ? (const char*)g.A + (size_t)nxt.pm * tstep : cA; const char* nB = has_next ? (const char*)g.Bt + (size_t)nxt.pn * tstep : cB;
        for (int t = 0; t < nt; t += 2) {
            const bool last = (t == nt - 2);
            const char* a1 = cA + (size_t)(t + 1) * kstep;
            const char* a2 = last ? nA : cA + (size_t)(t + 2) * kstep; const char* b2 = last ? nB : cB + (size_t)(t + 2) * kstep;
            const char* a3 = a2 + kstep; const char* b3 = b2 + kstep;
            if (last && has_next) S.a_ready(nxt);
            if constexpr (SP2) {
            PG8_LDB(B0, 0, 0); PG8_LDB(B1, 0, 1); PG8_SCHED; PG8_LDA(At, 0, 0); PG8_STAGE(PG8_SA(1, 1), a1 + hstep, voffA);
            PG8_WAIT_V(8); PG8_WAIT_L(0); PG8_BAR; PG8_MMA(0, 0, At, B0); PG8_MMA(0, 1, At, B1); PG8_BAR; PG8_SCHED;
            PG8_LDA(At, 0, 1); PG8_STAGE(PG8_SB(0, 0), b2, voffB); PG8_STAGE(PG8_SB(0, 1), b2 + hstep, voffB); PG8_STAGE(PG8_SA(0, 0), a2, voffA);
            PG8_WAIT_V(8); PG8_WAIT_L(0); PG8_BAR; PG8_MMA(1, 0, At, B0); PG8_MMA(1, 1, At, B1); PG8_BAR; PG8_SCHED;
            PG8_LDB(B0, 1, 0); PG8_LDB(B1, 1, 1); PG8_SCHED; PG8_LDA(At, 1, 0); PG8_STAGE(PG8_SA(0, 1), a2 + hstep, voffA);
            PG8_WAIT_V(8); PG8_WAIT_L(0); PG8_BAR; PG8_MMA(0, 0, At, B0); PG8_MMA(0, 1, At, B1); PG8_BAR; PG8_SCHED;
            PG8_LDA(At, 1, 1); PG8_STAGE(PG8_SB(1, 0), b3, voffB); PG8_STAGE(PG8_SB(1, 1), b3 + hstep, voffB); PG8_STAGE(PG8_SA(1, 0), a3, voffA);
            PG8_WAIT_V(8); PG8_WAIT_L(0); PG8_BAR; PG8_MMA(1, 0, At, B0); PG8_MMA(1, 1, At, B1); PG8_BAR; PG8_SCHED;
            } else {
            PG8_LDB(B0, 0, 0); PG8_SCHED; PG8_LDA(At, 0, 0); PG8_STAGE(PG8_SA(1, 1), a1 + hstep, voffA);
            PG8_WAIT_L(8); PG8_BAR; PG8_WAIT_L(0); PG8_MMA(0, 0, At, B0); PG8_BAR; PG8_SCHED;
            PG8_LDB(B1, 0, 1); PG8_STAGE(PG8_SB(0, 0), b2, voffB);
            PG8_BAR; PG8_WAIT_L(0); PG8_MMA(0, 1, At, B1); PG8_BAR;
            PG8_LDA(At, 0, 1); PG8_STAGE(PG8_SA(0, 0), a2, voffA);
            PG8_BAR; PG8_WAIT_L(0); PG8_MMA(1, 0, At, B0); PG8_BAR; PG8_SCHED;
            PG8_STAGE(PG8_SB(0, 1), b2 + hstep, voffB);
            PG8_WAIT_V(6); PG8_BAR; PG8_MMA(1, 1, At, B1); PG8_BAR;
            PG8_LDB(B0, 1, 0); PG8_SCHED; PG8_LDA(At, 1, 0); PG8_STAGE(PG8_SA(0, 1), a2 + hstep, voffA);
            PG8_WAIT_L(8); PG8_BAR; PG8_WAIT_L(0); PG8_MMA(0, 0, At, B0); PG8_BAR; PG8_SCHED;
            PG8_LDB(B1, 1, 1); PG8_STAGE(PG8_SB(1, 0), b3, voffB);
            PG8_BAR; PG8_WAIT_L(0); PG8_MMA(0, 1, At, B1); PG8_BAR;
            PG8_LDA(At, 1, 1); PG8_STAGE(PG8_SA(1, 0), a3, voffA);
            PG8_BAR; PG8_WAIT_L(0); PG8_MMA(1, 0, At, B0); PG8_BAR; PG8_SCHED;
            PG8_STAGE(PG8_SB(1, 1), b3 + hstep, voffB);
            PG8_WAIT_V(6); PG8_BAR; PG8_MMA(1, 1, At, B1); PG8_BAR;
            }
        }
        if constexpr (ALIGN_EPI) { if (wr == 0) PG8_BAR; }
        if constexpr (!Epi::AFTER_DRAIN) { E(acc, cur, wr, wc, fr, fq); S.done(cur); }
        if (!has_next) break;
#pragma unroll
        for (int a = 0; a < 2; ++a)
#pragma unroll
            for (int b = 0; b < 2; ++b)
#pragma unroll
                for (int m = 0; m < 4; ++m)
#pragma unroll
                    for (int n = 0; n < 2; ++n) acc[a][b][m][n] = (f32x4){0.f, 0.f, 0.f, 0.f};
        cur = nxt; cA = nA; cB = nB; ++ui;
        if constexpr (ALIGN_EPI) { if (wr == 1) PG8_BAR; }
    }
    PG8_WAIT_V(0);
    if constexpr (!ALIGN_EPI) { if (wr == 0) PG8_BAR; }
    PG8_BAR;
    if constexpr (Epi::AFTER_DRAIN) { E.fused(acc, cur, wr, wc, fr, fq, lds, wid, lane); S.done(cur); }
#undef PG8_SA
#undef PG8_SB
#undef PG8_STAGE
#undef PG8_LDA
#undef PG8_LDB
#undef PG8_MMA
#undef PG8_WAIT_V
#undef PG8_WAIT_L
#undef PG8_BAR
#undef PG8_SCHED
}
}

typedef unsigned short bf16;
typedef float v4f __attribute__((ext_vector_type(4)));
typedef float v16f __attribute__((ext_vector_type(16)));
typedef unsigned v4u __attribute__((ext_vector_type(4)));
typedef unsigned v2u __attribute__((ext_vector_type(2)));
typedef short v8s __attribute__((ext_vector_type(8)));
#define RLX_AGENT __ATOMIC_RELAXED, __HIP_MEMORY_SCOPE_AGENT
template <class T> __device__ __forceinline__ T lds_ld(lds_t p, int off) { return *(const LAS T*)(p + off); }
template <class T> __device__ __forceinline__ void lds_st(lds_t p, int off, T v) { *(LAS T*)(p + off) = v; }
__device__ __forceinline__ unsigned cvtpk(float lo, float hi) { return pg8::cvt_pk_bf16(lo, hi); }
__device__ __forceinline__ float bf_lo(unsigned w) { return __uint_as_float(w << 16); }
__device__ __forceinline__ float bf_hi(unsigned w) { return __uint_as_float(w & 0xffff0000u); }
__device__ __forceinline__ float wave_sum(float v) {
#pragma unroll
    for (int o = 1; o < 64; o <<= 1) v += __shfl_xor(v, o);
    return v;
}
#define MFMA16(a, b, c) __builtin_amdgcn_mfma_f32_16x16x32_bf16((a), (b), (c), 0, 0, 0)
#define MFMA32(a, b, c) __builtin_amdgcn_mfma_f32_32x32x16_bf16((a), (b), (c), 0, 0, 0)

#define XB_TMO      128
#define XB_XCNT(j)  (256  + 64 * (j))
#define XB_XSUB(j)  (1280 + 64 * (j))
#define XB_XGEN(j)  (2304 + 64 * (j))
#define XB_TOP      3328
#define XB_TOPGEN   3392
#define XCD_BAR_WORDS 3456
#define XB_SPIN_CAP (1u << 22)
__device__ __forceinline__ unsigned xb_ld(unsigned* p)              { return __hip_atomic_load(p, __ATOMIC_RELAXED, __HIP_MEMORY_SCOPE_AGENT); }
__device__ __forceinline__ unsigned xb_add(unsigned* p, unsigned v) { return __hip_atomic_fetch_add(p, v, __ATOMIC_RELAXED, __HIP_MEMORY_SCOPE_AGENT); }
__device__ __forceinline__ unsigned xb_xcc_id() { return (unsigned)__builtin_amdgcn_s_getreg((3 << 11) | 20) & 0xFu; }
#define XB_SPIN(cond, bar) do { unsigned _sp = 0; while (cond) { __builtin_amdgcn_s_sleep(1); \
    if ((++_sp & 255u) == 0u) { if (xb_ld(&(bar)[XB_TMO])) break; if (_sp > XB_SPIN_CAP) { atomicAdd(&(bar)[XB_TMO], 1u); break; } } } } while (0)
struct XcdBarrier { unsigned* bar; unsigned x; volatile LAS unsigned* st; };
__device__ __forceinline__ XcdBarrier xcd_barrier_post(unsigned* bar, volatile LAS unsigned* st) {
    XcdBarrier b; b.bar = bar; b.x = xb_xcc_id(); b.st = st;
    if (threadIdx.x == 0) (void)xb_add(&bar[XB_XCNT(b.x)], 1u);
    return b;
}
__device__ __forceinline__ void xcd_barrier_complete(unsigned* bar, unsigned x, unsigned& nloc, unsigned& nx) {
    const unsigned G = gridDim.x * gridDim.y * gridDim.z;
    unsigned sum, cnt, mine, sp = 0u;
    for (;;) {
        sum = 0u; cnt = 0u; mine = 0u;
#pragma unroll
        for (unsigned j = 0; j < 16; ++j) { const unsigned c = xb_ld(&bar[XB_XCNT(j)]); sum += c; cnt += (c > 0u) ? 1u : 0u; mine = (j == x) ? c : mine; }
        if (sum == G) break;
        __builtin_amdgcn_s_sleep(1);
        if ((++sp & 255u) == 0u) { if (xb_ld(&bar[XB_TMO])) break; if (sp > XB_SPIN_CAP) { atomicAdd(&bar[XB_TMO], 1u); break; } }
    }
    nloc = mine > 0u ? mine : 1u; nx = cnt > 0u ? cnt : 1u;
}
__device__ __forceinline__ void xcd_barrier(const XcdBarrier& b) {
    asm volatile("s_waitcnt vmcnt(0)" ::: "memory");
    __syncthreads();
    if (threadIdx.x == 0) {
        unsigned* bar = b.bar;
        __builtin_amdgcn_s_waitcnt(0);
        unsigned nloc = b.st[0], nx = b.st[1];
        if (nloc == 0u) { xcd_barrier_complete(bar, b.x, nloc, nx); b.st[0] = nloc; b.st[1] = nx; }
        const unsigned old = xb_add(&bar[XB_XSUB(b.x)], 1u);
        const unsigned gen = old / nloc;
        if (old + 1u == (gen + 1u) * nloc) {
            __builtin_amdgcn_fence(__ATOMIC_RELEASE, "agent");
            asm volatile("s_waitcnt vmcnt(0)" ::: "memory");
            const unsigned og = xb_add(&bar[XB_TOP], 1u);
            const unsigned tg = og / nx;
            if (og + 1u == (tg + 1u) * nx) xb_add(&bar[XB_TOPGEN], 1u);
            else XB_SPIN(xb_ld(&bar[XB_TOPGEN]) == tg, bar);
            __builtin_amdgcn_fence(__ATOMIC_ACQUIRE, "agent");
            xb_add(&bar[XB_XGEN(b.x)], 1u);
            asm volatile("s_waitcnt vmcnt(0)" ::: "memory");
        } else {
            XB_SPIN(xb_ld(&bar[XB_XGEN(b.x)]) == gen, bar);
            __builtin_amdgcn_fence(__ATOMIC_ACQUIRE, "agent");
            asm volatile("s_waitcnt vmcnt(0)" ::: "memory");
        }
    }
    __syncthreads();
}

__device__ __forceinline__ void tr_item(const float* W, int K, int Nsrc, int scol, bf16* WT, int drow, int kb, lds_t scr, int lane) {
    const int k0 = 64 * kb;
    { float v[32]; const float* wp = W + (size_t)(k0 + (lane >> 5)) * Nsrc + scol + (lane & 31);
#pragma unroll
      for (int i = 0; i < 32; ++i) v[i] = wp[(size_t)(2 * i) * Nsrc];
#pragma unroll
      for (int i = 0; i < 32; ++i) lds_st<float>(scr, ((2 * i + (lane >> 5)) * 33 + (lane & 31)) * 4, v[i]); }
    asm volatile("s_waitcnt lgkmcnt(0)" ::: "memory");
    const int c = lane & 7;
#pragma unroll
    for (int j = 0; j < 4; ++j) { const int n = (lane >> 3) + 8 * j; const int so = ((8 * c) * 33 + n) * 4;
        v4u o; o.x = cvtpk(lds_ld<float>(scr, so), lds_ld<float>(scr, so + 33 * 4)); o.y = cvtpk(lds_ld<float>(scr, so + 2 * 33 * 4), lds_ld<float>(scr, so + 3 * 33 * 4));
        o.z = cvtpk(lds_ld<float>(scr, so + 4 * 33 * 4), lds_ld<float>(scr, so + 5 * 33 * 4)); o.w = cvtpk(lds_ld<float>(scr, so + 6 * 33 * 4), lds_ld<float>(scr, so + 7 * 33 * 4));
        *(v4u*)(WT + (size_t)(drow + n) * K + k0 + 8 * c) = o; }
    asm volatile("s_waitcnt lgkmcnt(0)" ::: "memory");
}
__device__ __forceinline__ void tr_mat(const float* W, int K, int N, bf16* WT, int r, lds_t scr, int lane) { const int nblk = N / 32, kb = r / nblk, nb = r % nblk; tr_item(W, K, N, 32 * nb, WT, 32 * nb, kb, scr, lane); }

constexpr int I_WIN = 32 * 416, I_BG = 32 * 64, I_BF = 16 * 64, I_OUT = 32 * 64, I_G = 32 * 176, I_U = I_G, I_D = 88 * 64, I_PG = 32 * 64, I_PP = 4 * 64;
constexpr int I_REST = I_BG + I_BF + I_OUT + I_G + I_U + I_D + I_PG + I_PP;
__device__ __forceinline__ void rest_item(int r, const float* const* in, unsigned char* ws, lds_t scr, int lane) {
    if (r < I_BG) { tr_mat(in[7], 2048, 2048, (bf16*)(ws + WS_WBG), r, scr, lane); return; } r -= I_BG;
    if (r < I_BF) { tr_mat(in[8], 1024, 2048, (bf16*)(ws + WS_WBF), r, scr, lane); return; } r -= I_BF;
    if (r < I_OUT) { tr_mat(in[9], 2048, 2048, (bf16*)(ws + WS_WOUT), r, scr, lane); return; } r -= I_OUT;
    if (r < I_G) { tr_mat(in[12], 2048, FF, (bf16*)(ws + WS_WG), r, scr, lane); return; } r -= I_G;
    if (r < I_U) { tr_mat(in[13], 2048, FF, (bf16*)(ws + WS_WU), r, scr, lane); return; } r -= I_U;
    if (r < I_D) { tr_mat(in[16], FF, 2048, (bf16*)(ws + WS_WD), r, scr, lane); return; } r -= I_D;
    if (r < I_PG) { tr_mat(in[19], 2048, 2048, (bf16*)(ws + WS_WPG), r, scr, lane); return; } r -= I_PG;
    tr_mat(in[20], PLE, 2048, (bf16*)(ws + WS_WPP), r, scr, lane);
}
__device__ __forceinline__ void rest_queue(lds_t lds, volatile LAS unsigned* MISC, unsigned* qword, int lo, int hi, const float* const* in, unsigned char* ws) {
    int tid = threadIdx.x; asm volatile("" : "+v"(tid));
    const int lane = tid & 63, wave = tid >> 6; lds_t scr = lds + wave * 16384;
    for (;;) {
        __syncthreads();
        if (tid == 0) MISC[17] = __hip_atomic_fetch_add(qword, 1u, RLX_AGENT);
        __syncthreads();
        const int base = lo + (int)MISC[17] * 32;
        if (base >= hi) break;
#pragma unroll 1
        for (int j = 0; j < 4; ++j) { const int r = base + j * 8 + wave; if (r < hi) rest_item(r, in, ws, scr, lane); }
    }
}
__device__ __forceinline__ void p0_prologue(lds_t lds, const float* const* in, unsigned char* ws, int G) {
    const int tid = threadIdx.x, lane = tid & 63, wave = tid >> 6;
    lds_t scr = lds + wave * 16384;
    const int gw = blockIdx.x * 8 + wave, NGW = G * 8;
    for (int it = gw; it < I_WIN; it += NGW) {
        const int kb = it / 416, nb = it % 416, drow = 32 * nb; const int scol = drow + (drow >= 6144 ? 16 : 0) + (drow >= 9216 ? 8 : 0);
        tr_item(in[2], 2048, N_IN, scol, (bf16*)(ws + WS_WIN), drow, kb, scr, lane);
    }
    const int gt = blockIdx.x * 512 + tid, NT = G * 512;
    { const float* win = in[2]; bf16* WT = (bf16*)(ws + WS_WIN);
      for (int i = gt; i < 256 * 256; i += NT) { const int j = i >> 8, kc = (i & 255) * 8; v4u o = (v4u){0u, 0u, 0u, 0u};
          if (j < 24) { const int sc = j < 16 ? 6144 + j : 9232 + (j - 16); float f[8];
#pragma unroll
              for (int e = 0; e < 8; ++e) f[e] = win[(size_t)(kc + e) * N_IN + sc];
              o.x = cvtpk(f[0], f[1]); o.y = cvtpk(f[2], f[3]); o.z = cvtpk(f[4], f[5]); o.w = cvtpk(f[6], f[7]); }
          *(v4u*)(WT + (size_t)(13312 + j) * 2048 + kc) = o; } }
    { const float* x = in[0]; bf16* XB = (bf16*)(ws + WS_XB);
#pragma unroll 4
      for (int i = gt; i < MTOK * DM / 8; i += NT) { const v4f a = *(const v4f*)(x + (size_t)i * 8), b = *(const v4f*)(x + (size_t)i * 8 + 4);
          v4u o; o.x = cvtpk(a[0], a[1]); o.y = cvtpk(a[2], a[3]); o.z = cvtpk(b[0], b[1]); o.w = cvtpk(b[2], b[3]); *(v4u*)(XB + (size_t)i * 8) = o; } }
    { const float* p = in[1]; bf16* PB = (bf16*)(ws + WS_PB);
      for (int i = gt; i < MTOK * PLE / 8; i += NT) { const v4f a = *(const v4f*)(p + (size_t)i * 8), b = *(const v4f*)(p + (size_t)i * 8 + 4);
          v4u o; o.x = cvtpk(a[0], a[1]); o.y = cvtpk(a[2], a[3]); o.z = cvtpk(b[0], b[1]); o.w = cvtpk(b[2], b[3]); *(v4u*)(PB + (size_t)i * 8) = o; } }
}

__device__ __forceinline__ float log_sigmoid_fast(float z) { return fminf(z, 0.f) - __logf(1.0f + __expf(-fabsf(z))); }
__device__ __forceinline__ void gla_prep_item(lds_t lds, int item, const unsigned char* ws, const float* wlr, const float* blr, int tid) {
    asm volatile("" : "+v"(tid));
    const bf16* GQ = (const bf16*)(ws + WS_GQ); const bf16* GK = (const bf16*)(ws + WS_GK); const bf16* GV = (const bf16*)(ws + WS_GV); const float* SM = (const float*)(ws + WS_SM);
    bf16* QT = (bf16*)(ws + WS_QT); bf16* KT = (bf16*)(ws + WS_KT); bf16* VT = (bf16*)(ws + WS_VT); bf16* ATT = (bf16*)(ws + WS_ATT); float* DEC = (float*)(ws + WS_DEC);
    const int c = item & 63, bh = item >> 6, h = bh & 3, b = bh >> 2;
    const size_t tok0 = (size_t)b * SEQ + 64 * c;
    constexpr int L_BC = 0, L_TOT = 65536, L_GLR = 67584, L_QS = 71680, L_KS = 105472, QROW = 528;
    const int lane = tid & 63, wid = tid >> 6, l15 = lane & 15, q4 = lane >> 4;
    const int k = tid & 255, half = tid >> 8;
    v4f glv = (v4f){0.f, 0.f, 0.f, 0.f};
    if (tid < 256) glv = *(const v4f*)(SM + (tok0 + (tid >> 2)) * 32 + (tid & 3) * 4);
    float w[16];
#pragma unroll
    for (int r = 0; r < 16; ++r) w[r] = wlr[r * 1024 + h * 256 + k];
    const float bias = blr[h * 256 + k];
    v4u qv[4], kv[4], vv[8];
#pragma unroll
    for (int i = 0; i < 4; ++i) { const int idx = tid + 512 * i, t = idx >> 5, kc = (idx & 31) * 8; qv[i] = *(const v4u*)(GQ + (tok0 + t) * 1024 + h * 256 + kc); kv[i] = *(const v4u*)(GK + (tok0 + t) * 1024 + h * 256 + kc); }
#pragma unroll
    for (int i = 0; i < 8; ++i) { const int idx = tid + 512 * i; vv[i] = *(const v4u*)(GV + (tok0 + (idx >> 6)) * 2048 + h * 512 + (idx & 63) * 8); }
    __syncthreads();
    if (tid < 256) lds_st<v4f>(lds, L_GLR + ((tid >> 2) * 16 + (tid & 3) * 4) * 4, glv);
    __syncthreads();
    float run = 0.f;
    for (int tt = 0; tt < 32; ++tt) { const int t = half * 32 + tt; float z = bias;
#pragma unroll
        for (int r4 = 0; r4 < 4; ++r4) { const v4f g = lds_ld<v4f>(lds, L_GLR + (t * 16 + r4 * 4) * 4); z += g[0] * w[4 * r4] + g[1] * w[4 * r4 + 1] + g[2] * w[4 * r4 + 2] + g[3] * w[4 * r4 + 3]; }
        run += log_sigmoid_fast(z) * 0.0625f;
        lds_st<float>(lds, L_BC + (t * 256 + k) * 4, run); }
    lds_st<float>(lds, L_TOT + (half * 256 + k) * 4, run);
    __syncthreads();
    if (tid < 256) DEC[(size_t)item * 256 + tid] = __expf(lds_ld<float>(lds, L_TOT + tid * 4) + lds_ld<float>(lds, L_TOT + (256 + tid) * 4));
#pragma unroll
    for (int i = 0; i < 4; ++i) { const int idx = tid + 512 * i, t = idx >> 5, kc = (idx & 31) * 8;
        v4f b0 = lds_ld<v4f>(lds, L_BC + (t * 256 + kc) * 4), b1 = lds_ld<v4f>(lds, L_BC + (t * 256 + kc + 4) * 4);
        if (t >= 32) { b0 += lds_ld<v4f>(lds, L_TOT + kc * 4); b1 += lds_ld<v4f>(lds, L_TOT + (kc + 4) * 4); }
        float qq[8], kk[8], bc[8];
#pragma unroll
        for (int j = 0; j < 4; ++j) { qq[2 * j] = bf_lo(qv[i][j]); qq[2 * j + 1] = bf_hi(qv[i][j]); kk[2 * j] = bf_lo(kv[i][j]); kk[2 * j + 1] = bf_hi(kv[i][j]); bc[j] = b0[j]; bc[4 + j] = b1[j]; }
#pragma unroll
        for (int j = 0; j < 8; ++j) { qq[j] = qq[j] * __expf(bc[j]) * 0.0625f; kk[j] = kk[j] * __expf(-bc[j]); }
        v4u qp, kp; qp.x = cvtpk(qq[0], qq[1]); qp.y = cvtpk(qq[2], qq[3]); qp.z = cvtpk(qq[4], qq[5]); qp.w = cvtpk(qq[6], qq[7]);
        kp.x = cvtpk(kk[0], kk[1]); kp.y = cvtpk(kk[2], kk[3]); kp.z = cvtpk(kk[4], kk[5]); kp.w = cvtpk(kk[6], kk[7]);
        *(v4u*)(QT + (size_t)item * 16384 + t * 256 + kc) = qp;
        lds_st<v4u>(lds, L_QS + t * QROW + kc * 2, qp); lds_st<v4u>(lds, L_KS + t * QROW + kc * 2, kp); }
    __syncthreads();
#pragma unroll
    for (int i = 0; i < 4; ++i) { const int idx = tid + 512 * i, kk = idx >> 3, sc = (idx & 7) * 8; unsigned e[8];
#pragma unroll
        for (int j = 0; j < 8; ++j) e[j] = lds_ld<unsigned short>(lds, L_KS + (sc + j) * QROW + kk * 2);
        v4u o; o.x = e[0] | (e[1] << 16); o.y = e[2] | (e[3] << 16); o.z = e[4] | (e[5] << 16); o.w = e[6] | (e[7] << 16);
        *(v4u*)(KT + (size_t)item * 16384 + kk * 64 + sc) = o; }
    { const int mt = wid >> 1;
#pragma unroll
      for (int nn = 0; nn < 2; ++nn) { const int nt = (wid & 1) * 2 + nn; v4f acc = (v4f){0.f, 0.f, 0.f, 0.f};
          if (nt <= mt) {
#pragma unroll
              for (int ks = 0; ks < 8; ++ks) { const v8s a = lds_ld<v8s>(lds, L_QS + (16 * mt + l15) * QROW + (32 * ks + 8 * q4) * 2), bb = lds_ld<v8s>(lds, L_KS + (16 * nt + l15) * QROW + (32 * ks + 8 * q4) * 2); acc = MFMA16(a, bb, acc); } }
#pragma unroll
          for (int r = 0; r < 4; ++r) { const int t = 16 * mt + 4 * q4 + r, s2 = 16 * nt + l15; const float v = (s2 <= t) ? acc[r] : 0.f; ATT[(size_t)item * 4096 + t * 64 + s2] = (bf16)(cvtpk(v, 0.f) & 0xffffu); } } }
    __syncthreads();
#pragma unroll
    for (int i = 0; i < 8; ++i) { const int idx = tid + 512 * i, s2 = idx >> 6, vc = (idx & 63) * 8;
#pragma unroll
        for (int j = 0; j < 4; ++j) { lds_st<unsigned short>(lds, (vc + 2 * j) * 132 + s2 * 2, (unsigned short)(vv[i][j] & 0xffffu)); lds_st<unsigned short>(lds, (vc + 2 * j + 1) * 132 + s2 * 2, (unsigned short)(vv[i][j] >> 16)); } }
    __syncthreads();
#pragma unroll
    for (int i = 0; i < 8; ++i) { const int idx = tid + 512 * i, v = idx >> 3, c8 = idx & 7; v4u o;
        o.x = lds_ld<unsigned>(lds, v * 132 + c8 * 16); o.y = lds_ld<unsigned>(lds, v * 132 + c8 * 16 + 4); o.z = lds_ld<unsigned>(lds, v * 132 + c8 * 16 + 8); o.w = lds_ld<unsigned>(lds, v * 132 + c8 * 16 + 12);
        *(v4u*)(VT + (size_t)item * 32768 + v * 64 + c8 * 8) = o; }
}
__device__ __forceinline__ void fv_tr_item(lds_t lds, int item, const unsigned char* ws, int tid) {
    asm volatile("" : "+v"(tid));
    const bf16* FV = (const bf16*)(ws + WS_FV); bf16* FVT = (bf16*)(ws + WS_FVT);
    const int bh = item >> 4, tt = item & 15, b = bh >> 3, h = bh & 7;
    v4u vv[8];
#pragma unroll
    for (int i = 0; i < 8; ++i) { const int idx = tid + 512 * i; vv[i] = *(const v4u*)(FV + ((size_t)b * SEQ + 256 * tt + (idx >> 4)) * 1024 + h * 128 + (idx & 15) * 8); }
    __syncthreads();
#pragma unroll
    for (int i = 0; i < 8; ++i) { const int idx = tid + 512 * i, s = idx >> 4, dc = (idx & 15) * 8;
#pragma unroll
        for (int j = 0; j < 4; ++j) { lds_st<unsigned short>(lds, (dc + 2 * j) * 516 + s * 2, (unsigned short)(vv[i][j] & 0xffffu)); lds_st<unsigned short>(lds, (dc + 2 * j + 1) * 516 + s * 2, (unsigned short)(vv[i][j] >> 16)); } }
    __syncthreads();
#pragma unroll
    for (int i = 0; i < 8; ++i) { const int idx = tid + 512 * i, d = idx >> 5, c8 = idx & 31; v4u o;
        o.x = lds_ld<unsigned>(lds, d * 516 + c8 * 16); o.y = lds_ld<unsigned>(lds, d * 516 + c8 * 16 + 4); o.z = lds_ld<unsigned>(lds, d * 516 + c8 * 16 + 8); o.w = lds_ld<unsigned>(lds, d * 516 + c8 * 16 + 12);
        *(v4u*)(FVT + ((size_t)bh * 128 + d) * SEQ + 256 * tt + c8 * 8) = o; }
}
__device__ __forceinline__ void fox_cumsum_item(lds_t lds, int bh, const unsigned char* ws, const float* bfg, int tid) {
    asm volatile("" : "+v"(tid));
    const float* SM = (const float*)(ws + WS_SM); float* CB = (float*)(ws + WS_CB);
    const int b = bh >> 3, h = bh & 7, lane = tid & 63, wid = tid >> 6; const float bf = bfg[h];
    __syncthreads();
    float v[8]; float run = 0.f;
#pragma unroll
    for (int j = 0; j < 8; ++j) { const float z = SM[((size_t)b * SEQ + tid * 8 + j) * 32 + 16 + h] + bf; run += log_sigmoid_fast(z); v[j] = run; }
    float inc = run;
#pragma unroll
    for (int o = 1; o < 64; o <<= 1) { const float n = __shfl_up(inc, o); if (lane >= o) inc += n; }
    if (lane == 63) lds_st<float>(lds, wid * 4, inc);
    __syncthreads();
    float pre = inc - run;
    for (int w2 = 0; w2 < wid; ++w2) pre += lds_ld<float>(lds, w2 * 4);
#pragma unroll
    for (int j = 0; j < 8; ++j) CB[(size_t)bh * SEQ + tid * 8 + j] = -LOG2E * (pre + v[j]);
}

constexpr int NSEG = 8, SEGC = 64 / NSEG;
__device__ __forceinline__ void gla_scan_item(lds_t lds, int item, const unsigned char* ws, int tid) {
    asm volatile("" : "+v"(tid));
    const bf16* QT = (const bf16*)(ws + WS_QT); const bf16* KT = (const bf16*)(ws + WS_KT); const bf16* VT = (const bf16*)(ws + WS_VT); const bf16* ATT = (const bf16*)(ws + WS_ATT); const float* DEC = (const float*)(ws + WS_DEC);
    float* ORAW = (float*)(ws + WS_ORAW); bf16* LSEG = (bf16*)(ws + WS_LSEG); float* PDEC = (float*)(ws + WS_PDEC); float* DSEG = (float*)(ws + WS_DSEG);
    float prun = 1.f;
    const int seg = item & (NSEG - 1), i32 = item / NSEG, vq = i32 & 3, bh4 = i32 >> 2, h = bh4 & 3, b = bh4 >> 2;
    const int lane = tid & 63, wid = tid >> 6, l15 = lane & 15, q4 = lane >> 4;
    constexpr int QROW = 528, KROW = 144, L_Q = 0, L_K = 33792, L_A = 33792 + 36864, L_D = L_A + 9216;
    const int vcol = 128 * vq + 16 * wid + l15;
    v4f S[16];
#pragma unroll
    for (int i = 0; i < 16; ++i) S[i] = (v4f){0.f, 0.f, 0.f, 0.f};
    v4u pq[4], pk[4], pa, pvf[2]; v4f pd;
#define GS_PREFETCH(cc) do { const size_t it_ = (size_t)bh4 * 64 + (cc); \
        _Pragma("unroll") for (int i = 0; i < 4; ++i) { const int idx = tid + 512 * i; pq[i] = *(const v4u*)(QT + it_ * 16384 + idx * 8); } \
        pa = *(const v4u*)(ATT + it_ * 4096 + tid * 8); \
        _Pragma("unroll") for (int kk = 0; kk < 2; ++kk) pvf[kk] = *(const v4u*)(VT + (it_ * 512 + vcol) * 64 + 32 * kk + 8 * q4); } while (0)
#define GS_PREFETCH2(cc) do { const size_t it_ = (size_t)bh4 * 64 + (cc); \
        _Pragma("unroll") for (int i = 0; i < 4; ++i) { const int idx = tid + 512 * i; pk[i] = *(const v4u*)(KT + it_ * 16384 + idx * 8); } \
        if (tid < 64) pd = *(const v4f*)(DEC + it_ * 256 + tid * 4); } while (0)
    GS_PREFETCH(seg * SEGC); GS_PREFETCH2(seg * SEGC);
    for (int c = seg * SEGC; c < (seg + 1) * SEGC; ++c) {
        __syncthreads();
#pragma unroll
        for (int i = 0; i < 4; ++i) { const int idx = tid + 512 * i; lds_st<v4u>(lds, L_Q + (idx >> 5) * QROW + (idx & 31) * 16, pq[i]); lds_st<v4u>(lds, L_K + (idx >> 3) * KROW + (idx & 7) * 16, pk[i]); }
        lds_st<v4u>(lds, L_A + (tid >> 3) * KROW + (tid & 7) * 16, pa);
        if (tid < 64) lds_st<v4f>(lds, L_D + tid * 16, pd);
        v8s vf[2]; vf[0] = __builtin_bit_cast(v8s, pvf[0]); vf[1] = __builtin_bit_cast(v8s, pvf[1]);
        __syncthreads();
        if (c + 1 < (seg + 1) * SEGC) GS_PREFETCH(c + 1);
        v4f o[4];
#pragma unroll
        for (int mt = 0; mt < 4; ++mt) o[mt] = (v4f){0.f, 0.f, 0.f, 0.f};
#pragma unroll
        for (int ks = 0; ks < 8; ++ks) {
            v4u bw; bw.x = cvtpk(S[2 * ks][0], S[2 * ks][1]); bw.y = cvtpk(S[2 * ks][2], S[2 * ks][3]); bw.z = cvtpk(S[2 * ks + 1][0], S[2 * ks + 1][1]); bw.w = cvtpk(S[2 * ks + 1][2], S[2 * ks + 1][3]);
            const v8s bfr = __builtin_bit_cast(v8s, bw);
#pragma unroll
            for (int mt = 0; mt < 4; ++mt) { const v2u lo = lds_ld<v2u>(lds, L_Q + (16 * mt + l15) * QROW + (32 * ks + 4 * q4) * 2), hi = lds_ld<v2u>(lds, L_Q + (16 * mt + l15) * QROW + (32 * ks + 16 + 4 * q4) * 2);
                const v4u aw = (v4u){lo.x, lo.y, hi.x, hi.y}; o[mt] = MFMA16(__builtin_bit_cast(v8s, aw), bfr, o[mt]); }
        }
#pragma unroll
        for (int kk = 0; kk < 2; ++kk)
#pragma unroll
            for (int mt = 0; mt < 4; ++mt) { const v8s a = lds_ld<v8s>(lds, L_A + (16 * mt + l15) * KROW + (32 * kk + 8 * q4) * 2); o[mt] = MFMA16(a, vf[kk], o[mt]); }
        { float* op = ORAW + ((size_t)b * SEQ + 64 * c) * 2048 + h * 512 + vcol;
#pragma unroll
          for (int mt = 0; mt < 4; ++mt)
#pragma unroll
              for (int r = 0; r < 4; ++r) op[(size_t)(16 * mt + 4 * q4 + r) * 2048] = o[mt][r]; }
        if (vq == 0 && tid < 256) { PDEC[((size_t)bh4 * 64 + c) * 256 + tid] = prun; prun *= lds_ld<float>(lds, L_D + tid * 4); }
        __builtin_amdgcn_sched_barrier(0);
        if (c + 1 < (seg + 1) * SEGC) GS_PREFETCH2(c + 1);
        __builtin_amdgcn_sched_barrier(0);
#pragma unroll
        for (int kt = 0; kt < 16; ++kt) { v4f acc = S[kt];
#pragma unroll
            for (int kk = 0; kk < 2; ++kk) { const v8s a = lds_ld<v8s>(lds, L_K + (16 * kt + l15) * KROW + (32 * kk + 8 * q4) * 2); acc = MFMA16(a, vf[kk], acc); }
            const v4f dc = lds_ld<v4f>(lds, L_D + (16 * kt + 4 * q4) * 4); S[kt] = acc * dc; }
    }
#undef GS_PREFETCH
#undef GS_PREFETCH2
    if (vq == 0 && tid < 256) DSEG[((size_t)bh4 * NSEG + seg) * 256 + tid] = prun;
    if (seg < NSEG - 1) { bf16* lp = LSEG + ((size_t)(i32 * NSEG + seg) * 128 + 16 * wid + l15) * 256 + 4 * q4;
#pragma unroll
        for (int kt = 0; kt < 16; ++kt) *(v2u*)(lp + 16 * kt) = (v2u){cvtpk(S[kt][0], S[kt][1]), cvtpk(S[kt][2], S[kt][3])}; }
}

__device__ __forceinline__ void gla_fix_item(lds_t lds, int item, const unsigned char* ws, int tid) {
    asm volatile("" : "+v"(tid));
    const bf16* QT = (const bf16*)(ws + WS_QT); const bf16* LSEG = (const bf16*)(ws + WS_LSEG); float* ORAW = (float*)(ws + WS_ORAW); const float* PDEC = (const float*)(ws + WS_PDEC); const float* DSEG = (const float*)(ws + WS_DSEG);
    const int seg = item & (NSEG - 1), i32 = item / NSEG, vq = i32 & 3, bh4 = i32 >> 2, h = bh4 & 3, b = bh4 >> 2;
    const int lane = tid & 63, wid = tid >> 6, l15 = lane & 15, q4 = lane >> 4;
    constexpr int QROW = 528, L_Q = 0;
    const int vcol = 128 * vq + 16 * wid + l15;
    float a[8][8];
#pragma unroll
    for (int ks = 0; ks < 8; ++ks)
#pragma unroll
        for (int j = 0; j < 8; ++j) a[ks][j] = 0.f;
    for (int s2 = 0; s2 < seg; ++s2) {
        const bf16* lp = LSEG + ((size_t)(i32 * NSEG + s2) * 128 + 16 * wid + l15) * 256 + 8 * q4; const float* dp = DSEG + ((size_t)bh4 * NSEG + s2) * 256 + 8 * q4;
#pragma unroll
        for (int ks = 0; ks < 8; ++ks) { const v4u lw = *(const v4u*)(lp + 32 * ks); const v4f d0 = *(const v4f*)(dp + 32 * ks), d1 = *(const v4f*)(dp + 32 * ks + 4);
            a[ks][0] = a[ks][0] * d0[0] + bf_lo(lw.x); a[ks][1] = a[ks][1] * d0[1] + bf_hi(lw.x); a[ks][2] = a[ks][2] * d0[2] + bf_lo(lw.y); a[ks][3] = a[ks][3] * d0[3] + bf_hi(lw.y);
            a[ks][4] = a[ks][4] * d1[0] + bf_lo(lw.z); a[ks][5] = a[ks][5] * d1[1] + bf_hi(lw.z); a[ks][6] = a[ks][6] * d1[2] + bf_lo(lw.w); a[ks][7] = a[ks][7] * d1[3] + bf_hi(lw.w); }
    }
    v8s bfr[8];
#pragma unroll
    for (int ks = 0; ks < 8; ++ks) { v4u w; w.x = cvtpk(a[ks][0], a[ks][1]); w.y = cvtpk(a[ks][2], a[ks][3]); w.z = cvtpk(a[ks][4], a[ks][5]); w.w = cvtpk(a[ks][6], a[ks][7]); bfr[ks] = __builtin_bit_cast(v8s, w); }
    v4u pq[4]; v4f pp[4][2]; v4f po[4];
#define GF_PREFETCH(cc) do { const size_t it_ = (size_t)bh4 * 64 + (cc); \
        { const float* op_ = ORAW + ((size_t)b * SEQ + 64 * (cc)) * 2048 + h * 512 + vcol; \
          _Pragma("unroll") for (int mt = 0; mt < 4; ++mt) _Pragma("unroll") for (int r = 0; r < 4; ++r) po[mt][r] = op_[(size_t)(16 * mt + 4 * q4 + r) * 2048]; } \
        _Pragma("unroll") for (int i = 0; i < 4; ++i) { const int idx = tid + 512 * i; pq[i] = *(const v4u*)(QT + it_ * 16384 + idx * 8); \
            pp[i][0] = *(const v4f*)(PDEC + it_ * 256 + (idx & 31) * 8); pp[i][1] = *(const v4f*)(PDEC + it_ * 256 + (idx & 31) * 8 + 4); } } while (0)
    GF_PREFETCH(seg * SEGC);
    for (int ci = 0; ci < SEGC; ++ci) { const int c = seg * SEGC + ci;
        __syncthreads();
#pragma unroll
        for (int i = 0; i < 4; ++i) { const int idx = tid + 512 * i, t = idx >> 5, kc = (idx & 31) * 8; const v4f p0 = pp[i][0], p1 = pp[i][1];
            v4u w; w.x = cvtpk(bf_lo(pq[i].x) * p0[0], bf_hi(pq[i].x) * p0[1]); w.y = cvtpk(bf_lo(pq[i].y) * p0[2], bf_hi(pq[i].y) * p0[3]);
            w.z = cvtpk(bf_lo(pq[i].z) * p1[0], bf_hi(pq[i].z) * p1[1]); w.w = cvtpk(bf_lo(pq[i].w) * p1[2], bf_hi(pq[i].w) * p1[3]);
            lds_st<v4u>(lds, L_Q + t * QROW + kc * 2, w); }
        v4f o[4];
#pragma unroll
        for (int mt = 0; mt < 4; ++mt) o[mt] = po[mt];
        __syncthreads();
        if (ci + 1 < SEGC) GF_PREFETCH(c + 1);
        float* op = ORAW + ((size_t)b * SEQ + 64 * c) * 2048 + h * 512 + vcol;
#pragma unroll
        for (int ks = 0; ks < 8; ++ks)
#pragma unroll
            for (int mt = 0; mt < 4; ++mt) { const v8s aa = lds_ld<v8s>(lds, L_Q + (16 * mt + l15) * QROW + (32 * ks + 8 * q4) * 2); o[mt] = MFMA16(aa, bfr[ks], o[mt]); }
#pragma unroll
        for (int mt = 0; mt < 4; ++mt)
#pragma unroll
            for (int r = 0; r < 4; ++r) op[(size_t)(16 * mt + 4 * q4 + r) * 2048] = o[mt][r];
    }
#undef GF_PREFETCH
}

__device__ __forceinline__ void fox_unit(lds_t lds, int bh, int qi, const unsigned char* ws, int tid) {
    asm volatile("" : "+v"(tid));
    const bf16* FQ = (const bf16*)(ws + WS_FQ); const bf16* FK = (const bf16*)(ws + WS_FK); const bf16* FVT = (const bf16*)(ws + WS_FVT); const float* CB = (const float*)(ws + WS_CB); bf16* OF = (bf16*)(ws + WS_OF);
    const int lane = tid & 63, wid = tid >> 6, r32 = lane & 31, hi = lane >> 5, rg = wid & 3, par = wid >> 2;
    const int b = bh >> 3, h = bh & 7; const size_t rowbase = (size_t)b * SEQ; const int q0 = qi * 128;
    constexpr int KROW = 272, VROW = 136, TILEB = 17408, L_V0 = 2 * TILEB;
    const size_t qrow = rowbase + q0 + 32 * rg + r32;
    constexpr int L_QF = 4 * TILEB;
#pragma unroll
    for (int i = 0; i < 4; ++i) { const int idx = tid + 512 * i; lds_st<v4u>(lds, L_QF + (idx >> 4) * KROW + (idx & 15) * 16, *(const v4u*)(FQ + (rowbase + q0 + (idx >> 4)) * 1024 + h * 128 + (idx & 15) * 8)); }
    const int qb = L_QF + (32 * rg + r32) * KROW + 16 * hi;
    v16f o[4];
#pragma unroll
    for (int d = 0; d < 4; ++d)
#pragma unroll
        for (int r = 0; r < 16; ++r) o[d][r] = 0.f;
    const float NEG = -__builtin_inff();
    float m = NEG, l = 0.f;
    const int niter = qi + 1;
    v4u pk[4], pv[4]; v4f pb;
    constexpr int L_CB = L_QF + 128 * KROW;
#define FX_PREFETCH(it) do { if (tid < 32) pb = *(const v4f*)(CB + (size_t)bh * SEQ + (size_t)(it) * 128 + tid * 4); \
        _Pragma("unroll") for (int i = 0; i < 4; ++i) { const int idx = tid + 512 * i, tile = idx >> 10; \
            pk[i] = *(const v4u*)(FK + (rowbase + (size_t)(2 * (it) + tile) * 64 + ((idx >> 4) & 63)) * 1024 + h * 128 + (idx & 15) * 8); \
            pv[i] = *(const v4u*)(FVT + ((size_t)bh * 128 + ((idx >> 3) & 127)) * SEQ + (2 * (it) + tile) * 64 + (idx & 7) * 8); } } while (0)
    FX_PREFETCH(0);
    for (int it = 0; it < niter; ++it) {
        __syncthreads();
#pragma unroll
        for (int i = 0; i < 4; ++i) { const int idx = tid + 512 * i, tile = idx >> 10;
            lds_st<v4u>(lds, tile * TILEB + ((idx >> 4) & 63) * KROW + (idx & 15) * 16, pk[i]);
            const int vo = L_V0 + tile * TILEB + ((idx >> 3) & 127) * VROW + (idx & 7) * 16;
            lds_st<v2u>(lds, vo, (v2u){pv[i].x, pv[i].y}); lds_st<v2u>(lds, vo + 8, (v2u){pv[i].z, pv[i].w}); }
        if (tid < 32) lds_st<v4f>(lds, L_CB + tid * 16, pb);
        __syncthreads();
        if (it + 1 < niter) FX_PREFETCH(it + 1);
        const int ks0 = (2 * it + par) * 64;
        if (ks0 <= q0 + 32 * rg) {
            v16f s0, s1;
#pragma unroll
            for (int r = 0; r < 16; ++r) { s0[r] = 0.f; s1[r] = 0.f; }
            const int kb = par * TILEB + r32 * KROW + 16 * hi;
            { v8s qv[8];
#pragma unroll
              for (int s = 0; s < 8; ++s) qv[s] = lds_ld<v8s>(lds, qb + 32 * s);
              v8s a0 = lds_ld<v8s>(lds, kb), a1 = lds_ld<v8s>(lds, kb + 32 * KROW);
#pragma unroll
              for (int s = 0; s < 8; ++s) { v8s n0 = a0, n1 = a1;
                  if (s < 7) { n0 = lds_ld<v8s>(lds, kb + 32 * (s + 1)); n1 = lds_ld<v8s>(lds, kb + 32 * KROW + 32 * (s + 1)); }
                  __builtin_amdgcn_sched_barrier(0);
                  s0 = MFMA32(a0, qv[s], s0); s1 = MFMA32(a1, qv[s], s1);
                  __builtin_amdgcn_sched_barrier(0);
                  a0 = n0; a1 = n1; } }
#pragma unroll
            for (int g = 0; g < 4; ++g) { const v4f b0 = lds_ld<v4f>(lds, L_CB + (par * 64 + 8 * g + 4 * hi) * 4), b1 = lds_ld<v4f>(lds, L_CB + (par * 64 + 32 + 8 * g + 4 * hi) * 4);
#pragma unroll
                for (int j = 0; j < 4; ++j) { s0[4 * g + j] += b0[j]; s1[4 * g + j] += b1[j]; } }
            if (ks0 + 63 > q0 + 32 * rg) { const int qabs = q0 + 32 * rg + r32;
#pragma unroll
                for (int r = 0; r < 16; ++r) { const int kv = ks0 + (r & 3) + 8 * (r >> 2) + 4 * hi; if (kv > qabs) s0[r] = NEG; if (kv + 32 > qabs) s1[r] = NEG; } }
            float rm = fmaxf(s0[0], s1[0]);
#pragma unroll
            for (int r = 1; r < 16; ++r) rm = fmaxf(rm, fmaxf(s0[r], s1[r]));
            rm = fmaxf(rm, __shfl_xor(rm, 32));
            const float mn = fmaxf(m, rm), alpha = __builtin_amdgcn_exp2f(m - mn); m = mn;
            float ps = 0.f;
#pragma unroll
            for (int r = 0; r < 16; ++r) { s0[r] = __builtin_amdgcn_exp2f(s0[r] - mn); s1[r] = __builtin_amdgcn_exp2f(s1[r] - mn); ps += s0[r] + s1[r]; }
            l = l * alpha + ps;
#pragma unroll
            for (int d = 0; d < 4; ++d)
#pragma unroll
                for (int r = 0; r < 16; ++r) o[d][r] *= alpha;
            v8s pf[4];
            { v4u w;
              w.x = cvtpk(s0[0], s0[1]); w.y = cvtpk(s0[2], s0[3]); w.z = cvtpk(s0[4], s0[5]); w.w = cvtpk(s0[6], s0[7]); pf[0] = __builtin_bit_cast(v8s, w);
              w.x = cvtpk(s0[8], s0[9]); w.y = cvtpk(s0[10], s0[11]); w.z = cvtpk(s0[12], s0[13]); w.w = cvtpk(s0[14], s0[15]); pf[1] = __builtin_bit_cast(v8s, w);
              w.x = cvtpk(s1[0], s1[1]); w.y = cvtpk(s1[2], s1[3]); w.z = cvtpk(s1[4], s1[5]); w.w = cvtpk(s1[6], s1[7]); pf[2] = __builtin_bit_cast(v8s, w);
              w.x = cvtpk(s1[8], s1[9]); w.y = cvtpk(s1[10], s1[11]); w.z = cvtpk(s1[12], s1[13]); w.w = cvtpk(s1[14], s1[15]); pf[3] = __builtin_bit_cast(v8s, w); }
            const int vb = L_V0 + par * TILEB + r32 * VROW + 8 * hi;
#define FX_VLD(i) ({ const int d_ = (i) & 3, kk_ = (i) >> 2; const v2u lo_ = lds_ld<v2u>(lds, vb + 32 * d_ * VROW + 32 * kk_), hh_ = lds_ld<v2u>(lds, vb + 32 * d_ * VROW + 32 * kk_ + 16); (v4u){lo_.x, lo_.y, hh_.x, hh_.y}; })
            { v4u f0 = FX_VLD(0), f1 = FX_VLD(1), f2 = FX_VLD(2);
#pragma unroll
              for (int i = 0; i < 16; ++i) { v4u f3 = f0;
                  if (i + 3 < 16) f3 = FX_VLD(i + 3);
                  __builtin_amdgcn_sched_barrier(0);
                  o[i & 3] = MFMA32(__builtin_bit_cast(v8s, f0), pf[i >> 2], o[i & 3]);
                  __builtin_amdgcn_sched_barrier(0);
                  f0 = f1; f1 = f2; f2 = f3; } }
#undef FX_VLD
        }
    }
#undef FX_PREFETCH
    l += __shfl_xor(l, 32);
    __syncthreads();
    constexpr int L_ML = 65536;
    if (par == 1) {
#pragma unroll
        for (int d = 0; d < 4; ++d)
#pragma unroll
            for (int r = 0; r < 16; ++r) lds_st<float>(lds, ((rg * 64 + d * 16 + r) * 64 + lane) * 4, o[d][r]);
        lds_st<float>(lds, L_ML + (rg * 128 + lane) * 4, m); lds_st<float>(lds, L_ML + (rg * 128 + 64 + lane) * 4, l);
    }
    __syncthreads();
    if (par == 0) {
        const float m1 = lds_ld<float>(lds, L_ML + (rg * 128 + lane) * 4), l1 = lds_ld<float>(lds, L_ML + (rg * 128 + 64 + lane) * 4);
        const float mt = fmaxf(m, m1), a0 = __builtin_amdgcn_exp2f(m - mt), a1 = __builtin_amdgcn_exp2f(m1 - mt);
        const float inv = 1.0f / (l * a0 + l1 * a1);
        bf16* op = OF + qrow * 1024 + h * 128 + 4 * hi;
#pragma unroll
        for (int d = 0; d < 4; ++d)
#pragma unroll
            for (int g = 0; g < 4; ++g) { float v[4];
#pragma unroll
                for (int j = 0; j < 4; ++j) v[j] = (o[d][4 * g + j] * a0 + lds_ld<float>(lds, ((rg * 64 + d * 16 + 4 * g + j) * 64 + lane) * 4) * a1) * inv;
                *(v2u*)(op + 32 * d + 8 * g) = (v2u){cvtpk(v[0], v[1]), cvtpk(v[2], v[3])}; }
    }
}

__device__ __forceinline__ void gla_norm_pass(unsigned char* ws, const float* gng, int G) {
    const float* ORAW = (const float*)(ws + WS_ORAW); bf16* GR = (bf16*)(ws + WS_GR);
    const int lane = threadIdx.x & 63; const int gw = blockIdx.x * 8 + (threadIdx.x >> 6), NGW = G * 8;
    for (int it = gw; it < MTOK * 4; it += NGW) {
        const size_t off = (size_t)it * 512 + lane * 8;
        const v4f a = *(const v4f*)(ORAW + off), b = *(const v4f*)(ORAW + off + 4);
        float ss = (a[0] * a[0] + a[1] * a[1]) + (a[2] * a[2] + a[3] * a[3]) + (b[0] * b[0] + b[1] * b[1]) + (b[2] * b[2] + b[3] * b[3]);
        ss = wave_sum(ss);
        const float rstd = 1.0f / sqrtf(ss * (1.0f / 512.0f) + RMS_EPS);
        const v4u gw4 = *(const v4u*)(GR + off); const v4f g0 = *(const v4f*)(gng + lane * 8), g1 = *(const v4f*)(gng + lane * 8 + 4);
        float gr[8];
#pragma unroll
        for (int j = 0; j < 4; ++j) { gr[2 * j] = bf_lo(gw4[j]); gr[2 * j + 1] = bf_hi(gw4[j]); }
        float r[8];
#pragma unroll
        for (int j = 0; j < 4; ++j) { r[j] = a[j] * rstd * g0[j] * (gr[j] * pg8::fsigmoid(gr[j])); r[4 + j] = b[j] * rstd * g1[j] * (gr[4 + j] * pg8::fsigmoid(gr[4 + j])); }
        v4u o; o.x = cvtpk(r[0], r[1]); o.y = cvtpk(r[2], r[3]); o.z = cvtpk(r[4], r[5]); o.w = cvtpk(r[6], r[7]);
        *(v4u*)(GR + off) = o;
    }
}
__device__ __forceinline__ void ln_pass(const float* src, float* dst, bf16* dstb, const float* g, const float* bta, int G) {
    const int lane = threadIdx.x & 63; const int gw = blockIdx.x * 8 + (threadIdx.x >> 6), NGW = G * 8;
    for (int row = gw; row < MTOK; row += NGW) {
        const float* xr = src + (size_t)row * DM + lane * 4;
        v4f v[8]; float s = 0.f;
#pragma unroll
        for (int j = 0; j < 8; ++j) { v[j] = *(const v4f*)(xr + 256 * j); s += (v[j][0] + v[j][1]) + (v[j][2] + v[j][3]); }
        const float mean = wave_sum(s) * (1.0f / DM); float s2 = 0.f;
#pragma unroll
        for (int j = 0; j < 8; ++j) { v[j] = v[j] - mean; s2 += (v[j][0] * v[j][0] + v[j][1] * v[j][1]) + (v[j][2] * v[j][2] + v[j][3] * v[j][3]); }
        const float rstd = 1.0f / sqrtf(wave_sum(s2) * (1.0f / DM) + LN_EPS);
#pragma unroll
        for (int j = 0; j < 8; ++j) { const v4f gg = *(const v4f*)(g + lane * 4 + 256 * j), bb = *(const v4f*)(bta + lane * 4 + 256 * j); const v4f y = v[j] * rstd * gg + bb;
            *(v4f*)(dst + (size_t)row * DM + lane * 4 + 256 * j) = y;
            *(v2u*)(dstb + (size_t)row * DM + lane * 4 + 256 * j) = (v2u){cvtpk(y[0], y[1]), cvtpk(y[2], y[3])}; }
    }
}

#ifndef PH
#define PH 0xFFFF
#endif
#ifndef PROBE
#define PROBE 0
#endif
struct Args { const float* in[21]; float* out; unsigned char* ws; };
__global__ void __launch_bounds__(512, 2) mega_fwd(Args args) {
    extern __shared__ __attribute__((aligned(16))) unsigned char lds_raw[];
    lds_t lds = (lds_t)lds_raw;
    volatile LAS unsigned* MISC = (volatile LAS unsigned*)(lds + MISC_OFF);
    const int tid = threadIdx.x, G = gridDim.x;
    unsigned char* ws = args.ws;
    unsigned* ctl = (unsigned*)(ws + WS_CTL);
    if (tid < 64) MISC[tid] = 0u;
    __syncthreads();
    XcdBarrier bar = xcd_barrier_post(ctl + CW_BAR, MISC + 8);
#if PROBE
    int nstamp = 0;
#define STAMP() do { if (blockIdx.x == 0 && tid == 0) MISC[32 + nstamp] = (unsigned)__builtin_amdgcn_s_memrealtime(); ++nstamp; } while (0)
#else
#define STAMP() do { } while (0)
#endif
#define GRID_BAR() do { xcd_barrier(bar); STAMP(); } while (0)
    STAMP();

    if (PH & 1) p0_prologue(lds, args.in, ws, G);
    cg::this_grid().sync();
    STAMP();

    if (PH & 2) { pg8::Gemm g{(const pg8::bf16_t*)(ws + WS_XB), (const pg8::bf16_t*)(ws + WS_WIN), MTOK, NPAD, DM}; pg8::StaticOrder S; S.init(MTOK, NPAD, G, (int)blockIdx.x);
      pg8::EpiProj E{ws, 0.08838834764831845f * LOG2E};
      pg8::gemm_phase<pg8::EpiProj, pg8::StaticOrder, true, true>(lds, g, S, E); }
    if (PH & 1) rest_queue(lds, MISC, ctl + CW_QUEUE2, 0, I_BG + I_BF + I_OUT + I_G, args.in, ws);
    GRID_BAR();

    if (PH & 4) for (int it = blockIdx.x; it < 512 + 256 + 16; it += G) {
        if (it < 512) gla_prep_item(lds, it, ws, args.in[3], args.in[4], tid);
        else if (it < 768) fv_tr_item(lds, it - 512, ws, tid);
        else fox_cumsum_item(lds, it - 768, ws, args.in[6], tid);
    }
    GRID_BAR();

    if (PH & 8) for (int it = blockIdx.x; it < 32 * NSEG; it += G) gla_scan_item(lds, it, ws, tid);
#if PROBE
    if (blockIdx.x == 0 && tid == 0) MISC[31] = (unsigned)__builtin_amdgcn_s_memrealtime();
#endif
    if (PH & 16) for (;;) {
        __syncthreads();
        if (tid == 0) MISC[16] = __hip_atomic_fetch_add(ctl + CW_QUEUE, 1u, RLX_AGENT);
        __syncthreads();
        const int j = (int)MISC[16];
        if (j >= 512) break;
        fox_unit(lds, j & 15, 31 - (j >> 4), ws, tid);
    }
    GRID_BAR();
    if (PH & 0x4000) for (int it = blockIdx.x; it < 32 * NSEG; it += G) { if ((it & (NSEG - 1)) != 0) gla_fix_item(lds, it, ws, tid); }
    GRID_BAR();

    if (PH & 32) gla_norm_pass(ws, args.in[5], G);
    GRID_BAR();

    if (PH & 64) { pg8::StaticOrder S; S.init(MTOK, DM, G, (int)blockIdx.x);
      { pg8::Gemm g{(const pg8::bf16_t*)(ws + WS_OG), (const pg8::bf16_t*)(ws + WS_WBG), MTOK, DM, 2048};
        pg8::EpiEw<1> E{(float*)(ws + WS_YTMP), nullptr, nullptr, (const pg8::bf16_t*)(ws + WS_MA), DM, 0.f};
        pg8::gemm_phase<pg8::EpiEw<1>, pg8::StaticOrder, false, true>(lds, g, S, E); }
      asm volatile("s_waitcnt vmcnt(0)" ::: "memory"); __syncthreads();
      { pg8::Gemm g{(const pg8::bf16_t*)(ws + WS_OF), (const pg8::bf16_t*)(ws + WS_WBF), MTOK, DM, 1024};
        pg8::EpiEw<2> E{nullptr, (pg8::bf16_t*)(ws + WS_MERGED), (const float*)(ws + WS_YTMP), (const pg8::bf16_t*)(ws + WS_MB), DM, 0.f};
        pg8::gemm_phase<pg8::EpiEw<2>, pg8::StaticOrder, false, true>(lds, g, S, E); } }
    GRID_BAR();

    if (PH & 128) { pg8::StaticOrder S; S.init(MTOK, DM, G, (int)blockIdx.x);
      pg8::Gemm g{(const pg8::bf16_t*)(ws + WS_MERGED), (const pg8::bf16_t*)(ws + WS_WOUT), MTOK, DM, 2048};
      pg8::EpiEw<3> E{(float*)(ws + WS_X1), nullptr, args.in[0], nullptr, DM, ALPHA_RES};
      pg8::gemm_phase<pg8::EpiEw<3>, pg8::StaticOrder, false, true>(lds, g, S, E); }
    GRID_BAR();
    if (PH & 256) ln_pass((const float*)(ws + WS_X1), (float*)(ws + WS_X1), (bf16*)(ws + WS_XNB), args.in[10], args.in[11], G);
    GRID_BAR();

    if (PH & 512) { pg8::StaticOrder S; S.init(MTOK, FF, G, (int)blockIdx.x);
      pg8::Gemm g{(const pg8::bf16_t*)(ws + WS_XNB), (const pg8::bf16_t*)(ws + WS_WG), MTOK, FF, 2048};
      pg8::EpiBf E{(pg8::bf16_t*)(ws + WS_G), FF};
      pg8::gemm_phase<pg8::EpiBf, pg8::StaticOrder, true, true>(lds, g, S, E); }
    if (PH & 1) rest_queue(lds, MISC, ctl + CW_QUEUE2 + 64, I_BG + I_BF + I_OUT + I_G, I_BG + I_BF + I_OUT + I_G + I_U, args.in, ws);
    GRID_BAR();
    if (PH & 1024) { pg8::StaticOrder S; S.init(MTOK, FF, G, (int)blockIdx.x);
      pg8::Gemm g{(const pg8::bf16_t*)(ws + WS_XNB), (const pg8::bf16_t*)(ws + WS_WU), MTOK, FF, 2048};
      pg8::EpiUp E{(const pg8::bf16_t*)(ws + WS_G), (pg8::bf16_t*)(ws + WS_H), args.in[14], args.in[15]};
      pg8::gemm_phase<pg8::EpiUp, pg8::StaticOrder, true, true>(lds, g, S, E); }
    if (PH & 1) rest_queue(lds, MISC, ctl + CW_QUEUE2 + 128, I_BG + I_BF + I_OUT + I_G + I_U, I_REST, args.in, ws);
    GRID_BAR();
    if (PH & 2048) { pg8::StaticOrder S; S.init(MTOK, DM, G, (int)blockIdx.x);
      pg8::Gemm g{(const pg8::bf16_t*)(ws + WS_H), (const pg8::bf16_t*)(ws + WS_WD), MTOK, DM, FF};
      pg8::EpiEw<3> E{(float*)(ws + WS_V2), nullptr, (const float*)(ws + WS_X1), nullptr, DM, ALPHA_RES};
      pg8::gemm_phase<pg8::EpiEw<3>, pg8::StaticOrder, false, true>(lds, g, S, E); }
    GRID_BAR();
    if (PH & 4096) ln_pass((const float*)(ws + WS_V2), args.out, (bf16*)(ws + WS_XNB), args.in[17], args.in[18], G);
    GRID_BAR();

    if (PH & 8192) { pg8::StaticOrder S; S.init(MTOK, DM, G, (int)blockIdx.x);
      { pg8::Gemm g{(const pg8::bf16_t*)(ws + WS_PB), (const pg8::bf16_t*)(ws + WS_WPP), MTOK, DM, PLE};
        pg8::EpiEw<0> E{(float*)(ws + WS_TMP), nullptr, nullptr, nullptr, DM, 0.f};
        pg8::gemm_phase<pg8::EpiEw<0>, pg8::StaticOrder, false, true>(lds, g, S, E); }
      asm volatile("s_waitcnt vmcnt(0)" ::: "memory"); __syncthreads();
      { pg8::Gemm g{(const pg8::bf16_t*)(ws + WS_XNB), (const pg8::bf16_t*)(ws + WS_WPG), MTOK, DM, 2048};
        pg8::EpiEw<4> E{args.out, nullptr, (const float*)(ws + WS_TMP), nullptr, DM, 0.f};
        pg8::gemm_phase<pg8::EpiEw<4>, pg8::StaticOrder, false, true>(lds, g, S, E); } }
#if PROBE
    GRID_BAR();
    if (blockIdx.x == 0 && tid == 0) {
        const unsigned ta = (PROBE_A == 99) ? (MISC[31] - MISC[32 + 3]) : (MISC[32 + PROBE_A + 1] - MISC[32 + PROBE_A]);
        const unsigned tb = (PROBE_B == 99) ? (MISC[31] - MISC[32 + 3]) : (MISC[32 + PROBE_B + 1] - MISC[32 + PROBE_B]);
        __hip_atomic_store(ctl + 80, ta, RLX_AGENT); __hip_atomic_store(ctl + 81, tb, RLX_AGENT);
    }
    GRID_BAR();
    { unsigned na = __hip_atomic_load(ctl + 80, RLX_AGENT) * 40u; const unsigned tb = __hip_atomic_load(ctl + 81, RLX_AGENT);
      if (na > 8000000u) na = 8000000u;
      for (unsigned i = blockIdx.x * 512 + tid; i < na; i += G * 512) args.out[i] += 0.008f;
      const unsigned long long t0 = __builtin_amdgcn_s_memrealtime();
      while (__builtin_amdgcn_s_memrealtime() - t0 < 2ull * tb) __builtin_amdgcn_s_sleep(8); }
#endif
}

extern "C" void kernel_launch(void* const* d_in, const int* in_sizes, int n_in, void* d_out, int out_size, void* d_ws, size_t ws_size, hipStream_t stream) {
    static int grid = 0;
    if (grid == 0) {
        if (n_in != 21 || in_sizes[0] != MTOK * DM || out_size != MTOK * DM || ws_size < WS_END) { fprintf(stderr, "kernel_launch: unexpected shapes (n_in %d, in0 %d, out %d, ws %zu < %zu)\n", n_in, n_in > 0 ? in_sizes[0] : -1, out_size, ws_size, (size_t)WS_END); grid = -1; return; }
        int dev = 0, cus = 0, per_cu = 0;
        if (hipGetDevice(&dev) != hipSuccess || hipDeviceGetAttribute(&cus, hipDeviceAttributeMultiprocessorCount, dev) != hipSuccess) { fprintf(stderr, "kernel_launch: device query failed\n"); grid = -1; return; }
        if (hipFuncSetAttribute((const void*)mega_fwd, hipFuncAttributeMaxDynamicSharedMemorySize, LDS_BYTES) != hipSuccess) { fprintf(stderr, "kernel_launch: hipFuncSetAttribute failed\n"); grid = -1; return; }
        if (hipOccupancyMaxActiveBlocksPerMultiprocessor(&per_cu, (const void*)mega_fwd, 512, LDS_BYTES) != hipSuccess || per_cu < 1) { fprintf(stderr, "kernel_launch: occupancy query says %d blocks per CU\n", per_cu); per_cu = 1; }
        (void)hipGetLastError();
        grid = cus;
    }
    if (grid < 0) return;
    if (hipMemsetAsync((char*)d_ws + WS_CTL, 0, CTL_ZERO_BYTES, stream) != hipSuccess) { fprintf(stderr, "kernel_launch: memset failed\n"); return; }
    Args a{};
    for (int i = 0; i < 21; ++i) a.in[i] = (const float*)d_in[i];
    a.out = (float*)d_out; a.ws = (unsigned char*)d_ws;
    void* kargs[] = {&a};
    const hipError_t e = hipLaunchCooperativeKernel((const void*)mega_fwd, dim3(grid), dim3(512), kargs, LDS_BYTES, stream);
    if (e != hipSuccess) fprintf(stderr, "kernel_launch: cooperative launch failed: %s (grid %d)\n", hipGetErrorString(e), grid);
}
```
